# Optimizing an MI355X kernel written in HIP

```python
import jax, jax.numpy as jnp
from jax import lax
import numpy as np

D_MODEL = 1024
BATCH = 2
SEQ = 8192
DEPTH = 1

GRID_W = 64
CTX_LEN = 256
MLA_HEADS = 8
MLA_NOPE = 64
MLA_ROPE = 32
MLA_QK = MLA_NOPE + MLA_ROPE
MLA_V = 64
Q_LORA = 384
KV_LORA = 256
NA_HEADS = 8
NA_DIM = 64
NA_WIN_H = 8
NA_WIN_W = 16
MIX_WIDTH = MLA_HEADS * MLA_V + NA_HEADS * NA_DIM
Q_COLS = Q_LORA + NA_HEADS * NA_DIM
KV_COLS = KV_LORA + MLA_ROPE + 2 * NA_HEADS * NA_DIM
N_GROUPS = 4
EXPERTS_PER_GROUP = 4
N_EXPERTS = N_GROUPS * EXPERTS_PER_GROUP
TOP_K_IN_GROUP = 2
D_EXPERT = 512
Q_BLOCK = 128
ROPE_THETA = 10000.0
NORM_EPS = 1e-6
MASK_VALUE = -1e30

kernel_name = 'hybrid_mla_natten_hmoe_dit'


def rmsnorm(x, g):
    xf = x.astype(jnp.float32)
    y = xf * lax.rsqrt(jnp.mean(xf * xf, axis=-1, keepdims=True) + NORM_EPS)
    return (y * g.astype(jnp.float32)).astype(x.dtype)


def adaln(cond, w_mod, b_mod):
    return jnp.split(jax.nn.silu(cond) @ w_mod + b_mod, 6, axis=-1)


def modulate(h, shift, scale):
    return h * (1 + scale) + shift


def axial_rope_tables(row, col, dtype):
    half = MLA_ROPE // 2
    inv_freq = ROPE_THETA ** (-jnp.arange(0, half, 2, dtype=jnp.float32) / half)
    ang = jnp.concatenate([row.astype(jnp.float32)[:, None] * inv_freq,
                           col.astype(jnp.float32)[:, None] * inv_freq], axis=-1)
    return jnp.cos(ang).astype(dtype), jnp.sin(ang).astype(dtype)


def apply_rope(x, cos, sin):
    x1, x2 = jnp.split(x, 2, axis=-1)
    c, s = cos[:, None, :], sin[:, None, :]
    return jnp.concatenate([x1 * c - x2 * s, x1 * s + x2 * c], axis=-1)


def mixer_queries(pq, q_a_g, w_uq):
    B, L, _ = pq.shape
    q_lat, na_q = jnp.split(pq, [Q_LORA], axis=-1)
    q_mla = (rmsnorm(q_lat, q_a_g) @ w_uq).reshape(B, L, MLA_HEADS, MLA_QK)
    return q_mla, na_q.reshape(B, L, NA_HEADS, NA_DIM)


def mixer_keys_values(pkv, kv_a_g, w_ukv):
    B, L, _ = pkv.shape
    kv_lat, k_rope, na_k, na_v = jnp.split(
        pkv, [KV_LORA, KV_LORA + MLA_ROPE, KV_LORA + MLA_ROPE + NA_HEADS * NA_DIM], axis=-1)
    kv = (rmsnorm(kv_lat, kv_a_g) @ w_ukv).reshape(B, L, MLA_HEADS, MLA_NOPE + MLA_V)
    k_nope, v_mla = jnp.split(kv, [MLA_NOPE], axis=-1)
    return (k_nope, k_rope, v_mla,
            na_k.reshape(B, L, NA_HEADS, NA_DIM), na_v.reshape(B, L, NA_HEADS, NA_DIM))


def mla_keys(k_nope, k_rope_b):
    return jnp.concatenate([k_nope, jnp.broadcast_to(k_rope_b, k_nope.shape[:3] + (MLA_ROPE,))], axis=-1)


def dense_attention(q, k, v):
    s = jnp.einsum('bqhd,bkhd->bhqk', q, k).astype(jnp.float32) * (q.shape[-1] ** -0.5)
    p = jax.nn.softmax(s, axis=-1).astype(v.dtype)
    return jnp.einsum('bhqk,bkhd->bqhd', p, v)


def mla_latent_attention(q, k, v, k_ctx, v_ctx):
    B, N, H, Dq = q.shape
    k_all = jnp.concatenate([k_ctx, k], axis=1)
    v_all = jnp.concatenate([v_ctx, v], axis=1)
    q_blocks = jnp.moveaxis(q.reshape(B, N // Q_BLOCK, Q_BLOCK, H, Dq), 1, 0)
    out = lax.map(lambda qb: dense_attention(qb, k_all, v_all), q_blocks)
    return jnp.moveaxis(out, 0, 1).reshape(B, N, H, v.shape[-1])


def neighbourhood_attention(q, k, v, k_ctx, v_ctx, rel_bias):
    B, N, H, Dh = q.shape
    rows = N // GRID_W
    kh = min(NA_WIN_H, rows)
    kw = NA_WIN_W
    scale = Dh ** -0.5
    qg = jnp.moveaxis(q.reshape(B, rows, GRID_W, H, Dh), 1, 0)
    kg = k.reshape(B, rows, GRID_W, H, Dh)
    vg = v.reshape(B, rows, GRID_W, H, Dh)
    col = jnp.arange(GRID_W)
    col_start = jnp.clip(col - kw // 2, 0, GRID_W - kw)
    col_in = (col[None, :] >= col_start[:, None]) & (col[None, :] < col_start[:, None] + kw)
    bias_cols = rel_bias[:, :, col[None, :] - col[:, None] + (NA_WIN_W - 1)]

    def one_row(args):
        r, qr = args
        start = jnp.clip(r - kh // 2, 0, rows - kh)
        kr = lax.dynamic_slice_in_dim(kg, start, kh, axis=1)
        vr = lax.dynamic_slice_in_dim(vg, start, kh, axis=1)
        bias = bias_cols[:, start + jnp.arange(kh) - r + (NA_WIN_H - 1)]
        s = jnp.einsum('bqhd,bjkhd->bhqjk', qr, kr).astype(jnp.float32) * scale
        s = s + jnp.transpose(bias, (0, 2, 1, 3)).astype(jnp.float32)[None]
        s = jnp.where(col_in[None, None, :, None, :], s, MASK_VALUE).reshape(B, H, GRID_W, kh * GRID_W)
        s_ctx = jnp.einsum('bqhd,bchd->bhqc', qr, k_ctx).astype(jnp.float32) * scale
        p = jax.nn.softmax(jnp.concatenate([s, s_ctx], axis=-1), axis=-1).astype(v.dtype)
        p_win = p[..., :kh * GRID_W].reshape(B, H, GRID_W, kh, GRID_W)
        p_ctx = p[..., kh * GRID_W:]
        return (jnp.einsum('bhqjk,bjkhd->bqhd', p_win, vr)
                + jnp.einsum('bhqc,bchd->bqhd', p_ctx, v_ctx))

    out = lax.map(one_row, (jnp.arange(rows), qg))
    return jnp.moveaxis(out, 0, 1).reshape(B, N, H, Dh)


def hierarchical_moe(h, w_rg, b_rg, w_re, b_re, w_gate, w_up, w_down):
    B, L, D = h.shape
    t = h.reshape(B * L, D)
    T = t.shape[0]
    g_logits = (t @ w_rg + b_rg).astype(jnp.float32)
    g_prob = jax.nn.softmax(g_logits, axis=-1)
    g_sel = jnp.argmax(g_logits, axis=-1)
    g_w = jnp.take_along_axis(g_prob, g_sel[:, None], axis=-1)
    e_logits = (t @ w_re + b_re).astype(jnp.float32).reshape(T, N_GROUPS, EXPERTS_PER_GROUP)
    e_logits = jnp.take_along_axis(e_logits, g_sel[:, None, None], axis=1)[:, 0]
    top_p, top_i = lax.top_k(jax.nn.softmax(e_logits, axis=-1), TOP_K_IN_GROUP)
    top_p = top_p / jnp.sum(top_p, axis=-1, keepdims=True)
    within = jnp.sum(jax.nn.one_hot(top_i, EXPERTS_PER_GROUP, dtype=jnp.float32) * top_p[..., None], axis=1)
    combine = (jax.nn.one_hot(g_sel, N_GROUPS, dtype=jnp.float32)[:, :, None]
               * (g_w * within)[:, None, :]).astype(h.dtype)
    wg = w_gate.reshape(N_GROUPS, EXPERTS_PER_GROUP, D, D_EXPERT)
    wu = w_up.reshape(N_GROUPS, EXPERTS_PER_GROUP, D, D_EXPERT)
    wd = w_down.reshape(N_GROUPS, EXPERTS_PER_GROUP, D_EXPERT, D)

    def one_group(args):
        wg_g, wu_g, wd_g, comb_g = args
        hid = jax.nn.silu(jnp.einsum('td,edf->tef', t, wg_g)) * jnp.einsum('td,edf->tef', t, wu_g)
        return jnp.einsum('tef,efd->td', hid * comb_g[:, :, None], wd_g)

    y = jnp.sum(lax.map(one_group, (wg, wu, wd, jnp.moveaxis(combine, 1, 0))), axis=0)
    return y.reshape(B, L, D)


def setup_inputs(seed: int = 0) -> dict:
    key = jax.random.key(seed)
    ks = jax.random.split(key, 24)
    D = D_MODEL

    def nrm(k, shape, scale):
        return jax.random.normal(k, shape, jnp.float32) * scale

    return {
        'x': nrm(ks[0], (BATCH, SEQ, D), 1.0),
        'c': nrm(ks[1], (BATCH, D), 1.0),
        'ctx': nrm(ks[2], (BATCH, CTX_LEN, D), 1.0),
        'c_ctx': nrm(ks[3], (D,), 1.0),
        'w_mod': nrm(ks[4], (DEPTH, D, 6 * D), 0.5 * D ** -0.5),
        'b_mod': nrm(ks[5], (DEPTH, 6 * D), 0.02),
        'norm_attn_g': 1.0 + nrm(ks[6], (DEPTH, D), 0.02),
        'norm_ffn_g': 1.0 + nrm(ks[7], (DEPTH, D), 0.02),
        'w_in': nrm(ks[8], (DEPTH, D, Q_COLS + KV_COLS), D ** -0.5),
        'q_a_norm_g': 1.0 + nrm(ks[9], (DEPTH, Q_LORA), 0.02),
        'kv_a_norm_g': 1.0 + nrm(ks[10], (DEPTH, KV_LORA), 0.02),
        'w_uq': nrm(ks[11], (DEPTH, Q_LORA, MLA_HEADS * MLA_QK), Q_LORA ** -0.5),
        'w_ukv': nrm(ks[12], (DEPTH, KV_LORA, MLA_HEADS * (MLA_NOPE + MLA_V)), KV_LORA ** -0.5),
        'na_rel_bias': nrm(ks[13], (DEPTH, NA_HEADS, 2 * NA_WIN_H - 1, 2 * NA_WIN_W - 1), 0.5),
        'w_out': nrm(ks[14], (DEPTH, MIX_WIDTH, D), MIX_WIDTH ** -0.5),
        'w_router_group': nrm(ks[15], (DEPTH, D, N_GROUPS), D ** -0.5),
        'b_router_group': nrm(ks[16], (DEPTH, N_GROUPS), 0.01),
        'w_router_expert': nrm(ks[17], (DEPTH, D, N_EXPERTS), D ** -0.5),
        'b_router_expert': nrm(ks[18], (DEPTH, N_EXPERTS), 0.01),
        'w_gate': nrm(ks[19], (DEPTH, N_EXPERTS, D, D_EXPERT), D ** -0.5),
        'w_up': nrm(ks[20], (DEPTH, N_EXPERTS, D, D_EXPERT), D ** -0.5),
        'w_down': nrm(ks[21], (DEPTH, N_EXPERTS, D_EXPERT, D), D_EXPERT ** -0.5),
        'final_norm_g': 1.0 + nrm(ks[22], (D,), 0.02),
    }


def reference(x, c, ctx, c_ctx, w_mod, b_mod, norm_attn_g, norm_ffn_g, w_in, q_a_norm_g, kv_a_norm_g,
              w_uq, w_ukv, na_rel_bias, w_out, w_router_group, b_router_group, w_router_expert,
              b_router_expert, w_gate, w_up, w_down, final_norm_g):
    B, N, D = x.shape
    pos = jnp.arange(N)
    cos, sin = axial_rope_tables(pos // GRID_W, pos % GRID_W, x.dtype)
    for l in range(DEPTH):
        sh1, sc1, g1, sh2, sc2, g2 = [m[:, None, :] for m in adaln(c, w_mod[l], b_mod[l])]
        csh1, csc1, cg1, csh2, csc2, cg2 = adaln(c_ctx, w_mod[l], b_mod[l])
        hx = modulate(rmsnorm(x, norm_attn_g[l]), sh1, sc1)
        hc = modulate(rmsnorm(ctx, norm_attn_g[l]), csh1, csc1)

        kn_c, kr_c, v_c, nk_c, nv_c = mixer_keys_values(hc @ w_in[l][:, Q_COLS:], kv_a_norm_g[l], w_ukv[l])
        k_c = mla_keys(kn_c, kr_c[:, :, None, :])

        proj = hx @ w_in[l]
        q_m, nq = mixer_queries(proj[..., :Q_COLS], q_a_norm_g[l], w_uq[l])
        kn, kr, v_m, nk, nv = mixer_keys_values(proj[..., Q_COLS:], kv_a_norm_g[l], w_ukv[l])
        q_m = jnp.concatenate([q_m[..., :MLA_NOPE], apply_rope(q_m[..., MLA_NOPE:], cos, sin)], axis=-1)
        k_m = mla_keys(kn, apply_rope(kr[:, :, None, :], cos, sin))
        o_mla = mla_latent_attention(q_m, k_m, v_m, k_c, v_c)
        o_na = neighbourhood_attention(nq, nk, nv, nk_c, nv_c, na_rel_bias[l])
        mixed = jnp.concatenate([o_mla.reshape(B, N, -1), o_na.reshape(B, N, -1)], axis=-1) @ w_out[l]

        if l < DEPTH - 1:
            Bc, C = ctx.shape[:2]
            q_c, nq_c = mixer_queries(hc @ w_in[l][:, :Q_COLS], q_a_norm_g[l], w_uq[l])
            mixed_c = jnp.concatenate([dense_attention(q_c, k_c, v_c).reshape(Bc, C, -1),
                                       dense_attention(nq_c, nk_c, nv_c).reshape(Bc, C, -1)], axis=-1) @ w_out[l]
            ctx = ctx + cg1 * mixed_c
            hc2 = modulate(rmsnorm(ctx, norm_ffn_g[l]), csh2, csc2)
            ctx = ctx + cg2 * hierarchical_moe(hc2, w_router_group[l], b_router_group[l], w_router_expert[l],
                                               b_router_expert[l], w_gate[l], w_up[l], w_down[l])

        x = x + g1 * mixed
        hx2 = modulate(rmsnorm(x, norm_ffn_g[l]), sh2, sc2)
        x = x + g2 * hierarchical_moe(hx2, w_router_group[l], b_router_group[l], w_router_expert[l],
                                      b_router_expert[l], w_gate[l], w_up[l], w_down[l])
    return rmsnorm(x, final_norm_g)
```

```cpp
#include <hip/hip_runtime.h>
#include <hip/hip_cooperative_groups.h>
#include <cstdio>
#include <cstdint>
namespace cg = cooperative_groups;

#ifndef MODE_EXACT
#define MODE_EXACT 0
#endif
#ifndef ONE_LAUNCH
#define ONE_LAUNCH 0
#endif
#ifndef ATTN_EXACT
#define ATTN_EXACT MODE_EXACT
#endif
#ifndef GEMM_EXACT
#define GEMM_EXACT MODE_EXACT
#endif

#define DEVI __device__ __forceinline__

typedef unsigned short bf16_t;
typedef short bf16x8 __attribute__((ext_vector_type(8)));
typedef short s16x4 __attribute__((ext_vector_type(4)));
typedef float f32x16 __attribute__((ext_vector_type(16)));
typedef float f32x4 __attribute__((ext_vector_type(4)));
typedef unsigned u32x4 __attribute__((ext_vector_type(4)));

#if MODE_EXACT
typedef float act_t;
#else
typedef bf16_t act_t;
#endif

constexpr int DM = 1024, NBATCH = 2, SEQ = 8192, CTXL = 256, RB = SEQ + CTXL  , RR = NBATCH * RB  , TT = NBATCH * SEQ  ;
constexpr int GW = 64, GROWS = 128;
constexpr int QL = 384, KVL = 256, NPROJ = 2304  , NPROJ_REAL = 2208;
constexpr int NEXP = 16, DEXP = 512;
constexpr float EPS = 1e-6f, LOG2E = 1.4426950408889634f;
constexpr float QSCALE = 0.10206207261596577f * 1.4426950408889634f;
constexpr float NASCALE = 0.125f * 1.4426950408889634f;
constexpr int HIDROWS = 34816;
constexpr int NTHREADS = 256;

constexpr size_t AS = sizeof(act_t);
constexpr size_t OFF_BAR   = 0;
constexpr size_t OFF_CNT   = 16384;
constexpr size_t OFF_MOD   = OFF_CNT + 256;
constexpr size_t OFF_ROPE  = OFF_MOD + 3 * 6144 * 4;
constexpr size_t OFF_SSQ   = OFF_ROPE + 2 * 128 * 8 * 4;
constexpr size_t OFF_SSKV  = OFF_SSQ + (size_t)RR * 4 * 4;
constexpr size_t OFF_BT    = OFF_SSKV + (size_t)RR * 2 * 4;
constexpr size_t OFF_ELIST = OFF_BT + (size_t)8 * 15 * 4096 * 4;
constexpr size_t OFF_EW    = OFF_ELIST + (size_t)NEXP * TT * 4;
constexpr size_t SMALL_END = OFF_EW + (size_t)NEXP * TT * 4;
static_assert(SMALL_END <= (size_t)8 << 20, "small region");
constexpr size_t OFF_W     = (size_t)8 << 20;
#if MODE_EXACT
constexpr size_t W_BYTES = 0;
#else
constexpr size_t W_BYTES = (size_t)60 << 20;
#endif
constexpr size_t OFF_WIN  = OFF_W;
constexpr size_t OFF_WUQ  = OFF_WIN + (size_t)NPROJ * 1024 * 2;
constexpr size_t OFF_WUKV = OFF_WUQ + (size_t)768 * 384 * 2;
constexpr size_t OFF_WOUT = OFF_WUKV + (size_t)1024 * 256 * 2;
constexpr size_t OFF_WGU  = OFF_WOUT + (size_t)1024 * 1024 * 2;
constexpr size_t OFF_WD   = OFF_WGU + (size_t)16 * 1024 * 1024 * 2;
constexpr size_t W_END    = OFF_WD + (size_t)16 * 1024 * 512 * 2;
static_assert(MODE_EXACT || W_END <= OFF_W + W_BYTES, "weights region");
constexpr size_t G0 = OFF_W + W_BYTES;
constexpr size_t OFF_HXALL = G0;
constexpr size_t OFF_KV    = OFF_HXALL;
constexpr size_t OFF_NAQ   = OFF_HXALL + (size_t)RR * 1024 * AS;
constexpr size_t OFF_NAK   = OFF_NAQ + (size_t)RR * 512 * AS;
constexpr size_t OFF_NAV   = OFF_NAK + (size_t)RR * 512 * AS;
constexpr size_t OFF_KROPE = OFF_NAV + (size_t)RR * 512 * AS;
constexpr size_t OFF_QLAT  = OFF_KROPE + (size_t)RR * 32 * AS;
constexpr size_t OFF_KVLAT = OFF_QLAT + (size_t)RR * 384 * AS;
constexpr size_t OFF_ATTN  = OFF_QLAT;
constexpr size_t ATT_END   = OFF_ATTN + (size_t)TT * 1024 * AS;
constexpr size_t OFF_YBUF  = G0;
constexpr size_t OFF_HX2   = G0;
constexpr size_t OFF_HID   = OFF_YBUF + (size_t)2 * TT * 1024 * AS;
constexpr size_t MOE_END   = OFF_HID + (size_t)HIDROWS * 512 * AS;
constexpr size_t WS_NEED   = ATT_END > MOE_END ? ATT_END : MOE_END;
static_assert(WS_NEED <= ((size_t)256 << 20), "workspace");

struct Params {
  const float *x, *c, *ctx, *c_ctx, *w_mod, *b_mod, *g_attn, *g_ffn, *w_in, *g_q, *g_kv, *w_uq, *w_ukv, *rel_bias, *w_out,
              *w_rg, *b_rg, *w_re, *b_re, *w_gate, *w_up, *w_down, *g_final;
  float* out; char* ws;
};

DEVI float bf2f(bf16_t v) { return __uint_as_float(((unsigned)v) << 16); }
DEVI bf16_t f2bf(float f) { unsigned u = __float_as_uint(f); u += 0x7fffu + ((u >> 16) & 1u); return (bf16_t)(u >> 16); }
typedef __bf16 bf16x2_t __attribute__((ext_vector_type(2)));
typedef float f32x2_t __attribute__((ext_vector_type(2)));
DEVI unsigned pk2(float lo, float hi) { const f32x2_t v = {lo, hi}; return __builtin_bit_cast(unsigned, __builtin_convertvector(v, bf16x2_t)); }
DEVI float a2f(float v) { return v; }
DEVI float a2f(bf16_t v) { return bf2f(v); }
DEVI void ld4(const float* p, float (&v)[4]) { const float4 t = *(const float4*)p; v[0] = t.x; v[1] = t.y; v[2] = t.z; v[3] = t.w; }
DEVI void ld4(const bf16_t* p, float (&v)[4]) { const uint2 t = *(const uint2*)p; v[0] = __uint_as_float(t.x << 16); v[1] = __uint_as_float(t.x & 0xffff0000u); v[2] = __uint_as_float(t.y << 16); v[3] = __uint_as_float(t.y & 0xffff0000u); }
DEVI void st4(float* p, float a, float b, float c, float d) { *(float4*)p = make_float4(a, b, c, d); }
DEVI void st4(bf16_t* p, float a, float b, float c, float d) { uint2 t; t.x = pk2(a, b); t.y = pk2(c, d); *(uint2*)p = t; }
DEVI void st1(float* p, float a) { *p = a; }
DEVI void st1(bf16_t* p, float a) { *p = f2bf(a); }
DEVI int crow(int r, int hi) { return (r & 3) + 8 * (r >> 2) + 4 * hi; }
DEVI float wave_sum(float v) { v += __shfl_xor(v, 32); v += __shfl_xor(v, 16); v += __shfl_xor(v, 8); v += __shfl_xor(v, 4); v += __shfl_xor(v, 2); v += __shfl_xor(v, 1); return v; }
DEVI float half_sum32(float v) { v += __shfl_xor(v, 16); v += __shfl_xor(v, 8); v += __shfl_xor(v, 4); v += __shfl_xor(v, 2); v += __shfl_xor(v, 1); return v; }
DEVI float xhalf_max(float v) { auto rr = __builtin_amdgcn_permlane32_swap(__float_as_uint(v), __float_as_uint(v), false, false); return fmaxf(__uint_as_float(rr[0]), __uint_as_float(rr[1])); }
DEVI float xhalf_sum(float v) { auto rr = __builtin_amdgcn_permlane32_swap(__float_as_uint(v), __float_as_uint(v), false, false); return __uint_as_float(rr[0]) + __uint_as_float(rr[1]); }
DEVI float silu_f(float v) { return v / (1.f + expf(-v)); }

DEVI int xcd_unit(int v, int U) { const int chunk = (U + 7) >> 3; const int x = v & 7, j = v >> 3; if (j >= chunk) return -1; const int u = x * chunk + j; return u < U ? u : -1; }
DEVI int xcd_iters(int U, int nb) { const int chunk = (U + 7) >> 3; return (chunk * 8 + nb - 1) / nb; }

struct WInAcc { const float* w;
  DEVI float at(int k, int n) const { int o; if (n < 1152) o = n; else if (n < 2176) o = n + 32; else if (n < 2208) o = n - 1024; else return 0.f; return w[(size_t)k * NPROJ_REAL + o]; } };
struct WUqAcc { const float* w; const float* g; DEVI float at(int k, int n) const { return g[k] * w[(size_t)k * 768 + n]; } };
struct WUkvAcc { const float* w; const float* g; DEVI float at(int k, int n) const { return g[k] * w[(size_t)k * 1024 + n]; } };
struct WOutAcc { const float* w; DEVI float at(int k, int n) const { return w[(size_t)k * 1024 + n]; } };
struct WGUAcc { const float* wg; const float* wu;
  DEVI float at(int k, int n) const { const int q = n >> 6, r = n & 63; return r < 32 ? wg[(size_t)k * 512 + q * 32 + r] : wu[(size_t)k * 512 + q * 32 + r - 32]; } };
struct WDAcc { const float* w; DEVI float at(int k, int n) const { return w[(size_t)k * 1024 + n]; } };

struct ARows { const act_t* base; size_t ld; DEVI const act_t* row(int m) const { return base + (size_t)m * ld; } };
struct AGather { const act_t* base; const int* list; int cnt; int slot0;
  DEVI const act_t* row(int m) const { const int s = slot0 + m; const int tk = s < cnt ? list[s] : 0; return base + (size_t)(tk >> 1) * 1024; } };

constexpr int CT_LD = 132;
constexpr int LDS_BYTES = 73728;

template <class AF, class BACC>
DEVI void gemm_core_exact(const AF& af, const BACC& bacc, int n0, int K, char* smem) {
  float* As = (float*)smem;
  float* Bs = As + 16 * 132;
  float* Ct = (float*)smem;
  const int t = threadIdx.x, ty = t >> 4, tx = t & 15;
  float acc[8][8];
#pragma unroll
  for (int i = 0; i < 8; ++i)
#pragma unroll
    for (int j = 0; j < 8; ++j) acc[i][j] = 0.f;
  const act_t* ap = af.row(t >> 1) + (t & 1) * 8;
  for (int k0 = 0; k0 < K; k0 += 16) {
    __syncthreads();
    { float v[4], w[4]; ld4(ap + k0, v); ld4(ap + k0 + 4, w); const int m = t >> 1, kk = (t & 1) * 8;
      As[(kk + 0) * 132 + m] = v[0]; As[(kk + 1) * 132 + m] = v[1]; As[(kk + 2) * 132 + m] = v[2]; As[(kk + 3) * 132 + m] = v[3];
      As[(kk + 4) * 132 + m] = w[0]; As[(kk + 5) * 132 + m] = w[1]; As[(kk + 6) * 132 + m] = w[2]; As[(kk + 7) * 132 + m] = w[3]; }
#pragma unroll
    for (int i = 0; i < 8; ++i) { const int n = t & 127, kk = (t >> 7) + 2 * i; Bs[kk * 132 + n] = bacc.at(k0 + kk, n0 + n); }
    __syncthreads();
#pragma unroll 4
    for (int kk = 0; kk < 16; ++kk) {
      float a[8], b[8];
      { const float4 a0 = *(const float4*)&As[kk * 132 + ty * 8], a1 = *(const float4*)&As[kk * 132 + ty * 8 + 4];
        a[0] = a0.x; a[1] = a0.y; a[2] = a0.z; a[3] = a0.w; a[4] = a1.x; a[5] = a1.y; a[6] = a1.z; a[7] = a1.w;
        const float4 b0 = *(const float4*)&Bs[kk * 132 + tx * 8], b1 = *(const float4*)&Bs[kk * 132 + tx * 8 + 4];
        b[0] = b0.x; b[1] = b0.y; b[2] = b0.z; b[3] = b0.w; b[4] = b1.x; b[5] = b1.y; b[6] = b1.z; b[7] = b1.w; }
#pragma unroll
      for (int i = 0; i < 8; ++i)
#pragma unroll
        for (int j = 0; j < 8; ++j) acc[i][j] = fmaf(a[i], b[j], acc[i][j]);
    }
  }
  __syncthreads();
#pragma unroll
  for (int i = 0; i < 8; ++i) {
    *(float4*)&Ct[(ty * 8 + i) * CT_LD + tx * 8] = make_float4(acc[i][0], acc[i][1], acc[i][2], acc[i][3]);
    *(float4*)&Ct[(ty * 8 + i) * CT_LD + tx * 8 + 4] = make_float4(acc[i][4], acc[i][5], acc[i][6], acc[i][7]);
  }
  __syncthreads();
}

#if !MODE_EXACT
template <class AF>
DEVI void gemm_core_fast(const AF& af, const bf16_t* Bt  , int ldb, int K, char* smem) {
  constexpr int ROWB = 144, STG = 128 * ROWB  ;
  const int t = threadIdx.x, lane = t & 63, w = t >> 6, wr = w >> 1, wc = w & 1, r32 = lane & 31, hi = lane >> 5;
  const int srow = t >> 3, sch = t & 7;
  const bf16_t* ag[4]; const bf16_t* bg[4];
#pragma unroll
  for (int i = 0; i < 4; ++i) { ag[i] = af.row(srow + 32 * i) + sch * 8; bg[i] = Bt + (size_t)(srow + 32 * i) * ldb + sch * 8; }
  const int soff = srow * ROWB + sch * 16;
  f32x16 acc[2][2];
#pragma unroll
  for (int i = 0; i < 2; ++i)
#pragma unroll
    for (int j = 0; j < 2; ++j)
#pragma unroll
      for (int r = 0; r < 16; ++r) acc[i][j][r] = 0.f;
  u32x4 ra[4], rb[4];
  const int nk = K >> 6;
#pragma unroll
  for (int i = 0; i < 4; ++i) { ra[i] = *(const u32x4*)(ag[i]); rb[i] = *(const u32x4*)(bg[i]); }
  __syncthreads();
#pragma unroll
  for (int i = 0; i < 4; ++i) { *(u32x4*)(smem + soff + i * 32 * ROWB) = ra[i]; *(u32x4*)(smem + STG + soff + i * 32 * ROWB) = rb[i]; }
  __syncthreads();
  for (int ks = 0; ks < nk; ++ks) {
    const char* As = smem + (ks & 1) * 2 * STG; const char* Bs = As + STG;
    if (ks + 1 < nk) {
#pragma unroll
      for (int i = 0; i < 4; ++i) { ra[i] = *(const u32x4*)(ag[i] + (ks + 1) * 64); rb[i] = *(const u32x4*)(bg[i] + (ks + 1) * 64); }
    }
#pragma unroll
    for (int s = 0; s < 4; ++s) {
      const int co = (16 * s + 8 * hi) * 2;
      const bf16x8 a0 = *(const bf16x8*)(As + (wr * 64 + r32) * ROWB + co), a1 = *(const bf16x8*)(As + (wr * 64 + 32 + r32) * ROWB + co);
      const bf16x8 b0 = *(const bf16x8*)(Bs + (wc * 64 + r32) * ROWB + co), b1 = *(const bf16x8*)(Bs + (wc * 64 + 32 + r32) * ROWB + co);
      acc[0][0] = __builtin_amdgcn_mfma_f32_32x32x16_bf16(a0, b0, acc[0][0], 0, 0, 0);
      acc[0][1] = __builtin_amdgcn_mfma_f32_32x32x16_bf16(a0, b1, acc[0][1], 0, 0, 0);
      acc[1][0] = __builtin_amdgcn_mfma_f32_32x32x16_bf16(a1, b0, acc[1][0], 0, 0, 0);
      acc[1][1] = __builtin_amdgcn_mfma_f32_32x32x16_bf16(a1, b1, acc[1][1], 0, 0, 0);
    }
    if (ks + 1 < nk) {
      char* Aw = smem + ((ks + 1) & 1) * 2 * STG; char* Bw = Aw + STG;
#pragma unroll
      for (int i = 0; i < 4; ++i) { *(u32x4*)(Aw + soff + i * 32 * ROWB) = ra[i]; *(u32x4*)(Bw + soff + i * 32 * ROWB) = rb[i]; }
    }
    __syncthreads();
  }
  float* Ct = (float*)smem;
#pragma unroll
  for (int mi = 0; mi < 2; ++mi)
#pragma unroll
    for (int ni = 0; ni < 2; ++ni)
#pragma unroll
      for (int r = 0; r < 16; ++r) Ct[(wr * 64 + mi * 32 + crow(r, hi)) * CT_LD + wc * 64 + ni * 32 + r32] = acc[mi][ni][r];
  __syncthreads();
}
#endif

template <class AF, class BACC, class EPI>
DEVI void gemm_tile(const AF& af, const BACC& bacc, const bf16_t* Bt, int n0, int K, const EPI& epi, char* smem) {
#if GEMM_EXACT
  gemm_core_exact(af, bacc, n0, K, smem);
#else
  gemm_core_fast(af, Bt + (size_t)n0 * K, K, K, smem);
#endif
  epi((const float*)smem);
  __syncthreads();
}

#define EPI_LOOP for (int _i = 0, row = (threadIdx.x >> 5), c4 = (threadIdx.x & 31) * 4; _i < 16; ++_i, row += 8)

struct EpiProj { const Params* p; int tm, tn;
  DEVI void operator()(const float* Ct) const {
    char* ws = p->ws;
    EPI_LOOP {
      const int m = tm * 128 + row; const float4 v = *(const float4*)&Ct[row * CT_LD + c4];
      if (tn < 3) { st4((act_t*)(ws + OFF_QLAT) + (size_t)m * 384 + tn * 128 + c4, v.x, v.y, v.z, v.w);
        const float s = half_sum32(v.x * v.x + v.y * v.y + v.z * v.z + v.w * v.w); if ((threadIdx.x & 31) == 0) ((float*)(ws + OFF_SSQ))[(size_t)m * 4 + tn] = s; }
      else if (tn < 7) st4((act_t*)(ws + OFF_NAQ) + (size_t)m * 512 + (tn - 3) * 128 + c4, v.x * NASCALE, v.y * NASCALE, v.z * NASCALE, v.w * NASCALE);
      else if (tn < 9) { st4((act_t*)(ws + OFF_KVLAT) + (size_t)m * 256 + (tn - 7) * 128 + c4, v.x, v.y, v.z, v.w);
        const float s = half_sum32(v.x * v.x + v.y * v.y + v.z * v.z + v.w * v.w); if ((threadIdx.x & 31) == 0) ((float*)(ws + OFF_SSKV))[(size_t)m * 2 + tn - 7] = s; }
      else if (tn < 13) st4((act_t*)(ws + OFF_NAK) + (size_t)m * 512 + (tn - 9) * 128 + c4, v.x, v.y, v.z, v.w);
      else if (tn < 17) st4((act_t*)(ws + OFF_NAV) + (size_t)m * 512 + (tn - 13) * 128 + c4, v.x, v.y, v.z, v.w);
      else if (c4 < 32) {
        const int rb = m % RB; float o[4] = {v.x, v.y, v.z, v.w};
        if (rb >= CTXL) { const int pos = rb - CTXL, gr = pos >> 6, gc = pos & 63; const float* rc = (const float*)(ws + OFF_ROPE); const float* rs = rc + 128 * 8;
          const float vv[4] = {v.x, v.y, v.z, v.w};
#pragma unroll
          for (int e = 0; e < 4; ++e) { const int cc = c4 + e, i = cc & 15; const int pidx = (i < 8 ? gr : gc) * 8 + (i & 7); const float cs = rc[pidx], sn = rs[pidx];
            if (cc < 16) { const float x2 = Ct[row * CT_LD + cc + 16]; o[e] = vv[e] * cs - x2 * sn; } else { const float x1 = Ct[row * CT_LD + cc - 16]; o[e] = x1 * sn + vv[e] * cs; } } }
        st4((act_t*)(ws + OFF_KROPE) + (size_t)m * 32 + c4, o[0], o[1], o[2], o[3]);
      }
    }
  } };

struct EpiQm { const Params* p; int tm, tn;
  DEVI void operator()(const float* Ct) const {
    char* ws = p->ws; act_t* qm = (act_t*)p->out;
    EPI_LOOP {
      const int m = tm * 128 + row; const float* ss = (const float*)(ws + OFF_SSQ) + (size_t)m * 4;
      const float rstd = rsqrtf((ss[0] + ss[1] + ss[2]) * (1.f / 384.f) + EPS);
      const float4 v = *(const float4*)&Ct[row * CT_LD + c4]; const float vv[4] = {v.x, v.y, v.z, v.w}; float o[4];
      const int rb = m % RB; const int n0 = tn * 128 + c4; const int dh = n0 % 96;
      if (dh >= 64 && rb >= CTXL) { const int pos = rb - CTXL, gr = pos >> 6, gc = pos & 63; const float* rc = (const float*)(ws + OFF_ROPE); const float* rs = rc + 128 * 8;
#pragma unroll
        for (int e = 0; e < 4; ++e) { const int cc = dh - 64 + e, i = cc & 15; const int pidx = (i < 8 ? gr : gc) * 8 + (i & 7); const float cs = rc[pidx], sn = rs[pidx];
          if (cc < 16) { const float x2 = Ct[row * CT_LD + c4 + e + 16]; o[e] = (vv[e] * cs - x2 * sn) * rstd * QSCALE; } else { const float x1 = Ct[row * CT_LD + c4 + e - 16]; o[e] = (x1 * sn + vv[e] * cs) * rstd * QSCALE; } }
      } else {
#pragma unroll
        for (int e = 0; e < 4; ++e) o[e] = vv[e] * rstd * QSCALE; }
      st4(qm + (size_t)m * 768 + n0, o[0], o[1], o[2], o[3]);
    }
  } };

struct EpiKv { const Params* p; int tm, tn;
  DEVI void operator()(const float* Ct) const {
    char* ws = p->ws;
    EPI_LOOP {
      const int m = tm * 128 + row; const float* ss = (const float*)(ws + OFF_SSKV) + (size_t)m * 2;
      const float rstd = rsqrtf((ss[0] + ss[1]) * (1.f / 256.f) + EPS);
      const float4 v = *(const float4*)&Ct[row * CT_LD + c4];
      st4((act_t*)(ws + OFF_KV) + (size_t)m * 1024 + tn * 128 + c4, v.x * rstd, v.y * rstd, v.z * rstd, v.w * rstd);
    }
  } };

struct EpiOut { const Params* p; int tm, tn;
  DEVI void operator()(const float* Ct) const {
    const float* mod = (const float*)(p->ws + OFF_MOD);
    EPI_LOOP {
      const int tok = tm * 128 + row, b = tok >> 13, n = tn * 128 + c4;
      const float4 v = *(const float4*)&Ct[row * CT_LD + c4]; const float4 xx = *(const float4*)(p->x + (size_t)tok * 1024 + n); const float4 g = *(const float4*)(mod + b * 6144 + 2048 + n);
      *(float4*)(p->out + (size_t)tok * 1024 + n) = make_float4(xx.x + g.x * v.x, xx.y + g.y * v.y, xx.z + g.z * v.z, xx.w + g.w * v.w);
    }
  } };

struct EpiGU { const Params* p; int e, slot0, cnt, hrow0, tn;
  DEVI void operator()(const float* Ct) const {
    act_t* hid = (act_t*)(p->ws + OFF_HID); const float* ew = (const float*)(p->ws + OFF_EW) + (size_t)e * TT;
    EPI_LOOP {
      if ((c4 & 63) < 32) {
        const int slot = slot0 + row; const bool valid = slot < cnt; float o[4] = {0.f, 0.f, 0.f, 0.f};
        if (valid) { const float cw = ew[slot]; const float4 g = *(const float4*)&Ct[row * CT_LD + c4], u = *(const float4*)&Ct[row * CT_LD + c4 + 32];
          o[0] = silu_f(g.x) * u.x * cw; o[1] = silu_f(g.y) * u.y * cw; o[2] = silu_f(g.z) * u.z * cw; o[3] = silu_f(g.w) * u.w * cw; }
        st4(hid + (size_t)(hrow0 + row) * 512 + tn * 64 + (c4 >> 6) * 32 + (c4 & 31), o[0], o[1], o[2], o[3]);
      }
    }
  } };

struct EpiDown { const Params* p; int e, slot0, cnt, tn;
  DEVI void operator()(const float* Ct) const {
    act_t* yb = (act_t*)(p->ws + OFF_YBUF); const int* el = (const int*)(p->ws + OFF_ELIST) + (size_t)e * TT;
    EPI_LOOP {
      const int slot = slot0 + row;
      if (slot < cnt) { const int tk = el[slot]; const float4 v = *(const float4*)&Ct[row * CT_LD + c4];
        st4(yb + ((size_t)(tk & 1) * TT + (tk >> 1)) * 1024 + tn * 128 + c4, v.x, v.y, v.z, v.w); }
    }
  } };

DEVI void modgemv_item(const Params& p, int item, char* smem) {
  float* sc = (float*)smem; float* red = sc + 3072;
  const int t = threadIdx.x;
  __syncthreads();
  for (int i = t; i < 3072; i += 256) { const int ci = i >> 10, k = i & 1023; const float v = ci == 0 ? p.c[k] : ci == 1 ? p.c[1024 + k] : p.c_ctx[k]; sc[i] = silu_f(v); }
  __syncthreads();
  const int cc = t & 31, kg = t >> 5, col = item * 32 + cc;
  float a0 = 0.f, a1 = 0.f, a2 = 0.f;
#pragma unroll 16
  for (int k = kg; k < 1024; k += 8) { const float w = p.w_mod[(size_t)k * 6144 + col]; a0 = fmaf(sc[k], w, a0); a1 = fmaf(sc[1024 + k], w, a1); a2 = fmaf(sc[2048 + k], w, a2); }
  red[(kg * 32 + cc) * 3 + 0] = a0; red[(kg * 32 + cc) * 3 + 1] = a1; red[(kg * 32 + cc) * 3 + 2] = a2;
  __syncthreads();
  if (t < 96) { const int c2 = t & 31, ci = t >> 5; float s = 0.f;
#pragma unroll
    for (int g = 0; g < 8; ++g) s += red[(g * 32 + c2) * 3 + ci];
    ((float*)(p.ws + OFF_MOD))[ci * 6144 + item * 32 + c2] = s + p.b_mod[item * 32 + c2]; }
}

DEVI void misc_item(const Params& p) {
  const int t = threadIdx.x;
  if (t < 16) ((int*)(p.ws + OFF_CNT))[t] = 0;
  float* rc = (float*)(p.ws + OFF_ROPE); float* rs = rc + 1024;
  for (int i = t; i < 1024; i += 256) {
    const int pos = i >> 3, j = i & 7;
    double f = 1.0; for (int q = 0; q < j; ++q) f *= 0.31622776601683794;
    const double a = (double)pos * f; const double n = rint(a * 0.15915494309189535); const double r = a - n * 6.283185307179586477;
    const double r2 = r * r; double sn = r, cs = 1.0, ts = r, tc = 1.0;
    for (int q = 1; q <= 14; ++q) { tc *= -r2 / (double)((2 * q - 1) * (2 * q)); cs += tc; ts *= -r2 / (double)((2 * q) * (2 * q + 1)); sn += ts; }
    rc[i] = (float)cs; rs[i] = (float)sn;
  }
}

DEVI void bt_item(const Params& p, int item) {
  float* bt = (float*)(p.ws + OFF_BT) + (size_t)item * 4096;
  for (int i = threadIdx.x; i < 4096; i += 256) { const int kc = i >> 6, c = i & 63; int cs = c - 8; cs = cs < 0 ? 0 : (cs > 48 ? 48 : cs);
    bt[i] = (kc >= cs && kc < cs + 16) ? p.rel_bias[(size_t)item * 31 + (kc - c + 15)] * LOG2E : -1e30f; }
}

#if !MODE_EXACT
template <class ACC>
DEVI void conv_tile(const ACC& acc, bf16_t* dst, int K, int n0, int k0, char* smem) {
  float* tl = (float*)smem;
  const int t = threadIdx.x;
  __syncthreads();
#pragma unroll
  for (int i = 0; i < 16; ++i) { const int nn = t & 63, kk = (t >> 6) + 4 * i; tl[kk * 65 + nn] = acc.at(k0 + kk, n0 + nn); }
  __syncthreads();
  const int n = t >> 2, ks = (t & 3) * 16; unsigned w[8];
#pragma unroll
  for (int j = 0; j < 8; ++j) w[j] = pk2(tl[(ks + 2 * j) * 65 + n], tl[(ks + 2 * j + 1) * 65 + n]);
  uint4* d = (uint4*)(dst + (size_t)(n0 + n) * K + k0 + ks);
  d[0] = make_uint4(w[0], w[1], w[2], w[3]); d[1] = make_uint4(w[4], w[5], w[6], w[7]);
}
#endif

DEVI void phase_A(const Params& p, int bid, int nb, char* smem) {
  constexpr int N_MOD = 192, N_MISC = 1, N_BT = 120;
  constexpr int I0 = N_MOD + N_MISC + N_BT;
#if MODE_EXACT
  constexpr int NITEMS = I0;
#else
  constexpr int C_IN = (NPROJ / 64) * 16, C_UQ = 12 * 6, C_UKV = 16 * 4, C_OUT = 256, C_GU = 16 * 16 * 16, C_D = 16 * 16 * 8;
  constexpr int NITEMS = I0 + C_IN + C_UQ + C_UKV + C_OUT + C_GU + C_D;
#endif
  for (int it = bid; it < NITEMS; it += nb) {
    if (it < N_MOD) modgemv_item(p, it, smem);
    else if (it < N_MOD + N_MISC) misc_item(p);
    else if (it < I0) bt_item(p, it - N_MOD - N_MISC);
#if !MODE_EXACT
    else {
      int j = it - I0;
      if (j < C_IN) { WInAcc a{p.w_in}; conv_tile(a, (bf16_t*)(p.ws + OFF_WIN), 1024, (j >> 4) * 64, (j & 15) * 64, smem); continue; } j -= C_IN;
      if (j < C_UQ) { WUqAcc a{p.w_uq, p.g_q}; conv_tile(a, (bf16_t*)(p.ws + OFF_WUQ), 384, (j / 6) * 64, (j % 6) * 64, smem); continue; } j -= C_UQ;
      if (j < C_UKV) { WUkvAcc a{p.w_ukv, p.g_kv}; conv_tile(a, (bf16_t*)(p.ws + OFF_WUKV), 256, (j >> 2) * 64, (j & 3) * 64, smem); continue; } j -= C_UKV;
      if (j < C_OUT) { WOutAcc a{p.w_out}; conv_tile(a, (bf16_t*)(p.ws + OFF_WOUT), 1024, (j >> 4) * 64, (j & 15) * 64, smem); continue; } j -= C_OUT;
      if (j < C_GU) { const int e = j >> 8, r = j & 255; WGUAcc a{p.w_gate + (size_t)e * 1024 * 512, p.w_up + (size_t)e * 1024 * 512};
        conv_tile(a, (bf16_t*)(p.ws + OFF_WGU) + (size_t)e * 1024 * 1024, 1024, (r >> 4) * 64, (r & 15) * 64, smem); continue; } j -= C_GU;
      { const int e = j >> 7, r = j & 127; WDAcc a{p.w_down + (size_t)e * 512 * 1024};
        conv_tile(a, (bf16_t*)(p.ws + OFF_WD) + (size_t)e * 1024 * 512, 512, (r >> 3) * 64, (r & 7) * 64, smem); }
    }
#endif
  }
}

DEVI void phase_B(const Params& p, int bid, int nb) {
  const int lane = threadIdx.x & 63, wv = threadIdx.x >> 6;
  const float* mod = (const float*)(p.ws + OFF_MOD); act_t* hx = (act_t*)(p.ws + OFF_HXALL);
  for (int row = bid * 4 + wv; row < RR; row += nb * 4) {
    const int b = row / RB, rb = row - b * RB;
    const float* src = rb < CTXL ? p.ctx + (size_t)(b * CTXL + rb) * 1024 : p.x + (size_t)(b * SEQ + rb - CTXL) * 1024;
    const float* sh = mod + (rb < CTXL ? 2 : b) * 6144; const float* sc = sh + 1024;
    float4 v[4]; float ss = 0.f;
#pragma unroll
    for (int i = 0; i < 4; ++i) { v[i] = *(const float4*)(src + lane * 4 + 256 * i); ss += v[i].x * v[i].x + v[i].y * v[i].y + v[i].z * v[i].z + v[i].w * v[i].w; }
    ss = wave_sum(ss); const float rstd = rsqrtf(ss * (1.f / 1024.f) + EPS);
#pragma unroll
    for (int i = 0; i < 4; ++i) { const int k = lane * 4 + 256 * i; const float4 g = *(const float4*)(p.g_attn + k), s1 = *(const float4*)(sc + k), s0 = *(const float4*)(sh + k);
      st4(hx + (size_t)row * 1024 + k, v[i].x * rstd * g.x * (1.f + s1.x) + s0.x, v[i].y * rstd * g.y * (1.f + s1.y) + s0.y, v[i].z * rstd * g.z * (1.f + s1.z) + s0.z, v[i].w * rstd * g.w * (1.f + s1.w) + s0.w); }
  }
}

DEVI void phase_C(const Params& p, int bid, int nb, char* smem) {
  constexpr int U = 132 * 18; const int iters = xcd_iters(U, nb);
  for (int it = 0; it < iters; ++it) { const int u = xcd_unit(bid + it * nb, U); if (u < 0) continue;
    const int tm = u / 18, tn = u % 18;
    ARows af{(const act_t*)(p.ws + OFF_HXALL) + (size_t)tm * 128 * 1024, 1024}; WInAcc ba{p.w_in}; EpiProj epi{&p, tm, tn};
    gemm_tile(af, ba, (const bf16_t*)(p.ws + OFF_WIN), tn * 128, 1024, epi, smem); }
}
DEVI void phase_D(const Params& p, int bid, int nb, char* smem) {
  constexpr int UQ = 132 * 6, UK = 132 * 8, U = UQ + UK; const int iters = xcd_iters(U, nb);
  for (int it = 0; it < iters; ++it) { const int u = xcd_unit(bid + it * nb, U); if (u < 0) continue;
    if (u < UQ) { const int tm = u / 6, tn = u % 6; if ((tm % 66) < 2) continue;
      ARows af{(const act_t*)(p.ws + OFF_QLAT) + (size_t)tm * 128 * 384, 384}; WUqAcc ba{p.w_uq, p.g_q}; EpiQm epi{&p, tm, tn};
      gemm_tile(af, ba, (const bf16_t*)(p.ws + OFF_WUQ), tn * 128, 384, epi, smem); }
    else { const int v = u - UQ, tm = v >> 3, tn = v & 7;
      ARows af{(const act_t*)(p.ws + OFF_KVLAT) + (size_t)tm * 128 * 256, 256}; WUkvAcc ba{p.w_ukv, p.g_kv}; EpiKv epi{&p, tm, tn};
      gemm_tile(af, ba, (const bf16_t*)(p.ws + OFF_WUKV), tn * 128, 256, epi, smem); } }
}

template <typename TA, bool NA>
DEVI void attn_exact_unit(const Params& p, int unit, int lane) {
  constexpr int DQK = NA ? 64 : 96, DH = DQK / 2;
  const int r32 = lane & 31, kk = lane >> 5;
  const char* ws = p.ws;
  int b, h, q0, grow = 0, wstart = 0, qb = 0;
  if (NA) { qb = unit & 1; h = (unit >> 1) & 7; grow = (unit >> 4) & 127; b = unit >> 11; q0 = grow * 64 + qb * 32; wstart = grow - 4; wstart = wstart < 0 ? 0 : (wstart > 120 ? 120 : wstart); }
  else { q0 = (unit & 255) * 32; h = (unit >> 8) & 7; b = unit >> 11; }
  const size_t qrow = (size_t)b * RB + CTXL + q0 + r32;
  float q[DH];
  if (NA) { const TA* qp = (const TA*)(ws + OFF_NAQ) + qrow * 512 + h * 64 + kk * DH;
#pragma unroll
    for (int s = 0; s < DH; s += 4) { float v[4]; ld4(qp + s, v); q[s] = v[0]; q[s + 1] = v[1]; q[s + 2] = v[2]; q[s + 3] = v[3]; } }
  else { const TA* qp = (const TA*)p.out + qrow * 768 + h * 96 + kk * DH;
#pragma unroll
    for (int s = 0; s < DH; s += 4) { float v[4]; ld4(qp + s, v); q[s] = v[0]; q[s + 1] = v[1]; q[s + 2] = v[2]; q[s + 3] = v[3]; } }
  f32x16 o0, o1;
#pragma unroll
  for (int r = 0; r < 16; ++r) { o0[r] = 0.f; o1[r] = 0.f; }
  float m = -1e30f, l = 0.f;
  const int ntiles = NA ? 24 : RB / 32;
  for (int j = 0; j < ntiles; ++j) {
    size_t krow0; const float* bt = nullptr;
    if (NA) { if (j < 16) { const int jr = j >> 1, kb = j & 1, kr = wstart + jr; krow0 = (size_t)b * RB + CTXL + kr * 64 + kb * 32;
                bt = (const float*)(ws + OFF_BT) + ((size_t)(h * 15 + (kr - grow + 7)) * 64 + kb * 32) * 64 + qb * 32 + r32; }
              else krow0 = (size_t)b * RB + (j - 16) * 32; }
    else krow0 = (size_t)b * RB + j * 32;
    float kf[DH];
    if (NA) { const TA* kp = (const TA*)(ws + OFF_NAK) + (krow0 + r32) * 512 + h * 64 + kk * DH;
#pragma unroll
      for (int s = 0; s < DH; s += 4) { float v[4]; ld4(kp + s, v); kf[s] = v[0]; kf[s + 1] = v[1]; kf[s + 2] = v[2]; kf[s + 3] = v[3]; } }
    else { const TA* kp = (const TA*)(ws + OFF_KV) + (krow0 + r32) * 1024 + h * 128; const TA* rp = (const TA*)(ws + OFF_KROPE) + (krow0 + r32) * 32;
#pragma unroll
      for (int s = 0; s < DH; s += 4) { const int d = kk * DH + s; float v[4]; if (d < 64) ld4(kp + d, v); else ld4(rp + d - 64, v); kf[s] = v[0]; kf[s + 1] = v[1]; kf[s + 2] = v[2]; kf[s + 3] = v[3]; } }
    f32x16 sa;
#pragma unroll
    for (int r = 0; r < 16; ++r) sa[r] = 0.f;
#pragma unroll
    for (int s = 0; s < DH; ++s) sa = __builtin_amdgcn_mfma_f32_32x32x2f32(kf[s], q[s], sa, 0, 0, 0);
    if (NA && j < 16) {
#pragma unroll
      for (int r = 0; r < 16; ++r) sa[r] += bt[crow(r, kk) * 64]; }
    float mx = sa[0];
#pragma unroll
    for (int r = 1; r < 16; ++r) mx = fmaxf(mx, sa[r]);
    mx = xhalf_max(mx);
    const float mn = fmaxf(m, mx), alpha = exp2f(m - mn); m = mn;
    float ps = 0.f;
#pragma unroll
    for (int r = 0; r < 16; ++r) { sa[r] = exp2f(sa[r] - mn); ps += sa[r]; }
    ps = xhalf_sum(ps); l = l * alpha + ps;
#pragma unroll
    for (int r = 0; r < 16; ++r) { o0[r] *= alpha; o1[r] *= alpha; }
    const TA* vp = NA ? (const TA*)(ws + OFF_NAV) + krow0 * 512 + h * 64 + r32 : (const TA*)(ws + OFF_KV) + krow0 * 1024 + h * 128 + 64 + r32;
    const size_t vld = NA ? 512 : 1024;
#pragma unroll
    for (int s = 0; s < 16; ++s) { const int key = crow(s, kk);
      const float v0 = a2f(vp[(size_t)key * vld]), v1 = a2f(vp[(size_t)key * vld + 32]);
      o0 = __builtin_amdgcn_mfma_f32_32x32x2f32(v0, sa[s], o0, 0, 0, 0);
      o1 = __builtin_amdgcn_mfma_f32_32x32x2f32(v1, sa[s], o1, 0, 0, 0); }
  }
  const float rl = 1.f / l;
  act_t* op = (act_t*)(ws + OFF_ATTN) + ((size_t)b * SEQ + q0 + r32) * 1024 + (NA ? 512 : 0) + h * 64;
#pragma unroll
  for (int g = 0; g < 4; ++g) {
    st4(op + 8 * g + 4 * kk, o0[4 * g] * rl, o0[4 * g + 1] * rl, o0[4 * g + 2] * rl, o0[4 * g + 3] * rl);
    st4(op + 32 + 8 * g + 4 * kk, o1[4 * g] * rl, o1[4 * g + 1] * rl, o1[4 * g + 2] * rl, o1[4 * g + 3] * rl); }
}

DEVI void phase_E_exact(const Params& p, int bid, int nb) {
  const int lane = threadIdx.x & 63, wv = threadIdx.x >> 6;
  constexpr int UM = NBATCH * 8 * 256, UN = NBATCH * 128 * 8 * 2;
  for (int u = bid * 4 + wv; u < UM; u += nb * 4) attn_exact_unit<act_t, false>(p, u, lane);
  for (int u = bid * 4 + wv; u < UN; u += nb * 4) attn_exact_unit<act_t, true>(p, u, lane);
}

#if !MODE_EXACT
typedef s16x4 __attribute__((address_space(3))) las_s16x4;
DEVI bf16x8 pack8(const f32x16& s, int base) {
  u32x4 w = {pk2(s[base], s[base + 1]), pk2(s[base + 2], s[base + 3]), pk2(s[base + 4], s[base + 5]), pk2(s[base + 6], s[base + 7])};
  return __builtin_bit_cast(bf16x8, w);
}
DEVI bf16x8 tr_pair(const char* p) {
  const s16x4 lo = __builtin_amdgcn_ds_read_tr16_b64_v4i16((las_s16x4*)(p));
  const s16x4 hh = __builtin_amdgcn_ds_read_tr16_b64_v4i16((las_s16x4*)(p + 8 * 64));
  return (bf16x8){lo[0], lo[1], lo[2], lo[3], hh[0], hh[1], hh[2], hh[3]};
}
template <int DQK, bool BIAS>
DEVI void flash_tile(const char* Ks, const char* Vs, const bf16x8 (&qf)[DQK / 16], f32x16& o0, f32x16& o1, float& m, float& l, const float* bt, int r32, int hi, int vb) {
  constexpr int KROW = DQK * 2 + 16;
  f32x16 s0, s1;
#pragma unroll
  for (int r = 0; r < 16; ++r) { s0[r] = 0.f; s1[r] = 0.f; }
#pragma unroll
  for (int s = 0; s < DQK / 16; ++s) {
    const bf16x8 k0 = *(const bf16x8*)(Ks + r32 * KROW + (16 * s + 8 * hi) * 2);
    const bf16x8 k1 = *(const bf16x8*)(Ks + (32 + r32) * KROW + (16 * s + 8 * hi) * 2);
    s0 = __builtin_amdgcn_mfma_f32_32x32x16_bf16(k0, qf[s], s0, 0, 0, 0);
    s1 = __builtin_amdgcn_mfma_f32_32x32x16_bf16(k1, qf[s], s1, 0, 0, 0);
  }
  if (BIAS) {
#pragma unroll
    for (int r = 0; r < 16; ++r) { s0[r] += bt[crow(r, hi) * 64]; s1[r] += bt[(32 + crow(r, hi)) * 64]; }
  }
  float mx = fmaxf(s0[0], s1[0]);
#pragma unroll
  for (int r = 1; r < 16; ++r) mx = fmaxf(mx, fmaxf(s0[r], s1[r]));
  mx = xhalf_max(mx);
  const float mn = fmaxf(m, mx), alpha = __builtin_amdgcn_exp2f(m - mn); m = mn;
  float ps = 0.f;
#pragma unroll
  for (int r = 0; r < 16; ++r) { s0[r] = __builtin_amdgcn_exp2f(s0[r] - mn); s1[r] = __builtin_amdgcn_exp2f(s1[r] - mn); ps += s0[r] + s1[r]; }
  ps = xhalf_sum(ps); l = l * alpha + ps;
#pragma unroll
  for (int r = 0; r < 16; ++r) { o0[r] *= alpha; o1[r] *= alpha; }
  const bf16x8 p00 = pack8(s0, 0), p01 = pack8(s0, 8), p10 = pack8(s1, 0), p11 = pack8(s1, 8);
  const char* v0 = Vs + vb; const char* v1 = Vs + 4096 + vb;
  o0 = __builtin_amdgcn_mfma_f32_32x32x16_bf16(tr_pair(v0), p00, o0, 0, 0, 0);
  o0 = __builtin_amdgcn_mfma_f32_32x32x16_bf16(tr_pair(v0 + 16 * 64), p01, o0, 0, 0, 0);
  o0 = __builtin_amdgcn_mfma_f32_32x32x16_bf16(tr_pair(v0 + 32 * 64), p10, o0, 0, 0, 0);
  o0 = __builtin_amdgcn_mfma_f32_32x32x16_bf16(tr_pair(v0 + 48 * 64), p11, o0, 0, 0, 0);
  o1 = __builtin_amdgcn_mfma_f32_32x32x16_bf16(tr_pair(v1), p00, o1, 0, 0, 0);
  o1 = __builtin_amdgcn_mfma_f32_32x32x16_bf16(tr_pair(v1 + 16 * 64), p01, o1, 0, 0, 0);
  o1 = __builtin_amdgcn_mfma_f32_32x32x16_bf16(tr_pair(v1 + 32 * 64), p10, o1, 0, 0, 0);
  o1 = __builtin_amdgcn_mfma_f32_32x32x16_bf16(tr_pair(v1 + 48 * 64), p11, o1, 0, 0, 0);
}
DEVI void flash_store(bf16_t* op, const f32x16& o0, const f32x16& o1, float l, int hi) {
  const float rl = 1.f / l;
#pragma unroll
  for (int g = 0; g < 4; ++g) {
    st4(op + 8 * g + 4 * hi, o0[4 * g] * rl, o0[4 * g + 1] * rl, o0[4 * g + 2] * rl, o0[4 * g + 3] * rl);
    st4(op + 32 + 8 * g + 4 * hi, o1[4 * g] * rl, o1[4 * g + 1] * rl, o1[4 * g + 2] * rl, o1[4 * g + 3] * rl); }
}

DEVI void mla_unit(const Params& p, int unit, char* smem) {
  constexpr int KROW = 208, KBYTES = 64 * KROW  , STAGE = KBYTES + 8192  ;
  const int t = threadIdx.x, lane = t & 63, w = t >> 6, r32 = lane & 31, hi = lane >> 5;
  const int qblk = unit & 63, h = (unit >> 6) & 7, b = unit >> 9;
  const char* ws = p.ws;
  const bf16_t* kvb = (const bf16_t*)(ws + OFF_KV) + (size_t)b * RB * 1024 + h * 128;
  const bf16_t* krb = (const bf16_t*)(ws + OFF_KROPE) + (size_t)b * RB * 32;
  const size_t qrow = (size_t)b * RB + CTXL + qblk * 128 + w * 32 + r32;
  bf16x8 qf[6];
  { const bf16_t* qp = (const bf16_t*)p.out + qrow * 768 + h * 96 + hi * 8;
#pragma unroll
    for (int s = 0; s < 6; ++s) qf[s] = *(const bf16x8*)(qp + 16 * s); }
  const bf16_t* gsrc[5]; int ldst[5]; int gstep[5];
#pragma unroll
  for (int i = 0; i < 3; ++i) { const int c = t + 256 * i, key = c / 12, ch = c - key * 12;
    if (ch < 8) { gsrc[i] = kvb + (size_t)key * 1024 + ch * 8; gstep[i] = 64 * 1024; } else { gsrc[i] = krb + (size_t)key * 32 + (ch - 8) * 8; gstep[i] = 64 * 32; }
    ldst[i] = key * KROW + ch * 16; }
#pragma unroll
  for (int i = 0; i < 2; ++i) { const int c = t + 256 * i, key = c >> 3, ch = c & 7;
    gsrc[3 + i] = kvb + (size_t)key * 1024 + 64 + ch * 8; gstep[3 + i] = 64 * 1024; ldst[3 + i] = KBYTES + (ch >> 2) * 4096 + key * 64 + (ch & 3) * 16; }
  const int vb = (((lane & 15) >> 2) + 4 * hi) * 64 + (16 * ((lane >> 4) & 1) + 4 * (lane & 3)) * 2;
  f32x16 o0, o1;
#pragma unroll
  for (int r = 0; r < 16; ++r) { o0[r] = 0.f; o1[r] = 0.f; }
  float m = -1e30f, l = 0.f;
  constexpr int NT = RB / 64;
  u32x4 rg[5];
#pragma unroll
  for (int i = 0; i < 5; ++i) rg[i] = *(const u32x4*)(gsrc[i]);
  __syncthreads();
#pragma unroll
  for (int i = 0; i < 5; ++i) *(u32x4*)(smem + ldst[i]) = rg[i];
  __syncthreads();
  for (int j = 0; j < NT; ++j) {
    const char* st = smem + (j & 1) * STAGE;
    if (j + 1 < NT) {
#pragma unroll
      for (int i = 0; i < 5; ++i) rg[i] = *(const u32x4*)(gsrc[i] + (size_t)(j + 1) * gstep[i]);
    }
    flash_tile<96, false>(st, st + KBYTES, qf, o0, o1, m, l, nullptr, r32, hi, vb);
    if (j + 1 < NT) { char* sw = smem + ((j + 1) & 1) * STAGE;
#pragma unroll
      for (int i = 0; i < 5; ++i) *(u32x4*)(sw + ldst[i]) = rg[i]; }
    __syncthreads();
  }
  flash_store((bf16_t*)(ws + OFF_ATTN) + ((size_t)b * SEQ + qblk * 128 + w * 32 + r32) * 1024 + h * 64, o0, o1, l, hi);
}

DEVI void na_unit(const Params& p, int unit, char* smem) {
  constexpr int KROW = 144, KBYTES = 64 * KROW  , HSTR = KBYTES + 8192  , STAGE = 2 * HSTR  ;
  const int t = threadIdx.x, lane = t & 63, w = t >> 6, r32 = lane & 31, hi = lane >> 5;
  const int hp = unit & 3, grow = (unit >> 2) & 127, b = unit >> 9;
  const int hh = w >> 1, qb = w & 1, head = hp * 2 + hh, c = qb * 32 + r32;
  int wstart = grow - 4; wstart = wstart < 0 ? 0 : (wstart > 120 ? 120 : wstart);
  const char* ws = p.ws;
  const bf16_t* nak = (const bf16_t*)(ws + OFF_NAK) + (size_t)b * RB * 512 + hp * 128;
  const bf16_t* nav = (const bf16_t*)(ws + OFF_NAV) + (size_t)b * RB * 512 + hp * 128;
  bf16x8 qf[4];
  { const bf16_t* qp = (const bf16_t*)(ws + OFF_NAQ) + ((size_t)b * RB + CTXL + grow * 64 + c) * 512 + head * 64 + hi * 8;
#pragma unroll
    for (int s = 0; s < 4; ++s) qf[s] = *(const bf16x8*)(qp + 16 * s); }
  int goff[4], kdst[4], vdst[4];
#pragma unroll
  for (int i = 0; i < 4; ++i) { const int h2 = i >> 1, key = (t >> 3) + 32 * (i & 1), ch = t & 7;
    goff[i] = key * 512 + h2 * 64 + ch * 8; kdst[i] = h2 * HSTR + key * KROW + ch * 16; vdst[i] = h2 * HSTR + KBYTES + (ch >> 2) * 4096 + key * 64 + (ch & 3) * 16; }
  const int vb = (((lane & 15) >> 2) + 4 * hi) * 64 + (16 * ((lane >> 4) & 1) + 4 * (lane & 3)) * 2;
  f32x16 o0, o1;
#pragma unroll
  for (int r = 0; r < 16; ++r) { o0[r] = 0.f; o1[r] = 0.f; }
  float m = -1e30f, l = 0.f;
  const float* btb = (const float*)(ws + OFF_BT) + (size_t)(head * 15) * 4096 + c;
  u32x4 rk[4], rv[4];
  auto rowbase = [&](int j) -> size_t { return j < 8 ? (size_t)CTXL + (size_t)(wstart + j) * 64 : (size_t)(j - 8) * 64; };
  { const size_t rb0 = rowbase(0) * 512;
#pragma unroll
    for (int i = 0; i < 4; ++i) { rk[i] = *(const u32x4*)(nak + rb0 + goff[i]); rv[i] = *(const u32x4*)(nav + rb0 + goff[i]); } }
  __syncthreads();
#pragma unroll
  for (int i = 0; i < 4; ++i) { *(u32x4*)(smem + kdst[i]) = rk[i]; *(u32x4*)(smem + vdst[i]) = rv[i]; }
  __syncthreads();
  for (int j = 0; j < 12; ++j) {
    const char* st = smem + (j & 1) * STAGE + hh * HSTR;
    if (j + 1 < 12) { const size_t rb1 = rowbase(j + 1) * 512;
#pragma unroll
      for (int i = 0; i < 4; ++i) { rk[i] = *(const u32x4*)(nak + rb1 + goff[i]); rv[i] = *(const u32x4*)(nav + rb1 + goff[i]); } }
    if (j < 8) flash_tile<64, true>(st, st + KBYTES, qf, o0, o1, m, l, btb + (size_t)(wstart + j - grow + 7) * 4096, r32, hi, vb);
    else flash_tile<64, false>(st, st + KBYTES, qf, o0, o1, m, l, nullptr, r32, hi, vb);
    if (j + 1 < 12) { char* sw = smem + ((j + 1) & 1) * STAGE;
#pragma unroll
      for (int i = 0; i < 4; ++i) { *(u32x4*)(sw + kdst[i]) = rk[i]; *(u32x4*)(sw + vdst[i]) = rv[i]; } }
    __syncthreads();
  }
  flash_store((bf16_t*)(ws + OFF_ATTN) + ((size_t)b * SEQ + grow * 64 + c) * 1024 + 512 + head * 64, o0, o1, l, hi);
}

DEVI void phase_E_fast(const Params& p, int bid, int nb, char* smem) {
  constexpr int UM = NBATCH * 8 * 64, UN = NBATCH * 128 * 4;
  { const int iters = xcd_iters(UM, nb);
    for (int it = 0; it < iters; ++it) { const int u = xcd_unit(bid + it * nb, UM); if (u >= 0) mla_unit(p, u, smem); } }
  { const int iters = xcd_iters(UN, nb);
    for (int it = 0; it < iters; ++it) { const int u = xcd_unit(bid + it * nb, UN); if (u >= 0) na_unit(p, u, smem); } }
}
#endif

DEVI void phase_F(const Params& p, int bid, int nb, char* smem) {
  constexpr int U = 128 * 8; const int iters = xcd_iters(U, nb);
  for (int it = 0; it < iters; ++it) { const int u = xcd_unit(bid + it * nb, U); if (u < 0) continue;
    const int tm = u >> 3, tn = u & 7;
    ARows af{(const act_t*)(p.ws + OFF_ATTN) + (size_t)tm * 128 * 1024, 1024}; WOutAcc ba{p.w_out}; EpiOut epi{&p, tm, tn};
    gemm_tile(af, ba, (const bf16_t*)(p.ws + OFF_WOUT), tn * 128, 1024, epi, smem); }
}

DEVI void phase_G(const Params& p, int bid, int nb, char* smem) {
  const int t = threadIdx.x, lane = t & 63, wv = t >> 6;
  int* te = (int*)smem; float* tw = (float*)(smem + 256);
  const float* mod = (const float*)(p.ws + OFF_MOD); act_t* hx2 = (act_t*)(p.ws + OFF_HX2);
  int* cnt = (int*)(p.ws + OFF_CNT); int* elist = (int*)(p.ws + OFF_ELIST); float* ewt = (float*)(p.ws + OFF_EW);
  for (int ch = bid; ch < TT / 32; ch += nb) {
    __syncthreads();
    for (int q = 0; q < 8; ++q) {
      const int tl = wv * 8 + q, tok = ch * 32 + tl, b = tok >> 13;
      const float* src = p.out + (size_t)tok * 1024; const float* sh = mod + b * 6144 + 3072; const float* sc = sh + 1024;
      float4 v[4]; float ss = 0.f;
#pragma unroll
      for (int i = 0; i < 4; ++i) { v[i] = *(const float4*)(src + lane * 4 + 256 * i); ss += v[i].x * v[i].x + v[i].y * v[i].y + v[i].z * v[i].z + v[i].w * v[i].w; }
      ss = wave_sum(ss); const float rstd = rsqrtf(ss * (1.f / 1024.f) + EPS);
      float lg[20];
#pragma unroll
      for (int j = 0; j < 20; ++j) lg[j] = 0.f;
#pragma unroll
      for (int i = 0; i < 4; ++i) { const int k = lane * 4 + 256 * i; const float4 g = *(const float4*)(p.g_ffn + k), s1 = *(const float4*)(sc + k), s0 = *(const float4*)(sh + k);
        const float hv[4] = {v[i].x * rstd * g.x * (1.f + s1.x) + s0.x, v[i].y * rstd * g.y * (1.f + s1.y) + s0.y, v[i].z * rstd * g.z * (1.f + s1.z) + s0.z, v[i].w * rstd * g.w * (1.f + s1.w) + s0.w};
        st4(hx2 + (size_t)tok * 1024 + k, hv[0], hv[1], hv[2], hv[3]);
#pragma unroll
        for (int e = 0; e < 4; ++e) { const float4 wg = *(const float4*)(p.w_rg + (size_t)(k + e) * 4);
          lg[0] = fmaf(hv[e], wg.x, lg[0]); lg[1] = fmaf(hv[e], wg.y, lg[1]); lg[2] = fmaf(hv[e], wg.z, lg[2]); lg[3] = fmaf(hv[e], wg.w, lg[3]);
#pragma unroll
          for (int qq = 0; qq < 4; ++qq) { const float4 we = *(const float4*)(p.w_re + (size_t)(k + e) * 16 + qq * 4);
            lg[4 + qq * 4] = fmaf(hv[e], we.x, lg[4 + qq * 4]); lg[5 + qq * 4] = fmaf(hv[e], we.y, lg[5 + qq * 4]); lg[6 + qq * 4] = fmaf(hv[e], we.z, lg[6 + qq * 4]); lg[7 + qq * 4] = fmaf(hv[e], we.w, lg[7 + qq * 4]); } } }
#pragma unroll
      for (int j = 0; j < 20; ++j) lg[j] = wave_sum(lg[j]);
#pragma unroll
      for (int j = 0; j < 4; ++j) lg[j] += p.b_rg[j];
#pragma unroll
      for (int j = 0; j < 16; ++j) lg[4 + j] += p.b_re[j];
      int gs = 0; float gm = lg[0];
#pragma unroll
      for (int j = 1; j < 4; ++j) if (lg[j] > gm) { gm = lg[j]; gs = j; }
      float z = 0.f;
#pragma unroll
      for (int j = 0; j < 4; ++j) z += expf(lg[j] - gm);
      const float gw = 1.f / z;
      float e4[4];
#pragma unroll
      for (int j = 0; j < 4; ++j) e4[j] = gs == 0 ? lg[4 + j] : gs == 1 ? lg[8 + j] : gs == 2 ? lg[12 + j] : lg[16 + j];
      int i1 = 0; float m1 = e4[0];
#pragma unroll
      for (int j = 1; j < 4; ++j) if (e4[j] > m1) { m1 = e4[j]; i1 = j; }
      int i2 = -1; float m2 = -3.0e38f;
#pragma unroll
      for (int j = 0; j < 4; ++j) if (j != i1 && e4[j] > m2) { m2 = e4[j]; i2 = j; }
      const float ex = expf(m2 - m1), w1 = 1.f / (1.f + ex), w2 = ex / (1.f + ex);
      if (lane == 0) { te[tl * 2] = gs * 4 + i1; te[tl * 2 + 1] = gs * 4 + i2; tw[tl * 2] = gw * w1; tw[tl * 2 + 1] = gw * w2; }
    }
    __syncthreads();
    if (t < 16) { int n = 0; for (int i = 0; i < 64; ++i) n += (te[i] == t) ? 1 : 0;
      if (n) { const int base = atomicAdd(&cnt[t], n); int r = 0;
        for (int i = 0; i < 64; ++i) if (te[i] == t) { const int slot = base + r; ++r; elist[(size_t)t * TT + slot] = (ch * 32 + (i >> 1)) * 2 + (i & 1); ewt[(size_t)t * TT + slot] = tw[i]; } } }
  }
}

DEVI bool moe_tile(const Params& p, int mt, int& e, int& mi, int& cnt_e, int& hrow0) {
  const int* cnt = (const int*)(p.ws + OFF_CNT); int acc = 0;
  for (int i = 0; i < 16; ++i) { const int c = cnt[i], nt = (c + 127) >> 7; if (mt < acc + nt) { e = i; mi = mt - acc; cnt_e = c; hrow0 = (acc + mi) * 128; return true; } acc += nt; }
  return false;
}
DEVI int moe_mtiles(const Params& p) { const int* cnt = (const int*)(p.ws + OFF_CNT); int acc = 0; for (int i = 0; i < 16; ++i) acc += (cnt[i] + 127) >> 7; return acc; }

DEVI void phase_H(const Params& p, int bid, int nb, char* smem) {
  const int U = moe_mtiles(p) * 8; const int iters = xcd_iters(U, nb);
  for (int it = 0; it < iters; ++it) { const int u = xcd_unit(bid + it * nb, U); if (u < 0) continue;
    int e, mi, ce, hr; if (!moe_tile(p, u >> 3, e, mi, ce, hr)) continue; const int tn = u & 7;
    AGather af{(const act_t*)(p.ws + OFF_HX2), (const int*)(p.ws + OFF_ELIST) + (size_t)e * TT, ce, mi * 128};
    WGUAcc ba{p.w_gate + (size_t)e * 1024 * 512, p.w_up + (size_t)e * 1024 * 512}; EpiGU epi{&p, e, mi * 128, ce, hr, tn};
    gemm_tile(af, ba, (const bf16_t*)(p.ws + OFF_WGU) + (size_t)e * 1024 * 1024, tn * 128, 1024, epi, smem); }
}
DEVI void phase_I(const Params& p, int bid, int nb, char* smem) {
  const int U = moe_mtiles(p) * 8; const int iters = xcd_iters(U, nb);
  for (int it = 0; it < iters; ++it) { const int u = xcd_unit(bid + it * nb, U); if (u < 0) continue;
    int e, mi, ce, hr; if (!moe_tile(p, u >> 3, e, mi, ce, hr)) continue; const int tn = u & 7;
    ARows af{(const act_t*)(p.ws + OFF_HID) + (size_t)hr * 512, 512}; WDAcc ba{p.w_down + (size_t)e * 512 * 1024}; EpiDown epi{&p, e, mi * 128, ce, tn};
    gemm_tile(af, ba, (const bf16_t*)(p.ws + OFF_WD) + (size_t)e * 1024 * 512, tn * 128, 512, epi, smem); }
}

DEVI void phase_J(const Params& p, int bid, int nb) {
  const int lane = threadIdx.x & 63, wv = threadIdx.x >> 6;
  const float* mod = (const float*)(p.ws + OFF_MOD); const act_t* yb = (const act_t*)(p.ws + OFF_YBUF);
  for (int tok = bid * 4 + wv; tok < TT; tok += nb * 4) {
    const int b = tok >> 13; float* xo = p.out + (size_t)tok * 1024; const float* g2 = mod + b * 6144 + 5120;
    float o[16]; float ss = 0.f;
#pragma unroll
    for (int i = 0; i < 4; ++i) { const int k = lane * 4 + 256 * i; const float4 xv = *(const float4*)(xo + k), g = *(const float4*)(g2 + k);
      float y0[4], y1[4]; ld4(yb + (size_t)tok * 1024 + k, y0); ld4(yb + ((size_t)TT + tok) * 1024 + k, y1);
      o[4 * i] = xv.x + g.x * (y0[0] + y1[0]); o[4 * i + 1] = xv.y + g.y * (y0[1] + y1[1]); o[4 * i + 2] = xv.z + g.z * (y0[2] + y1[2]); o[4 * i + 3] = xv.w + g.w * (y0[3] + y1[3]);
      ss += o[4 * i] * o[4 * i] + o[4 * i + 1] * o[4 * i + 1] + o[4 * i + 2] * o[4 * i + 2] + o[4 * i + 3] * o[4 * i + 3]; }
    ss = wave_sum(ss); const float rstd = rsqrtf(ss * (1.f / 1024.f) + EPS);
#pragma unroll
    for (int i = 0; i < 4; ++i) { const int k = lane * 4 + 256 * i; const float4 g = *(const float4*)(p.g_final + k);
      *(float4*)(xo + k) = make_float4(o[4 * i] * rstd * g.x, o[4 * i + 1] * rstd * g.y, o[4 * i + 2] * rstd * g.z, o[4 * i + 3] * rstd * g.w); }
  }
}

template <int PH>
__global__ void __launch_bounds__(NTHREADS, (PH == 4 && ATTN_EXACT) ? 1 : 2) phase_kernel(Params p) {
  __shared__ __attribute__((aligned(16))) char smem[LDS_BYTES];
  const int bid = blockIdx.x, nb = gridDim.x;
  if (PH == 0) phase_A(p, bid, nb, smem);
  if (PH == 1) phase_B(p, bid, nb);
  if (PH == 2) phase_C(p, bid, nb, smem);
  if (PH == 3) phase_D(p, bid, nb, smem);
#if ATTN_EXACT
  if (PH == 4) phase_E_exact(p, bid, nb);
#else
  if (PH == 4) phase_E_fast(p, bid, nb, smem);
#endif
  if (PH == 5) phase_F(p, bid, nb, smem);
  if (PH == 6) phase_G(p, bid, nb, smem);
  if (PH == 7) phase_H(p, bid, nb, smem);
  if (PH == 8) phase_I(p, bid, nb, smem);
  if (PH == 9) phase_J(p, bid, nb);
}

extern "C" void kernel_launch(void* const* d_in, const int* in_sizes, int n_in, void* d_out, int out_size, void* d_ws, size_t ws_size, hipStream_t stream) {
  if (n_in != 23 || out_size != TT * 1024 || ws_size < WS_NEED) { fprintf(stderr, "kernel_launch: unexpected shapes n_in %d out %d ws %zu (need %zu)\n", n_in, out_size, ws_size, (size_t)WS_NEED); return; }
  Params p{};
  const float** f = (const float**)&p;
  for (int i = 0; i < 23; ++i) f[i] = (const float*)d_in[i];
  p.out = (float*)d_out; p.ws = (char*)d_ws;
  const int G = 1024;
  hipLaunchKernelGGL(phase_kernel<0>, dim3(G), dim3(NTHREADS), 0, stream, p);
  hipLaunchKernelGGL(phase_kernel<1>, dim3(G), dim3(NTHREADS), 0, stream, p);
  hipLaunchKernelGGL(phase_kernel<2>, dim3(G), dim3(NTHREADS), 0, stream, p);
  hipLaunchKernelGGL(phase_kernel<3>, dim3(G), dim3(NTHREADS), 0, stream, p);
  hipLaunchKernelGGL(phase_kernel<4>, dim3(G), dim3(NTHREADS), 0, stream, p);
  hipLaunchKernelGGL(phase_kernel<5>, dim3(G), dim3(NTHREADS), 0, stream, p);
  hipLaunchKernelGGL(phase_kernel<6>, dim3(G), dim3(NTHREADS), 0, stream, p);
  hipLaunchKernelGGL(phase_kernel<7>, dim3(G), dim3(NTHREADS), 0, stream, p);
  hipLaunchKernelGGL(phase_kernel<8>, dim3(G), dim3(NTHREADS), 0, stream, p);
  hipLaunchKernelGGL(phase_kernel<9>, dim3(G), dim3(NTHREADS), 0, stream, p);
}
```

```cpp
#include <hip/hip_runtime.h>
#include <hip/hip_cooperative_groups.h>
#include <cstdio>
#include <cstdint>
namespace cg = cooperative_groups;

#ifndef MODE_EXACT
#define MODE_EXACT 0
#endif
#ifndef ONE_LAUNCH
#define ONE_LAUNCH 1
#endif
#ifndef ATTN_EXACT
#define ATTN_EXACT MODE_EXACT
#endif
#ifndef GEMM_EXACT
#define GEMM_EXACT MODE_EXACT
#endif

#define DEVI __device__ __forceinline__

typedef unsigned short bf16_t;
typedef short bf16x8 __attribute__((ext_vector_type(8)));
typedef short s16x4 __attribute__((ext_vector_type(4)));
typedef float f32x16 __attribute__((ext_vector_type(16)));
typedef float f32x4 __attribute__((ext_vector_type(4)));
typedef unsigned u32x4 __attribute__((ext_vector_type(4)));

#if MODE_EXACT
typedef float act_t;
#else
typedef bf16_t act_t;
#endif

constexpr int DM = 1024, NBATCH = 2, SEQ = 8192, CTXL = 256, RB = SEQ + CTXL  , RR = NBATCH * RB  , TT = NBATCH * SEQ  ;
constexpr int GW = 64, GROWS = 128;
constexpr int QL = 384, KVL = 256, NPROJ = 2304  , NPROJ_REAL = 2208;
constexpr int NEXP = 16, DEXP = 512;
constexpr float EPS = 1e-6f, LOG2E = 1.4426950408889634f;
constexpr float QSCALE = 0.10206207261596577f * 1.4426950408889634f;
constexpr float NASCALE = 0.125f * 1.4426950408889634f;
constexpr int HIDROWS = 34816;
constexpr int NTHREADS = 256;

constexpr size_t AS = sizeof(act_t);
constexpr size_t OFF_BAR   = 0;
constexpr size_t OFF_CNT   = 16384;
constexpr size_t OFF_MOD   = OFF_CNT + 256;
constexpr size_t OFF_ROPE  = OFF_MOD + 3 * 6144 * 4;
constexpr size_t OFF_SSQ   = OFF_ROPE + 2 * 128 * 8 * 4;
constexpr size_t OFF_SSKV  = OFF_SSQ + (size_t)RR * 4 * 4;
constexpr size_t OFF_BT    = OFF_SSKV + (size_t)RR * 2 * 4;
constexpr size_t OFF_ELIST = OFF_BT + (size_t)8 * 15 * 4096 * 4;
constexpr size_t OFF_EW    = OFF_ELIST + (size_t)NEXP * TT * 4;
constexpr size_t SMALL_END = OFF_EW + (size_t)NEXP * TT * 4;
static_assert(SMALL_END <= (size_t)8 << 20, "small region");
constexpr size_t OFF_W     = (size_t)8 << 20;
#if MODE_EXACT
constexpr size_t W_BYTES = 0;
#else
constexpr size_t W_BYTES = (size_t)60 << 20;
#endif
constexpr size_t OFF_WIN  = OFF_W;
constexpr size_t OFF_WUQ  = OFF_WIN + (size_t)NPROJ * 1024 * 2;
constexpr size_t OFF_WUKV = OFF_WUQ + (size_t)768 * 384 * 2;
constexpr size_t OFF_WOUT = OFF_WUKV + (size_t)1024 * 256 * 2;
constexpr size_t OFF_WGU  = OFF_WOUT + (size_t)1024 * 1024 * 2;
constexpr size_t OFF_WD   = OFF_WGU + (size_t)16 * 1024 * 1024 * 2;
constexpr size_t W_END    = OFF_WD + (size_t)16 * 1024 * 512 * 2;
static_assert(MODE_EXACT || W_END <= OFF_W + W_BYTES, "weights region");
constexpr size_t G0 = OFF_W + W_BYTES;
constexpr size_t OFF_HXALL = G0;
constexpr size_t OFF_KV    = OFF_HXALL;
constexpr size_t OFF_NAQ   = OFF_HXALL + (size_t)RR * 1024 * AS;
constexpr size_t OFF_NAK   = OFF_NAQ + (size_t)RR * 512 * AS;
constexpr size_t OFF_NAV   = OFF_NAK + (size_t)RR * 512 * AS;
constexpr size_t OFF_KROPE = OFF_NAV + (size_t)RR * 512 * AS;
constexpr size_t OFF_QLAT  = OFF_KROPE + (size_t)RR * 32 * AS;
constexpr size_t OFF_KVLAT = OFF_QLAT + (size_t)RR * 384 * AS;
constexpr size_t OFF_ATTN  = OFF_QLAT;
constexpr size_t ATT_END   = OFF_ATTN + (size_t)TT * 1024 * AS;
constexpr size_t OFF_YBUF  = G0;
constexpr size_t OFF_HX2   = G0;
constexpr size_t OFF_HID   = OFF_YBUF + (size_t)2 * TT * 1024 * AS;
constexpr size_t MOE_END   = OFF_HID + (size_t)HIDROWS * 512 * AS;
constexpr size_t WS_NEED   = ATT_END > MOE_END ? ATT_END : MOE_END;
static_assert(WS_NEED <= ((size_t)256 << 20), "workspace");

struct Params {
  const float *x, *c, *ctx, *c_ctx, *w_mod, *b_mod, *g_attn, *g_ffn, *w_in, *g_q, *g_kv, *w_uq, *w_ukv, *rel_bias, *w_out,
              *w_rg, *b_rg, *w_re, *b_re, *w_gate, *w_up, *w_down, *g_final;
  float* out; char* ws;
};

DEVI float bf2f(bf16_t v) { return __uint_as_float(((unsigned)v) << 16); }
DEVI bf16_t f2bf(float f) { unsigned u = __float_as_uint(f); u += 0x7fffu + ((u >> 16) & 1u); return (bf16_t)(u >> 16); }
typedef __bf16 bf16x2_t __attribute__((ext_vector_type(2)));
typedef float f32x2_t __attribute__((ext_vector_type(2)));
DEVI unsigned pk2(float lo, float hi) { const f32x2_t v = {lo, hi}; return __builtin_bit_cast(unsigned, __builtin_convertvector(v, bf16x2_t)); }
DEVI float a2f(float v) { return v; }
DEVI float a2f(bf16_t v) { return bf2f(v); }
DEVI void ld4(const float* p, float (&v)[4]) { const float4 t = *(const float4*)p; v[0] = t.x; v[1] = t.y; v[2] = t.z; v[3] = t.w; }
DEVI void ld4(const bf16_t* p, float (&v)[4]) { const uint2 t = *(const uint2*)p; v[0] = __uint_as_float(t.x << 16); v[1] = __uint_as_float(t.x & 0xffff0000u); v[2] = __uint_as_float(t.y << 16); v[3] = __uint_as_float(t.y & 0xffff0000u); }
DEVI void st4(float* p, float a, float b, float c, float d) { *(float4*)p = make_float4(a, b, c, d); }
DEVI void st4(bf16_t* p, float a, float b, float c, float d) { uint2 t; t.x = pk2(a, b); t.y = pk2(c, d); *(uint2*)p = t; }
DEVI void st1(float* p, float a) { *p = a; }
DEVI void st1(bf16_t* p, float a) { *p = f2bf(a); }
DEVI int crow(int r, int hi) { return (r & 3) + 8 * (r >> 2) + 4 * hi; }
DEVI float wave_sum(float v) { v += __shfl_xor(v, 32); v += __shfl_xor(v, 16); v += __shfl_xor(v, 8); v += __shfl_xor(v, 4); v += __shfl_xor(v, 2); v += __shfl_xor(v, 1); return v; }
DEVI float half_sum32(float v) { v += __shfl_xor(v, 16); v += __shfl_xor(v, 8); v += __shfl_xor(v, 4); v += __shfl_xor(v, 2); v += __shfl_xor(v, 1); return v; }
DEVI float xhalf_max(float v) { auto rr = __builtin_amdgcn_permlane32_swap(__float_as_uint(v), __float_as_uint(v), false, false); return fmaxf(__uint_as_float(rr[0]), __uint_as_float(rr[1])); }
DEVI float xhalf_sum(float v) { auto rr = __builtin_amdgcn_permlane32_swap(__float_as_uint(v), __float_as_uint(v), false, false); return __uint_as_float(rr[0]) + __uint_as_float(rr[1]); }
DEVI float silu_f(float v) { return v / (1.f + expf(-v)); }

DEVI int xcd_unit(int v, int U) { const int chunk = (U + 7) >> 3; const int x = v & 7, j = v >> 3; if (j >= chunk) return -1; const int u = x * chunk + j; return u < U ? u : -1; }
DEVI int xcd_iters(int U, int nb) { const int chunk = (U + 7) >> 3; return (chunk * 8 + nb - 1) / nb; }

struct WInAcc { const float* w;
  DEVI float at(int k, int n) const { int o; if (n < 1152) o = n; else if (n < 2176) o = n + 32; else if (n < 2208) o = n - 1024; else return 0.f; return w[(size_t)k * NPROJ_REAL + o]; } };
struct WUqAcc { const float* w; const float* g; DEVI float at(int k, int n) const { return g[k] * w[(size_t)k * 768 + n]; } };
struct WUkvAcc { const float* w; const float* g; DEVI float at(int k, int n) const { return g[k] * w[(size_t)k * 1024 + n]; } };
struct WOutAcc { const float* w; DEVI float at(int k, int n) const { return w[(size_t)k * 1024 + n]; } };
struct WGUAcc { const float* wg; const float* wu;
  DEVI float at(int k, int n) const { const int q = n >> 6, r = n & 63; return r < 32 ? wg[(size_t)k * 512 + q * 32 + r] : wu[(size_t)k * 512 + q * 32 + r - 32]; } };
struct WDAcc { const float* w; DEVI float at(int k, int n) const { return w[(size_t)k * 1024 + n]; } };

struct ARows { const act_t* base; size_t ld; DEVI const act_t* row(int m) const { return base + (size_t)m * ld; } };
struct AGather { const act_t* base; const int* list; int cnt; int slot0;
  DEVI const act_t* row(int m) const { const int s = slot0 + m; const int tk = s < cnt ? list[s] : 0; return base + (size_t)(tk >> 1) * 1024; } };

constexpr int CT_LD = 132;
constexpr int LDS_BYTES = 73728;

template <class AF, class BACC>
DEVI void gemm_core_exact(const AF& af, const BACC& bacc, int n0, int K, char* smem) {
  float* As = (float*)smem;
  float* Bs = As + 16 * 132;
  float* Ct = (float*)smem;
  const int t = threadIdx.x, ty = t >> 4, tx = t & 15;
  float acc[8][8];
#pragma unroll
  for (int i = 0; i < 8; ++i)
#pragma unroll
    for (int j = 0; j < 8; ++j) acc[i][j] = 0.f;
  const act_t* ap = af.row(t >> 1) + (t & 1) * 8;
  for (int k0 = 0; k0 < K; k0 += 16) {
    __syncthreads();
    { float v[4], w[4]; ld4(ap + k0, v); ld4(ap + k0 + 4, w); const int m = t >> 1, kk = (t & 1) * 8;
      As[(kk + 0) * 132 + m] = v[0]; As[(kk + 1) * 132 + m] = v[1]; As[(kk + 2) * 132 + m] = v[2]; As[(kk + 3) * 132 + m] = v[3];
      As[(kk + 4) * 132 + m] = w[0]; As[(kk + 5) * 132 + m] = w[1]; As[(kk + 6) * 132 + m] = w[2]; As[(kk + 7) * 132 + m] = w[3]; }
#pragma unroll
    for (int i = 0; i < 8; ++i) { const int n = t & 127, kk = (t >> 7) + 2 * i; Bs[kk * 132 + n] = bacc.at(k0 + kk, n0 + n); }
    __syncthreads();
#pragma unroll 4
    for (int kk = 0; kk < 16; ++kk) {
      float a[8], b[8];
      { const float4 a0 = *(const float4*)&As[kk * 132 + ty * 8], a1 = *(const float4*)&As[kk * 132 + ty * 8 + 4];
        a[0] = a0.x; a[1] = a0.y; a[2] = a0.z; a[3] = a0.w; a[4] = a1.x; a[5] = a1.y; a[6] = a1.z; a[7] = a1.w;
        const float4 b0 = *(const float4*)&Bs[kk * 132 + tx * 8], b1 = *(const float4*)&Bs[kk * 132 + tx * 8 + 4];
        b[0] = b0.x; b[1] = b0.y; b[2] = b0.z; b[3] = b0.w; b[4] = b1.x; b[5] = b1.y; b[6] = b1.z; b[7] = b1.w; }
#pragma unroll
      for (int i = 0; i < 8; ++i)
#pragma unroll
        for (int j = 0; j < 8; ++j) acc[i][j] = fmaf(a[i], b[j], acc[i][j]);
    }
  }
  __syncthreads();
#pragma unroll
  for (int i = 0; i < 8; ++i) {
    *(float4*)&Ct[(ty * 8 + i) * CT_LD + tx * 8] = make_float4(acc[i][0], acc[i][1], acc[i][2], acc[i][3]);
    *(float4*)&Ct[(ty * 8 + i) * CT_LD + tx * 8 + 4] = make_float4(acc[i][4], acc[i][5], acc[i][6], acc[i][7]);
  }
  __syncthreads();
}

#if !MODE_EXACT
template <class AF>
DEVI void gemm_core_fast(const AF& af, const bf16_t* Bt  , int ldb, int K, char* smem) {
  constexpr int ROWB = 144, STG = 128 * ROWB  ;
  const int t = threadIdx.x, lane = t & 63, w = t >> 6, wr = w >> 1, wc = w & 1, r32 = lane & 31, hi = lane >> 5;
  const int srow = t >> 3, sch = t & 7;
  const bf16_t* ag[4]; const bf16_t* bg[4];
#pragma unroll
  for (int i = 0; i < 4; ++i) { ag[i] = af.row(srow + 32 * i) + sch * 8; bg[i] = Bt + (size_t)(srow + 32 * i) * ldb + sch * 8; }
  const int soff = srow * ROWB + sch * 16;
  f32x16 acc[2][2];
#pragma unroll
  for (int i = 0; i < 2; ++i)
#pragma unroll
    for (int j = 0; j < 2; ++j)
#pragma unroll
      for (int r = 0; r < 16; ++r) acc[i][j][r] = 0.f;
  u32x4 ra[4], rb[4];
  const int nk = K >> 6;
#pragma unroll
  for (int i = 0; i < 4; ++i) { ra[i] = *(const u32x4*)(ag[i]); rb[i] = *(const u32x4*)(bg[i]); }
  __syncthreads();
#pragma unroll
  for (int i = 0; i < 4; ++i) { *(u32x4*)(smem + soff + i * 32 * ROWB) = ra[i]; *(u32x4*)(smem + STG + soff + i * 32 * ROWB) = rb[i]; }
  __syncthreads();
  for (int ks = 0; ks < nk; ++ks) {
    const char* As = smem + (ks & 1) * 2 * STG; const char* Bs = As + STG;
    if (ks + 1 < nk) {
#pragma unroll
      for (int i = 0; i < 4; ++i) { ra[i] = *(const u32x4*)(ag[i] + (ks + 1) * 64); rb[i] = *(const u32x4*)(bg[i] + (ks + 1) * 64); }
    }
#pragma unroll
    for (int s = 0; s < 4; ++s) {
      const int co = (16 * s + 8 * hi) * 2;
      const bf16x8 a0 = *(const bf16x8*)(As + (wr * 64 + r32) * ROWB + co), a1 = *(const bf16x8*)(As + (wr * 64 + 32 + r32) * ROWB + co);
      const bf16x8 b0 = *(const bf16x8*)(Bs + (wc * 64 + r32) * ROWB + co), b1 = *(const bf16x8*)(Bs + (wc * 64 + 32 + r32) * ROWB + co);
      acc[0][0] = __builtin_amdgcn_mfma_f32_32x32x16_bf16(a0, b0, acc[0][0], 0, 0, 0);
      acc[0][1] = __builtin_amdgcn_mfma_f32_32x32x16_bf16(a0, b1, acc[0][1], 0, 0, 0);
      acc[1][0] = __builtin_amdgcn_mfma_f32_32x32x16_bf16(a1, b0, acc[1][0], 0, 0, 0);
      acc[1][1] = __builtin_amdgcn_mfma_f32_32x32x16_bf16(a1, b1, acc[1][1], 0, 0, 0);
    }
    if (ks + 1 < nk) {
      char* Aw = smem + ((ks + 1) & 1) * 2 * STG; char* Bw = Aw + STG;
#pragma unroll
      for (int i = 0; i < 4; ++i) { *(u32x4*)(Aw + soff + i * 32 * ROWB) = ra[i]; *(u32x4*)(Bw + soff + i * 32 * ROWB) = rb[i]; }
    }
    __syncthreads();
  }
  float* Ct = (float*)smem;
#pragma unroll
  for (int mi = 0; mi < 2; ++mi)
#pragma unroll
    for (int ni = 0; ni < 2; ++ni)
#pragma unroll
      for (int r = 0; r < 16; ++r) Ct[(wr * 64 + mi * 32 + crow(r, hi)) * CT_LD + wc * 64 + ni * 32 + r32] = acc[mi][ni][r];
  __syncthreads();
}
#endif

template <class AF, class BACC, class EPI>
DEVI void gemm_tile(const AF& af, const BACC& bacc, const bf16_t* Bt, int n0, int K, const EPI& epi, char* smem) {
#if GEMM_EXACT
  gemm_core_exact(af, bacc, n0, K, smem);
#else
  gemm_core_fast(af, Bt + (size_t)n0 * K, K, K, smem);
#endif
  epi((const float*)smem);
  __syncthreads();
}

#define EPI_LOOP for (int _i = 0, row = (threadIdx.x >> 5), c4 = (threadIdx.x & 31) * 4; _i < 16; ++_i, row += 8)

struct EpiProj { const Params* p; int tm, tn;
  DEVI void operator()(const float* Ct) const {
    char* ws = p->ws;
    EPI_LOOP {
      const int m = tm * 128 + row; const float4 v = *(const float4*)&Ct[row * CT_LD + c4];
      if (tn < 3) { st4((act_t*)(ws + OFF_QLAT) + (size_t)m * 384 + tn * 128 + c4, v.x, v.y, v.z, v.w);
        const float s = half_sum32(v.x * v.x + v.y * v.y + v.z * v.z + v.w * v.w); if ((threadIdx.x & 31) == 0) ((float*)(ws + OFF_SSQ))[(size_t)m * 4 + tn] = s; }
      else if (tn < 7) st4((act_t*)(ws + OFF_NAQ) + (size_t)m * 512 + (tn - 3) * 128 + c4, v.x * NASCALE, v.y * NASCALE, v.z * NASCALE, v.w * NASCALE);
      else if (tn < 9) { st4((act_t*)(ws + OFF_KVLAT) + (size_t)m * 256 + (tn - 7) * 128 + c4, v.x, v.y, v.z, v.w);
        const float s = half_sum32(v.x * v.x + v.y * v.y + v.z * v.z + v.w * v.w); if ((threadIdx.x & 31) == 0) ((float*)(ws + OFF_SSKV))[(size_t)m * 2 + tn - 7] = s; }
      else if (tn < 13) st4((act_t*)(ws + OFF_NAK) + (size_t)m * 512 + (tn - 9) * 128 + c4, v.x, v.y, v.z, v.w);
      else if (tn < 17) st4((act_t*)(ws + OFF_NAV) + (size_t)m * 512 + (tn - 13) * 128 + c4, v.x, v.y, v.z, v.w);
      else if (c4 < 32) {
        const int rb = m % RB; float o[4] = {v.x, v.y, v.z, v.w};
        if (rb >= CTXL) { const int pos = rb - CTXL, gr = pos >> 6, gc = pos & 63; const float* rc = (const float*)(ws + OFF_ROPE); const float* rs = rc + 128 * 8;
          const float vv[4] = {v.x, v.y, v.z, v.w};
#pragma unroll
          for (int e = 0; e < 4; ++e) { const int cc = c4 + e, i = cc & 15; const int pidx = (i < 8 ? gr : gc) * 8 + (i & 7); const float cs = rc[pidx], sn = rs[pidx];
            if (cc < 16) { const float x2 = Ct[row * CT_LD + cc + 16]; o[e] = vv[e] * cs - x2 * sn; } else { const float x1 = Ct[row * CT_LD + cc - 16]; o[e] = x1 * sn + vv[e] * cs; } } }
        st4((act_t*)(ws + OFF_KROPE) + (size_t)m * 32 + c4, o[0], o[1], o[2], o[3]);
      }
    }
  } };

struct EpiQm { const Params* p; int tm, tn;
  DEVI void operator()(const float* Ct) const {
    char* ws = p->ws; act_t* qm = (act_t*)p->out;
    EPI_LOOP {
      const int m = tm * 128 + row; const float* ss = (const float*)(ws + OFF_SSQ) + (size_t)m * 4;
      const float rstd = rsqrtf((ss[0] + ss[1] + ss[2]) * (1.f / 384.f) + EPS);
      const float4 v = *(const float4*)&Ct[row * CT_LD + c4]; const float vv[4] = {v.x, v.y, v.z, v.w}; float o[4];
      const int rb = m % RB; const int n0 = tn * 128 + c4; const int dh = n0 % 96;
      if (dh >= 64 && rb >= CTXL) { const int pos = rb - CTXL, gr = pos >> 6, gc = pos & 63; const float* rc = (const float*)(ws + OFF_ROPE); const float* rs = rc + 128 * 8;
#pragma unroll
        for (int e = 0; e < 4; ++e) { const int cc = dh - 64 + e, i = cc & 15; const int pidx = (i < 8 ? gr : gc) * 8 + (i & 7); const float cs = rc[pidx], sn = rs[pidx];
          if (cc < 16) { const float x2 = Ct[row * CT_LD + c4 + e + 16]; o[e] = (vv[e] * cs - x2 * sn) * rstd * QSCALE; } else { const float x1 = Ct[row * CT_LD + c4 + e - 16]; o[e] = (x1 * sn + vv[e] * cs) * rstd * QSCALE; } }
      } else {
#pragma unroll
        for (int e = 0; e < 4; ++e) o[e] = vv[e] * rstd * QSCALE; }
      st4(qm + (size_t)m * 768 + n0, o[0], o[1], o[2], o[3]);
    }
  } };

struct EpiKv { const Params* p; int tm, tn;
  DEVI void operator()(const float* Ct) const {
    char* ws = p->ws;
    EPI_LOOP {
      const int m = tm * 128 + row; const float* ss = (const float*)(ws + OFF_SSKV) + (size_t)m * 2;
      const float rstd = rsqrtf((ss[0] + ss[1]) * (1.f / 256.f) + EPS);
      const float4 v = *(const float4*)&Ct[row * CT_LD + c4];
      st4((act_t*)(ws + OFF_KV) + (size_t)m * 1024 + tn * 128 + c4, v.x * rstd, v.y * rstd, v.z * rstd, v.w * rstd);
    }
  } };

struct EpiOut { const Params* p; int tm, tn;
  DEVI void operator()(const float* Ct) const {
    const float* mod = (const float*)(p->ws + OFF_MOD);
    EPI_LOOP {
      const int tok = tm * 128 + row, b = tok >> 13, n = tn * 128 + c4;
      const float4 v = *(const float4*)&Ct[row * CT_LD + c4]; const float4 xx = *(const float4*)(p->x + (size_t)tok * 1024 + n); const float4 g = *(const float4*)(mod + b * 6144 + 2048 + n);
      *(float4*)(p->out + (size_t)tok * 1024 + n) = make_float4(xx.x + g.x * v.x, xx.y + g.y * v.y, xx.z + g.z * v.z, xx.w + g.w * v.w);
    }
  } };

struct EpiGU { const Params* p; int e, slot0, cnt, hrow0, tn;
  DEVI void operator()(const float* Ct) const {
    act_t* hid = (act_t*)(p->ws + OFF_HID); const float* ew = (const float*)(p->ws + OFF_EW) + (size_t)e * TT;
    EPI_LOOP {
      if ((c4 & 63) < 32) {
        const int slot = slot0 + row; const bool valid = slot < cnt; float o[4] = {0.f, 0.f, 0.f, 0.f};
        if (valid) { const float cw = ew[slot]; const float4 g = *(const float4*)&Ct[row * CT_LD + c4], u = *(const float4*)&Ct[row * CT_LD + c4 + 32];
          o[0] = silu_f(g.x) * u.x * cw; o[1] = silu_f(g.y) * u.y * cw; o[2] = silu_f(g.z) * u.z * cw; o[3] = silu_f(g.w) * u.w * cw; }
        st4(hid + (size_t)(hrow0 + row) * 512 + tn * 64 + (c4 >> 6) * 32 + (c4 & 31), o[0], o[1], o[2], o[3]);
      }
    }
  } };

struct EpiDown { const Params* p; int e, slot0, cnt, tn;
  DEVI void operator()(const float* Ct) const {
    act_t* yb = (act_t*)(p->ws + OFF_YBUF); const int* el = (const int*)(p->ws + OFF_ELIST) + (size_t)e * TT;
    EPI_LOOP {
      const int slot = slot0 + row;
      if (slot < cnt) { const int tk = el[slot]; const float4 v = *(const float4*)&Ct[row * CT_LD + c4];
        st4(yb + ((size_t)(tk & 1) * TT + (tk >> 1)) * 1024 + tn * 128 + c4, v.x, v.y, v.z, v.w); }
    }
  } };

DEVI void modgemv_item(const Params& p, int item, char* smem) {
  float* sc = (float*)smem; float* red = sc + 3072;
  const int t = threadIdx.x;
  __syncthreads();
  for (int i = t; i < 3072; i += 256) { const int ci = i >> 10, k = i & 1023; const float v = ci == 0 ? p.c[k] : ci == 1 ? p.c[1024 + k] : p.c_ctx[k]; sc[i] = silu_f(v); }
  __syncthreads();
  const int cc = t & 31, kg = t >> 5, col = item * 32 + cc;
  float a0 = 0.f, a1 = 0.f, a2 = 0.f;
#pragma unroll 16
  for (int k = kg; k < 1024; k += 8) { const float w = p.w_mod[(size_t)k * 6144 + col]; a0 = fmaf(sc[k], w, a0); a1 = fmaf(sc[1024 + k], w, a1); a2 = fmaf(sc[2048 + k], w, a2); }
  red[(kg * 32 + cc) * 3 + 0] = a0; red[(kg * 32 + cc) * 3 + 1] = a1; red[(kg * 32 + cc) * 3 + 2] = a2;
  __syncthreads();
  if (t < 96) { const int c2 = t & 31, ci = t >> 5; float s = 0.f;
#pragma unroll
    for (int g = 0; g < 8; ++g) s += red[(g * 32 + c2) * 3 + ci];
    ((float*)(p.ws + OFF_MOD))[ci * 6144 + item * 32 + c2] = s + p.b_mod[item * 32 + c2]; }
}

DEVI void misc_item(const Params& p) {
  const int t = threadIdx.x;
  if (t < 16) ((int*)(p.ws + OFF_CNT))[t] = 0;
  float* rc = (float*)(p.ws + OFF_ROPE); float* rs = rc + 1024;
  for (int i = t; i < 1024; i += 256) {
    const int pos = i >> 3, j = i & 7;
    double f = 1.0; for (int q = 0; q < j; ++q) f *= 0.31622776601683794;
    const double a = (double)pos * f; const double n = rint(a * 0.15915494309189535); const double r = a - n * 6.283185307179586477;
    const double r2 = r * r; double sn = r, cs = 1.0, ts = r, tc = 1.0;
    for (int q = 1; q <= 14; ++q) { tc *= -r2 / (double)((2 * q - 1) * (2 * q)); cs += tc; ts *= -r2 / (double)((2 * q) * (2 * q + 1)); sn += ts; }
    rc[i] = (float)cs; rs[i] = (float)sn;
  }
}

DEVI void bt_item(const Params& p, int item) {
  float* bt = (float*)(p.ws + OFF_BT) + (size_t)item * 4096;
  for (int i = threadIdx.x; i < 4096; i += 256) { const int kc = i >> 6, c = i & 63; int cs = c - 8; cs = cs < 0 ? 0 : (cs > 48 ? 48 : cs);
    bt[i] = (kc >= cs && kc < cs + 16) ? p.rel_bias[(size_t)item * 31 + (kc - c + 15)] * LOG2E : -1e30f; }
}

#if !MODE_EXACT
template <class ACC>
DEVI void conv_tile(const ACC& acc, bf16_t* dst, int K, int n0, int k0, char* smem) {
  float* tl = (float*)smem;
  const int t = threadIdx.x;
  __syncthreads();
#pragma unroll
  for (int i = 0; i < 16; ++i) { const int nn = t & 63, kk = (t >> 6) + 4 * i; tl[kk * 65 + nn] = acc.at(k0 + kk, n0 + nn); }
  __syncthreads();
  const int n = t >> 2, ks = (t & 3) * 16; unsigned w[8];
#pragma unroll
  for (int j = 0; j < 8; ++j) w[j] = pk2(tl[(ks + 2 * j) * 65 + n], tl[(ks + 2 * j + 1) * 65 + n]);
  uint4* d = (uint4*)(dst + (size_t)(n0 + n) * K + k0 + ks);
  d[0] = make_uint4(w[0], w[1], w[2], w[3]); d[1] = make_uint4(w[4], w[5], w[6], w[7]);
}
#endif

DEVI void phase_A(const Params& p, int bid, int nb, char* smem) {
  constexpr int N_MOD = 192, N_MISC = 1, N_BT = 120;
  constexpr int I0 = N_MOD + N_MISC + N_BT;
#if MODE_EXACT
  constexpr int NITEMS = I0;
#else
  constexpr int C_IN = (NPROJ / 64) * 16, C_UQ = 12 * 6, C_UKV = 16 * 4, C_OUT = 256, C_GU = 16 * 16 * 16, C_D = 16 * 16 * 8;
  constexpr int NITEMS = I0 + C_IN + C_UQ + C_UKV + C_OUT + C_GU + C_D;
#endif
  for (int it = bid; it < NITEMS; it += nb) {
    if (it < N_MOD) modgemv_item(p, it, smem);
    else if (it < N_MOD + N_MISC) misc_item(p);
    else if (it < I0) bt_item(p, it - N_MOD - N_MISC);
#if !MODE_EXACT
    else {
      int j = it - I0;
      if (j < C_IN) { WInAcc a{p.w_in}; conv_tile(a, (bf16_t*)(p.ws + OFF_WIN), 1024, (j >> 4) * 64, (j & 15) * 64, smem); continue; } j -= C_IN;
      if (j < C_UQ) { WUqAcc a{p.w_uq, p.g_q}; conv_tile(a, (bf16_t*)(p.ws + OFF_WUQ), 384, (j / 6) * 64, (j % 6) * 64, smem); continue; } j -= C_UQ;
      if (j < C_UKV) { WUkvAcc a{p.w_ukv, p.g_kv}; conv_tile(a, (bf16_t*)(p.ws + OFF_WUKV), 256, (j >> 2) * 64, (j & 3) * 64, smem); continue; } j -= C_UKV;
      if (j < C_OUT) { WOutAcc a{p.w_out}; conv_tile(a, (bf16_t*)(p.ws + OFF_WOUT), 1024, (j >> 4) * 64, (j & 15) * 64, smem); continue; } j -= C_OUT;
      if (j < C_GU) { const int e = j >> 8, r = j & 255; WGUAcc a{p.w_gate + (size_t)e * 1024 * 512, p.w_up + (size_t)e * 1024 * 512};
        conv_tile(a, (bf16_t*)(p.ws + OFF_WGU) + (size_t)e * 1024 * 1024, 1024, (r >> 4) * 64, (r & 15) * 64, smem); continue; } j -= C_GU;
      { const int e = j >> 7, r = j & 127; WDAcc a{p.w_down + (size_t)e * 512 * 1024};
        conv_tile(a, (bf16_t*)(p.ws + OFF_WD) + (size_t)e * 1024 * 512, 512, (r >> 3) * 64, (r & 7) * 64, smem); }
    }
#endif
  }
}

DEVI void phase_B(const Params& p, int bid, int nb) {
  const int lane = threadIdx.x & 63, wv = threadIdx.x >> 6;
  const float* mod = (const float*)(p.ws + OFF_MOD); act_t* hx = (act_t*)(p.ws + OFF_HXALL);
  for (int row = bid * 4 + wv; row < RR; row += nb * 4) {
    const int b = row / RB, rb = row - b * RB;
    const float* src = rb < CTXL ? p.ctx + (size_t)(b * CTXL + rb) * 1024 : p.x + (size_t)(b * SEQ + rb - CTXL) * 1024;
    const float* sh = mod + (rb < CTXL ? 2 : b) * 6144; const float* sc = sh + 1024;
    float4 v[4]; float ss = 0.f;
#pragma unroll
    for (int i = 0; i < 4; ++i) { v[i] = *(const float4*)(src + lane * 4 + 256 * i); ss += v[i].x * v[i].x + v[i].y * v[i].y + v[i].z * v[i].z + v[i].w * v[i].w; }
    ss = wave_sum(ss); const float rstd = rsqrtf(ss * (1.f / 1024.f) + EPS);
#pragma unroll
    for (int i = 0; i < 4; ++i) { const int k = lane * 4 + 256 * i; const float4 g = *(const float4*)(p.g_attn + k), s1 = *(const float4*)(sc + k), s0 = *(const float4*)(sh + k);
      st4(hx + (size_t)row * 1024 + k, v[i].x * rstd * g.x * (1.f + s1.x) + s0.x, v[i].y * rstd * g.y * (1.f + s1.y) + s0.y, v[i].z * rstd * g.z * (1.f + s1.z) + s0.z, v[i].w * rstd * g.w * (1.f + s1.w) + s0.w); }
  }
}

DEVI void phase_C(const Params& p, int bid, int nb, char* smem) {
  constexpr int U = 132 * 18; const int iters = xcd_iters(U, nb);
  for (int it = 0; it < iters; ++it) { const int u = xcd_unit(bid + it * nb, U); if (u < 0) continue;
    const int tm = u / 18, tn = u % 18;
    ARows af{(const act_t*)(p.ws + OFF_HXALL) + (size_t)tm * 128 * 1024, 1024}; WInAcc ba{p.w_in}; EpiProj epi{&p, tm, tn};
    gemm_tile(af, ba, (const bf16_t*)(p.ws + OFF_WIN), tn * 128, 1024, epi, smem); }
}
DEVI void phase_D(const Params& p, int bid, int nb, char* smem) {
  constexpr int UQ = 132 * 6, UK = 132 * 8, U = UQ + UK; const int iters = xcd_iters(U, nb);
  for (int it = 0; it < iters; ++it) { const int u = xcd_unit(bid + it * nb, U); if (u < 0) continue;
    if (u < UQ) { const int tm = u / 6, tn = u % 6; if ((tm % 66) < 2) continue;
      ARows af{(const act_t*)(p.ws + OFF_QLAT) + (size_t)tm * 128 * 384, 384}; WUqAcc ba{p.w_uq, p.g_q}; EpiQm epi{&p, tm, tn};
      gemm_tile(af, ba, (const bf16_t*)(p.ws + OFF_WUQ), tn * 128, 384, epi, smem); }
    else { const int v = u - UQ, tm = v >> 3, tn = v & 7;
      ARows af{(const act_t*)(p.ws + OFF_KVLAT) + (size_t)tm * 128 * 256, 256}; WUkvAcc ba{p.w_ukv, p.g_kv}; EpiKv epi{&p, tm, tn};
      gemm_tile(af, ba, (const bf16_t*)(p.ws + OFF_WUKV), tn * 128, 256, epi, smem); } }
}

template <typename TA, bool NA>
DEVI void attn_exact_unit(const Params& p, int unit, int lane) {
  constexpr int DQK = NA ? 64 : 96, DH = DQK / 2;
  const int r32 = lane & 31, kk = lane >> 5;
  const char* ws = p.ws;
  int b, h, q0, grow = 0, wstart = 0, qb = 0;
  if (NA) { qb = unit & 1; h = (unit >> 1) & 7; grow = (unit >> 4) & 127; b = unit >> 11; q0 = grow * 64 + qb * 32; wstart = grow - 4; wstart = wstart < 0 ? 0 : (wstart > 120 ? 120 : wstart); }
  else { q0 = (unit & 255) * 32; h = (unit >> 8) & 7; b = unit >> 11; }
  const size_t qrow = (size_t)b * RB + CTXL + q0 + r32;
  float q[DH];
  if (NA) { const TA* qp = (const TA*)(ws + OFF_NAQ) + qrow * 512 + h * 64 + kk * DH;
#pragma unroll
    for (int s = 0; s < DH; s += 4) { float v[4]; ld4(qp + s, v); q[s] = v[0]; q[s + 1] = v[1]; q[s + 2] = v[2]; q[s + 3] = v[3]; } }
  else { const TA* qp = (const TA*)p.out + qrow * 768 + h * 96 + kk * DH;
#pragma unroll
    for (int s = 0; s < DH; s += 4) { float v[4]; ld4(qp + s, v); q[s] = v[0]; q[s + 1] = v[1]; q[s + 2] = v[2]; q[s + 3] = v[3]; } }
  f32x16 o0, o1;
#pragma unroll
  for (int r = 0; r < 16; ++r) { o0[r] = 0.f; o1[r] = 0.f; }
  float m = -1e30f, l = 0.f;
  const int ntiles = NA ? 24 : RB / 32;
  for (int j = 0; j < ntiles; ++j) {
    size_t krow0; const float* bt = nullptr;
    if (NA) { if (j < 16) { const int jr = j >> 1, kb = j & 1, kr = wstart + jr; krow0 = (size_t)b * RB + CTXL + kr * 64 + kb * 32;
                bt = (const float*)(ws + OFF_BT) + ((size_t)(h * 15 + (kr - grow + 7)) * 64 + kb * 32) * 64 + qb * 32 + r32; }
              else krow0 = (size_t)b * RB + (j - 16) * 32; }
    else krow0 = (size_t)b * RB + j * 32;
    float kf[DH];
    if (NA) { const TA* kp = (const TA*)(ws + OFF_NAK) + (krow0 + r32) * 512 + h * 64 + kk * DH;
#pragma unroll
      for (int s = 0; s < DH; s += 4) { float v[4]; ld4(kp + s, v); kf[s] = v[0]; kf[s + 1] = v[1]; kf[s + 2] = v[2]; kf[s + 3] = v[3]; } }
    else { const TA* kp = (const TA*)(ws + OFF_KV) + (krow0 + r32) * 1024 + h * 128; const TA* rp = (const TA*)(ws + OFF_KROPE) + (krow0 + r32) * 32;
#pragma unroll
      for (int s = 0; s < DH; s += 4) { const int d = kk * DH + s; float v[4]; if (d < 64) ld4(kp + d, v); else ld4(rp + d - 64, v); kf[s] = v[0]; kf[s + 1] = v[1]; kf[s + 2] = v[2]; kf[s + 3] = v[3]; } }
    f32x16 sa;
#pragma unroll
    for (int r = 0; r < 16; ++r) sa[r] = 0.f;
#pragma unroll
    for (int s = 0; s < DH; ++s) sa = __builtin_amdgcn_mfma_f32_32x32x2f32(kf[s], q[s], sa, 0, 0, 0);
    if (NA && j < 16) {
#pragma unroll
      for (int r = 0; r < 16; ++r) sa[r] += bt[crow(r, kk) * 64]; }
    float mx = sa[0];
#pragma unroll
    for (int r = 1; r < 16; ++r) mx = fmaxf(mx, sa[r]);
    mx = xhalf_max(mx);
    const float mn = fmaxf(m, mx), alpha = exp2f(m - mn); m = mn;
    float ps = 0.f;
#pragma unroll
    for (int r = 0; r < 16; ++r) { sa[r] = exp2f(sa[r] - mn); ps += sa[r]; }
    ps = xhalf_sum(ps); l = l * alpha + ps;
#pragma unroll
    for (int r = 0; r < 16; ++r) { o0[r] *= alpha; o1[r] *= alpha; }
    const TA* vp = NA ? (const TA*)(ws + OFF_NAV) + krow0 * 512 + h * 64 + r32 : (const TA*)(ws + OFF_KV) + krow0 * 1024 + h * 128 + 64 + r32;
    const size_t vld = NA ? 512 : 1024;
#pragma unroll
    for (int s = 0; s < 16; ++s) { const int key = crow(s, kk);
      const float v0 = a2f(vp[(size_t)key * vld]), v1 = a2f(vp[(size_t)key * vld + 32]);
      o0 = __builtin_amdgcn_mfma_f32_32x32x2f32(v0, sa[s], o0, 0, 0, 0);
      o1 = __builtin_amdgcn_mfma_f32_32x32x2f32(v1, sa[s], o1, 0, 0, 0); }
  }
  const float rl = 1.f / l;
  act_t* op = (act_t*)(ws + OFF_ATTN) + ((size_t)b * SEQ + q0 + r32) * 1024 + (NA ? 512 : 0) + h * 64;
#pragma unroll
  for (int g = 0; g < 4; ++g) {
    st4(op + 8 * g + 4 * kk, o0[4 * g] * rl, o0[4 * g + 1] * rl, o0[4 * g + 2] * rl, o0[4 * g + 3] * rl);
    st4(op + 32 + 8 * g + 4 * kk, o1[4 * g] * rl, o1[4 * g + 1] * rl, o1[4 * g + 2] * rl, o1[4 * g + 3] * rl); }
}

DEVI void phase_E_exact(const Params& p, int bid, int nb) {
  const int lane = threadIdx.x & 63, wv = threadIdx.x >> 6;
  constexpr int UM = NBATCH * 8 * 256, UN = NBATCH * 128 * 8 * 2;
  for (int u = bid * 4 + wv; u < UM; u += nb * 4) attn_exact_unit<act_t, false>(p, u, lane);
  for (int u = bid * 4 + wv; u < UN; u += nb * 4) attn_exact_unit<act_t, true>(p, u, lane);
}

#if !MODE_EXACT
typedef s16x4 __attribute__((address_space(3))) las_s16x4;
DEVI bf16x8 pack8(const f32x16& s, int base) {
  u32x4 w = {pk2(s[base], s[base + 1]), pk2(s[base + 2], s[base + 3]), pk2(s[base + 4], s[base + 5]), pk2(s[base + 6], s[base + 7])};
  return __builtin_bit_cast(bf16x8, w);
}
DEVI bf16x8 tr_pair(const char* p) {
  const s16x4 lo = __builtin_amdgcn_ds_read_tr16_b64_v4i16((las_s16x4*)(p));
  const s16x4 hh = __builtin_amdgcn_ds_read_tr16_b64_v4i16((las_s16x4*)(p + 8 * 64));
  return (bf16x8){lo[0], lo[1], lo[2], lo[3], hh[0], hh[1], hh[2], hh[3]};
}
template <int DQK, bool BIAS>
DEVI void flash_tile(const char* Ks, const char* Vs, const bf16x8 (&qf)[DQK / 16], f32x16& o0, f32x16& o1, float& m, float& l, const float* bt, int r32, int hi, int vb) {
  constexpr int KROW = DQK * 2 + 16;
  f32x16 s0, s1;
#pragma unroll
  for (int r = 0; r < 16; ++r) { s0[r] = 0.f; s1[r] = 0.f; }
#pragma unroll
  for (int s = 0; s < DQK / 16; ++s) {
    const bf16x8 k0 = *(const bf16x8*)(Ks + r32 * KROW + (16 * s + 8 * hi) * 2);
    const bf16x8 k1 = *(const bf16x8*)(Ks + (32 + r32) * KROW + (16 * s + 8 * hi) * 2);
    s0 = __builtin_amdgcn_mfma_f32_32x32x16_bf16(k0, qf[s], s0, 0, 0, 0);
    s1 = __builtin_amdgcn_mfma_f32_32x32x16_bf16(k1, qf[s], s1, 0, 0, 0);
  }
  if (BIAS) {
#pragma unroll
    for (int r = 0; r < 16; ++r) { s0[r] += bt[crow(r, hi) * 64]; s1[r] += bt[(32 + crow(r, hi)) * 64]; }
  }
  float mx = fmaxf(s0[0], s1[0]);
#pragma unroll
  for (int r = 1; r < 16; ++r) mx = fmaxf(mx, fmaxf(s0[r], s1[r]));
  mx = xhalf_max(mx);
  const float mn = fmaxf(m, mx), alpha = __builtin_amdgcn_exp2f(m - mn); m = mn;
  float ps = 0.f;
#pragma unroll
  for (int r = 0; r < 16; ++r) { s0[r] = __builtin_amdgcn_exp2f(s0[r] - mn); s1[r] = __builtin_amdgcn_exp2f(s1[r] - mn); ps += s0[r] + s1[r]; }
  ps = xhalf_sum(ps); l = l * alpha + ps;
#pragma unroll
  for (int r = 0; r < 16; ++r) { o0[r] *= alpha; o1[r] *= alpha; }
  const bf16x8 p00 = pack8(s0, 0), p01 = pack8(s0, 8), p10 = pack8(s1, 0), p11 = pack8(s1, 8);
  const char* v0 = Vs + vb; const char* v1 = Vs + 4096 + vb;
  o0 = __builtin_amdgcn_mfma_f32_32x32x16_bf16(tr_pair(v0), p00, o0, 0, 0, 0);
  o0 = __builtin_amdgcn_mfma_f32_32x32x16_bf16(tr_pair(v0 + 16 * 64), p01, o0, 0, 0, 0);
  o0 = __builtin_amdgcn_mfma_f32_32x32x16_bf16(tr_pair(v0 + 32 * 64), p10, o0, 0, 0, 0);
  o0 = __builtin_amdgcn_mfma_f32_32x32x16_bf16(tr_pair(v0 + 48 * 64), p11, o0, 0, 0, 0);
  o1 = __builtin_amdgcn_mfma_f32_32x32x16_bf16(tr_pair(v1), p00, o1, 0, 0, 0);
  o1 = __builtin_amdgcn_mfma_f32_32x32x16_bf16(tr_pair(v1 + 16 * 64), p01, o1, 0, 0, 0);
  o1 = __builtin_amdgcn_mfma_f32_32x32x16_bf16(tr_pair(v1 + 32 * 64), p10, o1, 0, 0, 0);
  o1 = __builtin_amdgcn_mfma_f32_32x32x16_bf16(tr_pair(v1 + 48 * 64), p11, o1, 0, 0, 0);
}
DEVI void flash_store(bf16_t* op, const f32x16& o0, const f32x16& o1, float l, int hi) {
  const float rl = 1.f / l;
#pragma unroll
  for (int g = 0; g < 4; ++g) {
    st4(op + 8 * g + 4 * hi, o0[4 * g] * rl, o0[4 * g + 1] * rl, o0[4 * g + 2] * rl, o0[4 * g + 3] * rl);
    st4(op + 32 + 8 * g + 4 * hi, o1[4 * g] * rl, o1[4 * g + 1] * rl, o1[4 * g + 2] * rl, o1[4 * g + 3] * rl); }
}

DEVI void mla_unit(const Params& p, int unit, char* smem) {
  constexpr int KROW = 208, KBYTES = 64 * KROW  , STAGE = KBYTES + 8192  ;
  const int t = threadIdx.x, lane = t & 63, w = t >> 6, r32 = lane & 31, hi = lane >> 5;
  const int qblk = unit & 63, h = (unit >> 6) & 7, b = unit >> 9;
  const char* ws = p.ws;
  const bf16_t* kvb = (const bf16_t*)(ws + OFF_KV) + (size_t)b * RB * 1024 + h * 128;
  const bf16_t* krb = (const bf16_t*)(ws + OFF_KROPE) + (size_t)b * RB * 32;
  const size_t qrow = (size_t)b * RB + CTXL + qblk * 128 + w * 32 + r32;
  bf16x8 qf[6];
  { const bf16_t* qp = (const bf16_t*)p.out + qrow * 768 + h * 96 + hi * 8;
#pragma unroll
    for (int s = 0; s < 6; ++s) qf[s] = *(const bf16x8*)(qp + 16 * s); }
  const bf16_t* gsrc[5]; int ldst[5]; int gstep[5];
#pragma unroll
  for (int i = 0; i < 3; ++i) { const int c = t + 256 * i, key = c / 12, ch = c - key * 12;
    if (ch < 8) { gsrc[i] = kvb + (size_t)key * 1024 + ch * 8; gstep[i] = 64 * 1024; } else { gsrc[i] = krb + (size_t)key * 32 + (ch - 8) * 8; gstep[i] = 64 * 32; }
    ldst[i] = key * KROW + ch * 16; }
#pragma unroll
  for (int i = 0; i < 2; ++i) { const int c = t + 256 * i, key = c >> 3, ch = c & 7;
    gsrc[3 + i] = kvb + (size_t)key * 1024 + 64 + ch * 8; gstep[3 + i] = 64 * 1024; ldst[3 + i] = KBYTES + (ch >> 2) * 4096 + key * 64 + (ch & 3) * 16; }
  const int vb = (((lane & 15) >> 2) + 4 * hi) * 64 + (16 * ((lane >> 4) & 1) + 4 * (lane & 3)) * 2;
  f32x16 o0, o1;
#pragma unroll
  for (int r = 0; r < 16; ++r) { o0[r] = 0.f; o1[r] = 0.f; }
  float m = -1e30f, l = 0.f;
  constexpr int NT = RB / 64;
  u32x4 rg[5];
#pragma unroll
  for (int i = 0; i < 5; ++i) rg[i] = *(const u32x4*)(gsrc[i]);
  __syncthreads();
#pragma unroll
  for (int i = 0; i < 5; ++i) *(u32x4*)(smem + ldst[i]) = rg[i];
  __syncthreads();
  for (int j = 0; j < NT; ++j) {
    const char* st = smem + (j & 1) * STAGE;
    if (j + 1 < NT) {
#pragma unroll
      for (int i = 0; i < 5; ++i) rg[i] = *(const u32x4*)(gsrc[i] + (size_t)(j + 1) * gstep[i]);
    }
    flash_tile<96, false>(st, st + KBYTES, qf, o0, o1, m, l, nullptr, r32, hi, vb);
    if (j + 1 < NT) { char* sw = smem + ((j + 1) & 1) * STAGE;
#pragma unroll
      for (int i = 0; i < 5; ++i) *(u32x4*)(sw + ldst[i]) = rg[i]; }
    __syncthreads();
  }
  flash_store((bf16_t*)(ws + OFF_ATTN) + ((size_t)b * SEQ + qblk * 128 + w * 32 + r32) * 1024 + h * 64, o0, o1, l, hi);
}

DEVI void na_unit(const Params& p, int unit, char* smem) {
  constexpr int KROW = 144, KBYTES = 64 * KROW  , HSTR = KBYTES + 8192  , STAGE = 2 * HSTR  ;
  const int t = threadIdx.x, lane = t & 63, w = t >> 6, r32 = lane & 31, hi = lane >> 5;
  const int hp = unit & 3, grow = (unit >> 2) & 127, b = unit >> 9;
  const int hh = w >> 1, qb = w & 1, head = hp * 2 + hh, c = qb * 32 + r32;
  int wstart = grow - 4; wstart = wstart < 0 ? 0 : (wstart > 120 ? 120 : wstart);
  const char* ws = p.ws;
  const bf16_t* nak = (const bf16_t*)(ws + OFF_NAK) + (size_t)b * RB * 512 + hp * 128;
  const bf16_t* nav = (const bf16_t*)(ws + OFF_NAV) + (size_t)b * RB * 512 + hp * 128;
  bf16x8 qf[4];
  { const bf16_t* qp = (const bf16_t*)(ws + OFF_NAQ) + ((size_t)b * RB + CTXL + grow * 64 + c) * 512 + head * 64 + hi * 8;
#pragma unroll
    for (int s = 0; s < 4; ++s) qf[s] = *(const bf16x8*)(qp + 16 * s); }
  int goff[4], kdst[4], vdst[4];
#pragma unroll
  for (int i = 0; i < 4; ++i) { const int h2 = i >> 1, key = (t >> 3) + 32 * (i & 1), ch = t & 7;
    goff[i] = key * 512 + h2 * 64 + ch * 8; kdst[i] = h2 * HSTR + key * KROW + ch * 16; vdst[i] = h2 * HSTR + KBYTES + (ch >> 2) * 4096 + key * 64 + (ch & 3) * 16; }
  const int vb = (((lane & 15) >> 2) + 4 * hi) * 64 + (16 * ((lane >> 4) & 1) + 4 * (lane & 3)) * 2;
  f32x16 o0, o1;
#pragma unroll
  for (int r = 0; r < 16; ++r) { o0[r] = 0.f; o1[r] = 0.f; }
  float m = -1e30f, l = 0.f;
  const float* btb = (const float*)(ws + OFF_BT) + (size_t)(head * 15) * 4096 + c;
  u32x4 rk[4], rv[4];
  auto rowbase = [&](int j) -> size_t { return j < 8 ? (size_t)CTXL + (size_t)(wstart + j) * 64 : (size_t)(j - 8) * 64; };
  { const size_t rb0 = rowbase(0) * 512;
#pragma unroll
    for (int i = 0; i < 4; ++i) { rk[i] = *(const u32x4*)(nak + rb0 + goff[i]); rv[i] = *(const u32x4*)(nav + rb0 + goff[i]); } }
  __syncthreads();
#pragma unroll
  for (int i = 0; i < 4; ++i) { *(u32x4*)(smem + kdst[i]) = rk[i]; *(u32x4*)(smem + vdst[i]) = rv[i]; }
  __syncthreads();
  for (int j = 0; j < 12; ++j) {
    const char* st = smem + (j & 1) * STAGE + hh * HSTR;
    if (j + 1 < 12) { const size_t rb1 = rowbase(j + 1) * 512;
#pragma unroll
      for (int i = 0; i < 4; ++i) { rk[i] = *(const u32x4*)(nak + rb1 + goff[i]); rv[i] = *(const u32x4*)(nav + rb1 + goff[i]); } }
    if (j < 8) flash_tile<64, true>(st, st + KBYTES, qf, o0, o1, m, l, btb + (size_t)(wstart + j - grow + 7) * 4096, r32, hi, vb);
    else flash_tile<64, false>(st, st + KBYTES, qf, o0, o1, m, l, nullptr, r32, hi, vb);
    if (j + 1 < 12) { char* sw = smem + ((j + 1) & 1) * STAGE;
#pragma unroll
      for (int i = 0; i < 4; ++i) { *(u32x4*)(sw + kdst[i]) = rk[i]; *(u32x4*)(sw + vdst[i]) = rv[i]; } }
    __syncthreads();
  }
  flash_store((bf16_t*)(ws + OFF_ATTN) + ((size_t)b * SEQ + grow * 64 + c) * 1024 + 512 + head * 64, o0, o1, l, hi);
}

DEVI void phase_E_fast(const Params& p, int bid, int nb, char* smem) {
  constexpr int UM = NBATCH * 8 * 64, UN = NBATCH * 128 * 4;
  { const int iters = xcd_iters(UM, nb);
    for (int it = 0; it < iters; ++it) { const int u = xcd_unit(bid + it * nb, UM); if (u >= 0) mla_unit(p, u, smem); } }
  { const int iters = xcd_iters(UN, nb);
    for (int it = 0; it < iters; ++it) { const int u = xcd_unit(bid + it * nb, UN); if (u >= 0) na_unit(p, u, smem); } }
}
#endif

DEVI void phase_F(const Params& p, int bid, int nb, char* smem) {
  constexpr int U = 128 * 8; const int iters = xcd_iters(U, nb);
  for (int it = 0; it < iters; ++it) { const int u = xcd_unit(bid + it * nb, U); if (u < 0) continue;
    const int tm = u >> 3, tn = u & 7;
    ARows af{(const act_t*)(p.ws + OFF_ATTN) + (size_t)tm * 128 * 1024, 1024}; WOutAcc ba{p.w_out}; EpiOut epi{&p, tm, tn};
    gemm_tile(af, ba, (const bf16_t*)(p.ws + OFF_WOUT), tn * 128, 1024, epi, smem); }
}

DEVI void phase_G(const Params& p, int bid, int nb, char* smem) {
  const int t = threadIdx.x, lane = t & 63, wv = t >> 6;
  int* te = (int*)smem; float* tw = (float*)(smem + 256);
  const float* mod = (const float*)(p.ws + OFF_MOD); act_t* hx2 = (act_t*)(p.ws + OFF_HX2);
  int* cnt = (int*)(p.ws + OFF_CNT); int* elist = (int*)(p.ws + OFF_ELIST); float* ewt = (float*)(p.ws + OFF_EW);
  for (int ch = bid; ch < TT / 32; ch += nb) {
    __syncthreads();
    for (int q = 0; q < 8; ++q) {
      const int tl = wv * 8 + q, tok = ch * 32 + tl, b = tok >> 13;
      const float* src = p.out + (size_t)tok * 1024; const float* sh = mod + b * 6144 + 3072; const float* sc = sh + 1024;
      float4 v[4]; float ss = 0.f;
#pragma unroll
      for (int i = 0; i < 4; ++i) { v[i] = *(const float4*)(src + lane * 4 + 256 * i); ss += v[i].x * v[i].x + v[i].y * v[i].y + v[i].z * v[i].z + v[i].w * v[i].w; }
      ss = wave_sum(ss); const float rstd = rsqrtf(ss * (1.f / 1024.f) + EPS);
      float lg[20];
#pragma unroll
      for (int j = 0; j < 20; ++j) lg[j] = 0.f;
#pragma unroll
      for (int i = 0; i < 4; ++i) { const int k = lane * 4 + 256 * i; const float4 g = *(const float4*)(p.g_ffn + k), s1 = *(const float4*)(sc + k), s0 = *(const float4*)(sh + k);
        const float hv[4] = {v[i].x * rstd * g.x * (1.f + s1.x) + s0.x, v[i].y * rstd * g.y * (1.f + s1.y) + s0.y, v[i].z * rstd * g.z * (1.f + s1.z) + s0.z, v[i].w * rstd * g.w * (1.f + s1.w) + s0.w};
        st4(hx2 + (size_t)tok * 1024 + k, hv[0], hv[1], hv[2], hv[3]);
#pragma unroll
        for (int e = 0; e < 4; ++e) { const float4 wg = *(const float4*)(p.w_rg + (size_t)(k + e) * 4);
          lg[0] = fmaf(hv[e], wg.x, lg[0]); lg[1] = fmaf(hv[e], wg.y, lg[1]); lg[2] = fmaf(hv[e], wg.z, lg[2]); lg[3] = fmaf(hv[e], wg.w, lg[3]);
#pragma unroll
          for (int qq = 0; qq < 4; ++qq) { const float4 we = *(const float4*)(p.w_re + (size_t)(k + e) * 16 + qq * 4);
            lg[4 + qq * 4] = fmaf(hv[e], we.x, lg[4 + qq * 4]); lg[5 + qq * 4] = fmaf(hv[e], we.y, lg[5 + qq * 4]); lg[6 + qq * 4] = fmaf(hv[e], we.z, lg[6 + qq * 4]); lg[7 + qq * 4] = fmaf(hv[e], we.w, lg[7 + qq * 4]); } } }
#pragma unroll
      for (int j = 0; j < 20; ++j) lg[j] = wave_sum(lg[j]);
#pragma unroll
      for (int j = 0; j < 4; ++j) lg[j] += p.b_rg[j];
#pragma unroll
      for (int j = 0; j < 16; ++j) lg[4 + j] += p.b_re[j];
      int gs = 0; float gm = lg[0];
#pragma unroll
      for (int j = 1; j < 4; ++j) if (lg[j] > gm) { gm = lg[j]; gs = j; }
      float z = 0.f;
#pragma unroll
      for (int j = 0; j < 4; ++j) z += expf(lg[j] - gm);
      const float gw = 1.f / z;
      float e4[4];
#pragma unroll
      for (int j = 0; j < 4; ++j) e4[j] = gs == 0 ? lg[4 + j] : gs == 1 ? lg[8 + j] : gs == 2 ? lg[12 + j] : lg[16 + j];
      int i1 = 0; float m1 = e4[0];
#pragma unroll
      for (int j = 1; j < 4; ++j) if (e4[j] > m1) { m1 = e4[j]; i1 = j; }
      int i2 = -1; float m2 = -3.0e38f;
#pragma unroll
      for (int j = 0; j < 4; ++j) if (j != i1 && e4[j] > m2) { m2 = e4[j]; i2 = j; }
      const float ex = expf(m2 - m1), w1 = 1.f / (1.f + ex), w2 = ex / (1.f + ex);
      if (lane == 0) { te[tl * 2] = gs * 4 + i1; te[tl * 2 + 1] = gs * 4 + i2; tw[tl * 2] = gw * w1; tw[tl * 2 + 1] = gw * w2; }
    }
    __syncthreads();
    if (t < 16) { int n = 0; for (int i = 0; i < 64; ++i) n += (te[i] == t) ? 1 : 0;
      if (n) { const int base = atomicAdd(&cnt[t], n); int r = 0;
        for (int i = 0; i < 64; ++i) if (te[i] == t) { const int slot = base + r; ++r; elist[(size_t)t * TT + slot] = (ch * 32 + (i >> 1)) * 2 + (i & 1); ewt[(size_t)t * TT + slot] = tw[i]; } } }
  }
}

DEVI bool moe_tile(const Params& p, int mt, int& e, int& mi, int& cnt_e, int& hrow0) {
  const int* cnt = (const int*)(p.ws + OFF_CNT); int acc = 0;
  for (int i = 0; i < 16; ++i) { const int c = cnt[i], nt = (c + 127) >> 7; if (mt < acc + nt) { e = i; mi = mt - acc; cnt_e = c; hrow0 = (acc + mi) * 128; return true; } acc += nt; }
  return false;
}
DEVI int moe_mtiles(const Params& p) { const int* cnt = (const int*)(p.ws + OFF_CNT); int acc = 0; for (int i = 0; i < 16; ++i) acc += (cnt[i] + 127) >> 7; return acc; }

DEVI void phase_H(const Params& p, int bid, int nb, char* smem) {
  const int U = moe_mtiles(p) * 8; const int iters = xcd_iters(U, nb);
  for (int it = 0; it < iters; ++it) { const int u = xcd_unit(bid + it * nb, U); if (u < 0) continue;
    int e, mi, ce, hr; if (!moe_tile(p, u >> 3, e, mi, ce, hr)) continue; const int tn = u & 7;
    AGather af{(const act_t*)(p.ws + OFF_HX2), (const int*)(p.ws + OFF_ELIST) + (size_t)e * TT, ce, mi * 128};
    WGUAcc ba{p.w_gate + (size_t)e * 1024 * 512, p.w_up + (size_t)e * 1024 * 512}; EpiGU epi{&p, e, mi * 128, ce, hr, tn};
    gemm_tile(af, ba, (const bf16_t*)(p.ws + OFF_WGU) + (size_t)e * 1024 * 1024, tn * 128, 1024, epi, smem); }
}
DEVI void phase_I(const Params& p, int bid, int nb, char* smem) {
  const int U = moe_mtiles(p) * 8; const int iters = xcd_iters(U, nb);
  for (int it = 0; it < iters; ++it) { const int u = xcd_unit(bid + it * nb, U); if (u < 0) continue;
    int e, mi, ce, hr; if (!moe_tile(p, u >> 3, e, mi, ce, hr)) continue; const int tn = u & 7;
    ARows af{(const act_t*)(p.ws + OFF_HID) + (size_t)hr * 512, 512}; WDAcc ba{p.w_down + (size_t)e * 512 * 1024}; EpiDown epi{&p, e, mi * 128, ce, tn};
    gemm_tile(af, ba, (const bf16_t*)(p.ws + OFF_WD) + (size_t)e * 1024 * 512, tn * 128, 512, epi, smem); }
}

DEVI void phase_J(const Params& p, int bid, int nb) {
  const int lane = threadIdx.x & 63, wv = threadIdx.x >> 6;
  const float* mod = (const float*)(p.ws + OFF_MOD); const act_t* yb = (const act_t*)(p.ws + OFF_YBUF);
  for (int tok = bid * 4 + wv; tok < TT; tok += nb * 4) {
    const int b = tok >> 13; float* xo = p.out + (size_t)tok * 1024; const float* g2 = mod + b * 6144 + 5120;
    float o[16]; float ss = 0.f;
#pragma unroll
    for (int i = 0; i < 4; ++i) { const int k = lane * 4 + 256 * i; const float4 xv = *(const float4*)(xo + k), g = *(const float4*)(g2 + k);
      float y0[4], y1[4]; ld4(yb + (size_t)tok * 1024 + k, y0); ld4(yb + ((size_t)TT + tok) * 1024 + k, y1);
      o[4 * i] = xv.x + g.x * (y0[0] + y1[0]); o[4 * i + 1] = xv.y + g.y * (y0[1] + y1[1]); o[4 * i + 2] = xv.z + g.z * (y0[2] + y1[2]); o[4 * i + 3] = xv.w + g.w * (y0[3] + y1[3]);
      ss += o[4 * i] * o[4 * i] + o[4 * i + 1] * o[4 * i + 1] + o[4 * i + 2] * o[4 * i + 2] + o[4 * i + 3] * o[4 * i + 3]; }
    ss = wave_sum(ss); const float rstd = rsqrtf(ss * (1.f / 1024.f) + EPS);
#pragma unroll
    for (int i = 0; i < 4; ++i) { const int k = lane * 4 + 256 * i; const float4 g = *(const float4*)(p.g_final + k);
      *(float4*)(xo + k) = make_float4(o[4 * i] * rstd * g.x, o[4 * i + 1] * rstd * g.y, o[4 * i + 2] * rstd * g.z, o[4 * i + 3] * rstd * g.w); }
  }
}

#if !ONE_LAUNCH
template <int PH>
__global__ void __launch_bounds__(NTHREADS, (PH == 4 && ATTN_EXACT) ? 1 : 2) phase_kernel(Params p) {
  __shared__ __attribute__((aligned(16))) char smem[LDS_BYTES];
  const int bid = blockIdx.x, nb = gridDim.x;
  if (PH == 0) phase_A(p, bid, nb, smem);
  if (PH == 1) phase_B(p, bid, nb);
  if (PH == 2) phase_C(p, bid, nb, smem);
  if (PH == 3) phase_D(p, bid, nb, smem);
#if ATTN_EXACT
  if (PH == 4) phase_E_exact(p, bid, nb);
#else
  if (PH == 4) phase_E_fast(p, bid, nb, smem);
#endif
  if (PH == 5) phase_F(p, bid, nb, smem);
  if (PH == 6) phase_G(p, bid, nb, smem);
  if (PH == 7) phase_H(p, bid, nb, smem);
  if (PH == 8) phase_I(p, bid, nb, smem);
  if (PH == 9) phase_J(p, bid, nb);
}
#endif

#if ONE_LAUNCH
DEVI void grid_barrier(cg::grid_group& grid) { grid.sync(); }
__global__ void __launch_bounds__(NTHREADS, 2) mega_kernel(Params p) {
  __shared__ __attribute__((aligned(16))) char smem[LDS_BYTES];
  cg::grid_group grid = cg::this_grid();
  const int bid = blockIdx.x, nb = gridDim.x;
  phase_A(p, bid, nb, smem); grid_barrier(grid);
  phase_B(p, bid, nb); grid_barrier(grid);
  phase_C(p, bid, nb, smem); grid_barrier(grid);
  phase_D(p, bid, nb, smem); grid_barrier(grid);
#if ATTN_EXACT
  phase_E_exact(p, bid, nb); grid_barrier(grid);
#else
  phase_E_fast(p, bid, nb, smem); grid_barrier(grid);
#endif
  phase_F(p, bid, nb, smem); grid_barrier(grid);
  phase_G(p, bid, nb, smem); grid_barrier(grid);
  phase_H(p, bid, nb, smem); grid_barrier(grid);
  phase_I(p, bid, nb, smem); grid_barrier(grid);
  phase_J(p, bid, nb);
}
#endif

extern "C" void kernel_launch(void* const* d_in, const int* in_sizes, int n_in, void* d_out, int out_size, void* d_ws, size_t ws_size, hipStream_t stream) {
  if (n_in != 23 || out_size != TT * 1024 || ws_size < WS_NEED) { fprintf(stderr, "kernel_launch: unexpected shapes n_in %d out %d ws %zu (need %zu)\n", n_in, out_size, ws_size, (size_t)WS_NEED); return; }
  Params p{};
  const float** f = (const float**)&p;
  for (int i = 0; i < 23; ++i) f[i] = (const float*)d_in[i];
  p.out = (float*)d_out; p.ws = (char*)d_ws;
#if ONE_LAUNCH
  static int grid_blocks = 0;
  if (!grid_blocks) {
    int dev = 0, cus = 0, per_cu = 0;
    hipGetDevice(&dev);
    hipDeviceGetAttribute(&cus, hipDeviceAttributeMultiprocessorCount, dev);
    hipOccupancyMaxActiveBlocksPerMultiprocessor(&per_cu, mega_kernel, NTHREADS, 0);
    if (per_cu > 2) per_cu = 2;
    grid_blocks = cus * per_cu;
    if (grid_blocks <= 0) { fprintf(stderr, "kernel_launch: occupancy query failed (cus %d per_cu %d)\n", cus, per_cu); grid_blocks = 0; return; }
  }
  void* args[] = {&p};
  hipError_t e = hipLaunchCooperativeKernel((void*)mega_kernel, dim3(grid_blocks), dim3(NTHREADS), args, 0, stream);
  if (e != hipSuccess) fprintf(stderr, "cooperative launch failed: %s (grid %d)\n", hipGetErrorString(e), grid_blocks);
#else
  const int G = 1024;
  hipLaunchKernelGGL(phase_kernel<0>, dim3(G), dim3(NTHREADS), 0, stream, p);
  hipLaunchKernelGGL(phase_kernel<1>, dim3(G), dim3(NTHREADS), 0, stream, p);
  hipLaunchKernelGGL(phase_kernel<2>, dim3(G), dim3(NTHREADS), 0, stream, p);
  hipLaunchKernelGGL(phase_kernel<3>, dim3(G), dim3(NTHREADS), 0, stream, p);
  hipLaunchKernelGGL(phase_kernel<4>, dim3(G), dim3(NTHREADS), 0, stream, p);
  hipLaunchKernelGGL(phase_kernel<5>, dim3(G), dim3(NTHREADS), 0, stream, p);
  hipLaunchKernelGGL(phase_kernel<6>, dim3(G), dim3(NTHREADS), 0, stream, p);
  hipLaunchKernelGGL(phase_kernel<7>, dim3(G), dim3(NTHREADS), 0, stream, p);
  hipLaunchKernelGGL(phase_kernel<8>, dim3(G), dim3(NTHREADS), 0, stream, p);
  hipLaunchKernelGGL(phase_kernel<9>, dim3(G), dim3(NTHREADS), 0, stream, p);
#endif
}
```

```cpp
#include <hip/hip_runtime.h>
#include <cstdio>
#include <cstdint>

#ifndef MODE_EXACT
#define MODE_EXACT 0
#endif
#ifndef ONE_LAUNCH
#define ONE_LAUNCH 1
#endif
#ifndef ATTN_EXACT
#define ATTN_EXACT MODE_EXACT
#endif
#ifndef PHASE_ONLY
#define PHASE_ONLY -1
#endif
#ifndef TIMING_PROBE
#define TIMING_PROBE 0
#endif
#ifndef PROBE_A_MASK
#define PROBE_A_MASK 0
#endif
#ifndef PROBE_R_MASK
#define PROBE_R_MASK 0
#endif
#ifndef PROBE_R_SCALE
#define PROBE_R_SCALE 0.002f
#endif
#ifndef GEMM_EXACT
#define GEMM_EXACT MODE_EXACT
#endif

#define DEVI __device__ __forceinline__

typedef unsigned short bf16_t;
typedef short bf16x8 __attribute__((ext_vector_type(8)));
typedef short s16x4 __attribute__((ext_vector_type(4)));
typedef float f32x16 __attribute__((ext_vector_type(16)));
typedef float f32x4 __attribute__((ext_vector_type(4)));
typedef unsigned u32x4 __attribute__((ext_vector_type(4)));

#if MODE_EXACT
typedef float act_t;
#else
typedef bf16_t act_t;
#endif

constexpr int DM = 1024, NBATCH = 2, SEQ = 8192, CTXL = 256, RB = SEQ + CTXL  , RR = NBATCH * RB  , TT = NBATCH * SEQ  ;
constexpr int GW = 64, GROWS = 128;
constexpr int QL = 384, KVL = 256, NPROJ = 2304  , NPROJ_REAL = 2208;
constexpr int NEXP = 16, DEXP = 512;
constexpr float EPS = 1e-6f, LOG2E = 1.4426950408889634f;
constexpr float QSCALE = 0.10206207261596577f * 1.4426950408889634f;
constexpr float NASCALE = 0.125f * 1.4426950408889634f;
constexpr int HIDROWS = 36864;
constexpr int NTHREADS = 512, NWAVES = 8;

constexpr size_t AS = sizeof(act_t);
constexpr size_t OFF_BAR   = 0;
constexpr size_t OFF_CNT   = 16384;
constexpr size_t OFF_MOD   = OFF_CNT + 256;
constexpr size_t OFF_ROPE  = OFF_MOD + 3 * 6144 * 4;
constexpr size_t OFF_SSQ   = OFF_ROPE + 2 * 128 * 8 * 4;
constexpr size_t OFF_SSKV  = OFF_SSQ + (size_t)RR * 12 * 4;
constexpr size_t OFF_BT    = OFF_SSKV + (size_t)RR * 8 * 4;
constexpr size_t OFF_ELIST = OFF_BT + (size_t)8 * 15 * 4096 * 4;
constexpr size_t OFF_EW    = OFF_ELIST + (size_t)NEXP * TT * 4;
constexpr size_t OFF_WRT   = OFF_EW + (size_t)NEXP * TT * 4;
constexpr size_t OFF_KMAX  = OFF_WRT + 20 * 1024 * 4;
constexpr size_t SMALL_END = OFF_KMAX + 512;
static_assert(SMALL_END <= (size_t)8 << 20, "small region");
constexpr size_t OFF_W     = (size_t)8 << 20;
#if MODE_EXACT
constexpr size_t W_BYTES = 0;
#else
constexpr size_t W_BYTES = (size_t)60 << 20;
#endif
constexpr size_t OFF_WIN  = OFF_W;
constexpr size_t OFF_WUQ  = OFF_WIN + (size_t)NPROJ * 1024 * 2;
constexpr size_t OFF_WUKV = OFF_WUQ + (size_t)768 * 384 * 2;
constexpr size_t OFF_WOUT = OFF_WUKV + (size_t)1024 * 256 * 2;
constexpr size_t OFF_WGU  = OFF_WOUT + (size_t)1024 * 1024 * 2;
constexpr size_t OFF_WD   = OFF_WGU + (size_t)16 * 1024 * 1024 * 2;
constexpr size_t W_END    = OFF_WD + (size_t)16 * 1024 * 512 * 2;
static_assert(MODE_EXACT || W_END <= OFF_W + W_BYTES, "weights region");
constexpr size_t G0 = OFF_W + W_BYTES;
constexpr size_t OFF_HXALL = G0;
constexpr size_t OFF_KV    = OFF_HXALL;
constexpr size_t OFF_NAQ   = OFF_HXALL + (size_t)RR * 1024 * AS;
constexpr size_t OFF_NAK   = OFF_NAQ + (size_t)RR * 512 * AS;
constexpr size_t OFF_NAV   = OFF_NAK + (size_t)RR * 512 * AS;
constexpr size_t OFF_KROPE = OFF_NAV + (size_t)RR * 512 * AS;
constexpr size_t OFF_QLAT  = OFF_KROPE + (size_t)RR * 32 * AS;
constexpr size_t OFF_KVLAT = OFF_QLAT + (size_t)RR * 384 * AS;
constexpr size_t OFF_ATTN  = OFF_QLAT;
constexpr size_t ATT_END   = OFF_ATTN + (size_t)TT * 1024 * AS;
constexpr size_t OFF_YBUF  = G0;
constexpr size_t OFF_HX2   = G0;
constexpr size_t OFF_HID   = OFF_YBUF + (size_t)2 * TT * 1024 * AS;
constexpr size_t MOE_END   = OFF_HID + (size_t)HIDROWS * 512 * AS;
constexpr size_t OFF_X1    = ATT_END > MOE_END ? ATT_END : MOE_END;
constexpr size_t WS_NEED   = OFF_X1 + (size_t)TT * 1024 * AS;
static_assert(MODE_EXACT || WS_NEED <= ((size_t)256 << 20), "workspace");

struct Params {
  const float *x, *c, *ctx, *c_ctx, *w_mod, *b_mod, *g_attn, *g_ffn, *w_in, *g_q, *g_kv, *w_uq, *w_ukv, *rel_bias, *w_out,
              *w_rg, *b_rg, *w_re, *b_re, *w_gate, *w_up, *w_down, *g_final;
  float* out; char* ws;
};

DEVI float bf2f(bf16_t v) { return __uint_as_float(((unsigned)v) << 16); }
DEVI bf16_t f2bf(float f) { unsigned u = __float_as_uint(f); u += 0x7fffu + ((u >> 16) & 1u); return (bf16_t)(u >> 16); }
typedef __bf16 bf16x2_t __attribute__((ext_vector_type(2)));
typedef float f32x2_t __attribute__((ext_vector_type(2)));
DEVI unsigned pk2(float lo, float hi) { const f32x2_t v = {lo, hi}; return __builtin_bit_cast(unsigned, __builtin_convertvector(v, bf16x2_t)); }
DEVI float a2f(float v) { return v; }
DEVI float a2f(bf16_t v) { return bf2f(v); }
DEVI void ld4(const float* p, float (&v)[4]) { const float4 t = *(const float4*)p; v[0] = t.x; v[1] = t.y; v[2] = t.z; v[3] = t.w; }
DEVI void ld4(const bf16_t* p, float (&v)[4]) { const uint2 t = *(const uint2*)p; v[0] = __uint_as_float(t.x << 16); v[1] = __uint_as_float(t.x & 0xffff0000u); v[2] = __uint_as_float(t.y << 16); v[3] = __uint_as_float(t.y & 0xffff0000u); }
DEVI void st4(float* p, float a, float b, float c, float d) { *(float4*)p = make_float4(a, b, c, d); }
DEVI void st4(bf16_t* p, float a, float b, float c, float d) { uint2 t; t.x = pk2(a, b); t.y = pk2(c, d); *(uint2*)p = t; }
DEVI void st1(float* p, float a) { *p = a; }
DEVI void st1(bf16_t* p, float a) { *p = f2bf(a); }
DEVI int crow(int r, int hi) { return (r & 3) + 8 * (r >> 2) + 4 * hi; }
DEVI float wave_sum(float v) { v += __shfl_xor(v, 32); v += __shfl_xor(v, 16); v += __shfl_xor(v, 8); v += __shfl_xor(v, 4); v += __shfl_xor(v, 2); v += __shfl_xor(v, 1); return v; }
DEVI float half_sum32(float v) { v += __shfl_xor(v, 16); v += __shfl_xor(v, 8); v += __shfl_xor(v, 4); v += __shfl_xor(v, 2); v += __shfl_xor(v, 1); return v; }
DEVI float xhalf_max(float v) { auto rr = __builtin_amdgcn_permlane32_swap(__float_as_uint(v), __float_as_uint(v), false, false); return fmaxf(__uint_as_float(rr[0]), __uint_as_float(rr[1])); }
DEVI float xhalf_sum(float v) { auto rr = __builtin_amdgcn_permlane32_swap(__float_as_uint(v), __float_as_uint(v), false, false); return __uint_as_float(rr[0]) + __uint_as_float(rr[1]); }
DEVI float silu_f(float v) { return v / (1.f + expf(-v)); }
DEVI float silu_fast(float v) { return v * __builtin_amdgcn_rcpf(1.f + __builtin_amdgcn_exp2f(-v * LOG2E)); }

DEVI int xcd_unit(int v, int U) { const int chunk = (U + 7) >> 3; const int x = v & 7, j = v >> 3; if (j >= chunk) return -1; const int u = x * chunk + j; return u < U ? u : -1; }
DEVI void panel_order(int idx, int nM, int nN, int& tm, int& tn) { const int nig = 8 * nN, gid = idx / nig, fm = gid * 8, gsz = (nM - fm) < 8 ? (nM - fm) : 8, r = idx - gid * nig; tm = fm + r % gsz; tn = r / gsz; }
DEVI int xcd_iters(int U, int nb) { const int chunk = (U + 7) >> 3; return (chunk * 8 + nb - 1) / nb; }

struct WInAcc { const float* w; static constexpr int LD = NPROJ_REAL;
  DEVI const float* col(int n, float& msk) const { const int o = n < 1152 ? n : (n < 2176 ? n + 32 : n - 1024); const bool ok = n < 2208; msk = ok ? 1.f : 0.f; return w + (ok ? o : 0); }
  DEVI float kscale(int) const { return 1.f; }
  DEVI float at(int k, int n) const { int o; if (n < 1152) o = n; else if (n < 2176) o = n + 32; else if (n < 2208) o = n - 1024; else return 0.f; return w[(size_t)k * NPROJ_REAL + o]; } };
struct WUqAcc { const float* w; const float* g; static constexpr int LD = 768;
  DEVI const float* col(int n, float& msk) const { msk = 1.f; return w + n; }
  DEVI float kscale(int k) const { return g[k]; }
  DEVI float at(int k, int n) const { return g[k] * w[(size_t)k * 768 + n]; } };
struct WUkvAcc { const float* w; const float* g; static constexpr int LD = 1024;
  DEVI const float* col(int n, float& msk) const { msk = 1.f; return w + n; }
  DEVI float kscale(int k) const { return g[k]; }
  DEVI float at(int k, int n) const { return g[k] * w[(size_t)k * 1024 + n]; } };
struct WOutAcc { const float* w; static constexpr int LD = 1024;
  DEVI const float* col(int n, float& msk) const { msk = 1.f; return w + n; }
  DEVI float kscale(int) const { return 1.f; }
  DEVI float at(int k, int n) const { return w[(size_t)k * 1024 + n]; } };
struct WGUAcc { const float* wg; const float* wu;
  static constexpr int LD = 512;
  DEVI const float* col(int n, float& msk) const { const int g = n >> 3, j = n & 7; msk = 1.f;
    const unsigned long long a = (unsigned long long)wg, b = (unsigned long long)wu;
    const unsigned lo = j < 4 ? (unsigned)a : (unsigned)b, hi = j < 4 ? (unsigned)(a >> 32) : (unsigned)(b >> 32);
    return (const float*)(((unsigned long long)hi << 32) | lo) + g * 4 + (j & 3); }
  DEVI float kscale(int) const { return 1.f; }
  DEVI float at(int k, int n) const { const int g = n >> 3, j = n & 7; return j < 4 ? wg[(size_t)k * 512 + g * 4 + j] : wu[(size_t)k * 512 + g * 4 + j - 4]; } };
struct WDAcc { const float* w; static constexpr int LD = 1024;
  DEVI const float* col(int n, float& msk) const { msk = 1.f; return w + n; }
  DEVI float kscale(int) const { return 1.f; }
  DEVI float at(int k, int n) const { return w[(size_t)k * 1024 + n]; } };

namespace g8 {
#define G8_LAS __attribute__((address_space(3)))
constexpr int BM = 256, BK = 64, HALF = 128, HTB = HALF * BK * 2  , STAGE_BYTES = 8 * HTB;
DEVI int lds_byte(int r, int c) { const int st = (r >> 4) * 2 + (c >> 5), rr = r & 15, cc = c & 31, ob = rr * 64 + cc * 2; return st * 1024 + (ob ^ (((ob >> 9) & 1) << 5)); }
DEVI void stage_rc(int b, int& R, int& C) { const int st = b / 1024, sb = b % 1024, swz = sb ^ (((sb >> 9) & 1) << 5); R = (st >> 1) * 16 + swz / 64; C = (st & 1) * 32 + (swz % 64) / 2; }
DEVI int perm32(int rho) { const int n = rho >> 4, i = rho & 15; return 8 * (i >> 2) + 4 * n + (i & 3); }
struct Unit { int pm, pn; };
template <class Epi, class Sched, bool GATHER, int K>
DEVI void gemm_phase(G8_LAS unsigned char* lds, const bf16_t* A, const bf16_t* Bt, const Sched& S, const Epi& E) {
  int tid = threadIdx.x; asm volatile("" : "+v"(tid));
  const int wid = __builtin_amdgcn_readfirstlane(tid >> 6), lane = tid & 63, wr = wid >> 2, wc = wid & 3, fr = lane & 15, fq = lane >> 4;
  constexpr int nt = K / BK;
  int sR[2], sC[2]; unsigned voffB[2];
#pragma unroll
  for (int i = 0; i < 2; ++i) { int R, C; stage_rc(tid * 16 + i * 8192, R, C); sR[i] = R; sC[i] = C; const int Rb = (R & ~31) + perm32(R & 31); voffB[i] = (unsigned)(Rb * K + C) * 2u; }
  constexpr size_t kstep = (size_t)(BK * 2);
  constexpr size_t hstep = (size_t)HALF * K * 2;
  constexpr size_t tstep = 2 * hstep;
  const unsigned ldsw = (unsigned)wid * 1024u;
  const int aoff = lds_byte(wr * 64 + fr, fq * 8), boff = lds_byte(wc * 32 + fr, fq * 8);
#define PG8_SA(b, h) (((b) * 2 + (h)) * HTB)
#define PG8_SB(b, h) ((4 + (b) * 2 + (h)) * HTB)
#define PG8_STAGE(bufoff, gbase, voff) do { _Pragma("unroll") for (int _i = 0; _i < 2; ++_i) \
        __builtin_amdgcn_global_load_lds((const unsigned*)((const char*)(gbase) + (voff)[_i]), (G8_LAS unsigned*)(lds + (bufoff) + ldsw + _i * 8192), 16, 0, 0); } while (0)
#define PG8_LDA(dst, b, h) do { _Pragma("unroll") for (int m = 0; m < 4; ++m) _Pragma("unroll") for (int k = 0; k < 2; ++k) dst[m][k] = *(const G8_LAS bf16x8*)(lds + PG8_SA(b, h) + aoff + m * 2048 + k * 1024); } while (0)
#define PG8_LDB(dst, b, h) do { _Pragma("unroll") for (int n = 0; n < 2; ++n) _Pragma("unroll") for (int k = 0; k < 2; ++k) dst[n][k] = *(const G8_LAS bf16x8*)(lds + PG8_SB(b, h) + boff + n * 2048 + k * 1024); } while (0)
#define PG8_MMA(ai, bj, At, Bt_) do { __builtin_amdgcn_s_setprio(1); _Pragma("unroll") for (int m = 0; m < 4; ++m) _Pragma("unroll") for (int n = 0; n < 2; ++n) _Pragma("unroll") for (int k = 0; k < 2; ++k) \
        acc[ai][bj][m][n] = __builtin_amdgcn_mfma_f32_16x16x32_bf16(Bt_[n][k], At[m][k], acc[ai][bj][m][n], 0, 0, 0); __builtin_amdgcn_s_setprio(0); } while (0)
#define PG8_WAIT_V(n) asm volatile("s_waitcnt vmcnt(" #n ")" ::: "memory")
#define PG8_WAIT_L(n) asm volatile("s_waitcnt lgkmcnt(" #n ")" ::: "memory")
#define PG8_BAR __builtin_amdgcn_s_barrier()
#define PG8_SCHED __builtin_amdgcn_sched_barrier(0)
  Unit cur, nxt; int ui = 0;
  if (!S.next(0, cur)) return;
  f32x4 acc[2][2][4][2];
#pragma unroll
  for (int a = 0; a < 2; ++a)
#pragma unroll
    for (int b = 0; b < 2; ++b)
#pragma unroll
      for (int m = 0; m < 4; ++m)
#pragma unroll
        for (int n = 0; n < 2; ++n) acc[a][b][m][n] = (f32x4){0.f, 0.f, 0.f, 0.f};
  bf16x8 At[4][2], B0[2][2], B1[2][2];
  unsigned vA0[2], vA1[2];
#define G8_SETV(U_, V0, V1) do { _Pragma("unroll") for (int _i = 0; _i < 2; ++_i) { \
      V0[_i] = (unsigned)S.arow(U_, sR[_i]) * (unsigned)(K * 2) + (unsigned)(sC[_i] * 2); V1[_i] = (unsigned)S.arow(U_, 128 + sR[_i]) * (unsigned)(K * 2) + (unsigned)(sC[_i] * 2); } } while (0)
  if (GATHER) { G8_SETV(cur, vA0, vA1); }
  else {
#pragma unroll
    for (int i = 0; i < 2; ++i) { vA0[i] = (unsigned)(sR[i] * K + sC[i]) * 2u; vA1[i] = vA0[i]; } }
  constexpr size_t hA = GATHER ? (size_t)0 : hstep;
  const char* cA = GATHER ? (const char*)A : (const char*)A + (size_t)cur.pm * tstep; const char* cB = (const char*)Bt + (size_t)cur.pn * tstep;
  PG8_STAGE(PG8_SB(0, 0), cB, voffB); PG8_STAGE(PG8_SA(0, 0), cA, vA0); PG8_STAGE(PG8_SB(0, 1), cB + hstep, voffB); PG8_STAGE(PG8_SA(0, 1), cA + hA, vA1);
  if (wr == 1) PG8_BAR;
  PG8_WAIT_V(4); PG8_BAR;
  PG8_STAGE(PG8_SB(1, 0), cB + kstep, voffB); PG8_STAGE(PG8_SA(1, 0), cA + kstep, vA0); PG8_STAGE(PG8_SB(1, 1), cB + hstep + kstep, voffB);
  PG8_WAIT_V(6); PG8_BAR;
  for (;;) {
    const bool has_next = S.next(ui + 1, nxt);
    const char* nA = has_next ? (GATHER ? (const char*)A : (const char*)A + (size_t)nxt.pm * tstep) : cA; const char* nB = has_next ? (const char*)Bt + (size_t)nxt.pn * tstep : cB;
#pragma unroll 1
    for (int t = 0; t < nt; t += 2) {
      const bool last = (t == nt - 2);
      const char* a1 = cA + (size_t)(t + 1) * kstep;
      const char* a2 = last ? nA : cA + (size_t)(t + 2) * kstep; const char* b2 = last ? nB : cB + (size_t)(t + 2) * kstep;
      const char* a3 = a2 + kstep; const char* b3 = b2 + kstep;
      PG8_LDB(B0, 0, 0); PG8_SCHED; PG8_LDA(At, 0, 0); PG8_STAGE(PG8_SA(1, 1), a1 + hA, vA1);
      PG8_WAIT_L(8); PG8_BAR; PG8_WAIT_L(0); PG8_MMA(0, 0, At, B0); PG8_BAR; PG8_SCHED;
      if (GATHER) { if (last && has_next) { G8_SETV(nxt, vA0, vA1); } }
      PG8_LDB(B1, 0, 1); PG8_STAGE(PG8_SB(0, 0), b2, voffB);
      PG8_BAR; PG8_WAIT_L(0); PG8_MMA(0, 1, At, B1); PG8_BAR;
      PG8_LDA(At, 0, 1); PG8_STAGE(PG8_SA(0, 0), a2, vA0);
      PG8_BAR; PG8_WAIT_L(0); PG8_MMA(1, 0, At, B0); PG8_BAR; PG8_SCHED;
      PG8_STAGE(PG8_SB(0, 1), b2 + hstep, voffB);
      PG8_WAIT_V(6); PG8_BAR; PG8_MMA(1, 1, At, B1); PG8_BAR;
      PG8_LDB(B0, 1, 0); PG8_SCHED; PG8_LDA(At, 1, 0); PG8_STAGE(PG8_SA(0, 1), a2 + hA, vA1);
      PG8_WAIT_L(8); PG8_BAR; PG8_WAIT_L(0); PG8_MMA(0, 0, At, B0); PG8_BAR; PG8_SCHED;
      PG8_LDB(B1, 1, 1); PG8_STAGE(PG8_SB(1, 0), b3, voffB);
      PG8_BAR; PG8_WAIT_L(0); PG8_MMA(0, 1, At, B1); PG8_BAR;
      PG8_LDA(At, 1, 1); PG8_STAGE(PG8_SA(1, 0), a3, vA0);
      PG8_BAR; PG8_WAIT_L(0); PG8_MMA(1, 0, At, B0); PG8_BAR; PG8_SCHED;
      PG8_STAGE(PG8_SB(1, 1), b3 + hstep, voffB);
      PG8_WAIT_V(6); PG8_BAR; PG8_MMA(1, 1, At, B1); PG8_BAR;
    }
    E(acc, cur, wr, wc, fr, fq);
    if (!has_next) break;
#pragma unroll
    for (int a = 0; a < 2; ++a)
#pragma unroll
      for (int b = 0; b < 2; ++b)
#pragma unroll
        for (int m = 0; m < 4; ++m)
#pragma unroll
          for (int n = 0; n < 2; ++n) acc[a][b][m][n] = (f32x4){0.f, 0.f, 0.f, 0.f};
    cur = nxt; cA = nA; cB = nB; ++ui;
  }
  PG8_WAIT_V(0);
  if (wr == 0) PG8_BAR;
  PG8_BAR;
#undef G8_SETV
#undef PG8_SA
#undef PG8_SB
#undef PG8_STAGE
#undef PG8_LDA
#undef PG8_LDB
#undef PG8_MMA
#undef PG8_WAIT_V
#undef PG8_WAIT_L
#undef PG8_BAR
#undef PG8_SCHED
}
}

constexpr int PH_BYTES = 139264;
constexpr int SM_BARW  = PH_BYTES;
constexpr int SM_TAB   = PH_BYTES + 32;
constexpr int SM_PTR   = PH_BYTES + 32 + 160;
constexpr int LDS_TOTAL = PH_BYTES + 32 + 160 + 208;
constexpr int KM_KN = 0;
constexpr int KM_KR = 32;
constexpr int KM_NA = 40;
constexpr int KM_BM = 80;

DEVI void store8(bf16_t* p, const f32x4& a, const f32x4& b) { u32x4 w = {pk2(a[0], a[1]), pk2(a[2], a[3]), pk2(b[0], b[1]), pk2(b[2], b[3])}; *(u32x4*)p = w; }
DEVI float sumsq8(const f32x4& a, const f32x4& b) { return a[0] * a[0] + a[1] * a[1] + a[2] * a[2] + a[3] * a[3] + b[0] * b[0] + b[1] * b[1] + b[2] * b[2] + b[3] * b[3]; }
DEVI float fq_sum(float v) { v += __shfl_xor(v, 16); v += __shfl_xor(v, 32); return v; }
DEVI float fr_max(float v) { v = fmaxf(v, __shfl_xor(v, 1)); v = fmaxf(v, __shfl_xor(v, 2)); v = fmaxf(v, __shfl_xor(v, 4)); v = fmaxf(v, __shfl_xor(v, 8)); return v; }
DEVI void rope8(f32x4& v0, f32x4& v1, int fq, int gr, int gc, const float* rc, const float* rs) {
  const int pb = ((fq & 1) ? gc : gr) * 8;
  float x[8] = {v0[0], v0[1], v0[2], v0[3], v1[0], v1[1], v1[2], v1[3]};
#pragma unroll
  for (int e = 0; e < 8; ++e) { const float y = __shfl_xor(x[e], 32); const float cs = rc[pb + e], sn = rs[pb + e];
    x[e] = fq < 2 ? x[e] * cs - y * sn : y * sn + x[e] * cs; }
  v0 = (f32x4){x[0], x[1], x[2], x[3]}; v1 = (f32x4){x[4], x[5], x[6], x[7]};
}

struct SchedGrid {
  int nM, nN, U, nb, bid, mskip;
  DEVI bool next(int i, g8::Unit& u) const { const int x = xcd_unit(bid + i * nb, U); if (x < 0) return false; int tm, tn; panel_order(x, nM, nN, tm, tn); u.pm = mskip ? tm + 1 + tm / 32 : tm; u.pn = tn; return true; }
  DEVI unsigned arow(const g8::Unit&, int) const { return 0u; }
};
typedef const int __attribute__((address_space(3))) las_cint;
struct SchedMoe {
  las_cint* tab; const int* elist; int MT, U, nb, bid;
  DEVI bool next(int i, g8::Unit& u) const { const int x = xcd_unit(bid + i * nb, U); if (x < 0) return false; int mt, tn; panel_order(x, MT, 4, mt, tn);
    int e = 0;
#pragma unroll
    for (int q = 1; q < 16; ++q) e += (mt >= tab[q]) ? 1 : 0;
    u.pm = mt; u.pn = e * 4 + tn; return true; }
  DEVI unsigned arow(const g8::Unit& u, int r) const { const int e = u.pn >> 2, slot = (u.pm - tab[e]) * 256 + r; return slot < tab[17 + e] ? (unsigned)(elist[(size_t)e * TT + slot] >> 1) : 0u; }
};
DEVI void moe_table(const Params& p, char* smem) {
  if (threadIdx.x == 0) { int* tab = (int*)(smem + SM_TAB); const int* cnt = (const int*)(p.ws + OFF_CNT); int acc = 0;
    for (int e = 0; e < 16; ++e) { tab[e] = acc; tab[17 + e] = cnt[e]; acc += (cnt[e] + 255) >> 8; } tab[16] = acc; }
  __syncthreads();
}

#define EPI_ROWS for (int ai = 0; ai < 2; ++ai) _Pragma("unroll") for (int m = 0; m < 4; ++m)
struct EpiProj8 { const Params* p;
  DEVI void operator()(const f32x4 (&acc)[2][2][4][2], const g8::Unit& u, int wr, int wc, int fr, int fq) const {
    char* ws = p->ws; const int b = (u.pm * 256) / RB;
    const float* rc = (const float*)(ws + OFF_ROPE); const float* rs = rc + 1024;
#pragma unroll
    for (int bj = 0; bj < 2; ++bj) {
      const int gc = u.pn * 256 + bj * 128 + wc * 32;
      float rmx = 0.f;
#pragma unroll
      EPI_ROWS {
        const int row = u.pm * 256 + ai * 128 + wr * 64 + m * 16 + fr;
        f32x4 v0 = acc[ai][bj][m][0], v1 = acc[ai][bj][m][1];
        if (gc < 384) { store8((bf16_t*)(ws + OFF_QLAT) + (size_t)row * 384 + gc + 8 * fq, v0, v1);
          const float ss = fq_sum(sumsq8(v0, v1)); if (fq == 0) ((float*)(ws + OFF_SSQ))[(size_t)row * 12 + (gc >> 5)] = ss; }
        else if (gc < 896) { store8((bf16_t*)(ws + OFF_NAQ) + (size_t)row * 512 + (gc - 384) + 8 * fq, v0 * NASCALE, v1 * NASCALE); }
        else if (gc < 1152) { store8((bf16_t*)(ws + OFF_KVLAT) + (size_t)row * 256 + (gc - 896) + 8 * fq, v0, v1);
          const float ss = fq_sum(sumsq8(v0, v1)); if (fq == 0) ((float*)(ws + OFF_SSKV))[(size_t)row * 8 + ((gc - 896) >> 5)] = ss; }
        else if (gc < 1664) { store8((bf16_t*)(ws + OFF_NAK) + (size_t)row * 512 + (gc - 1152) + 8 * fq, v0, v1); rmx = fmaxf(rmx, fq_sum(sumsq8(v0, v1))); }
        else if (gc < 2176) { store8((bf16_t*)(ws + OFF_NAV) + (size_t)row * 512 + (gc - 1664) + 8 * fq, v0, v1); }
        else if (gc == 2176) { const int rb = row % RB;
          if (rb >= CTXL) { const int pos = rb - CTXL; rope8(v0, v1, fq, pos >> 6, pos & 63, rc, rs); }
          store8((bf16_t*)(ws + OFF_KROPE) + (size_t)row * 32 + 8 * fq, v0, v1); rmx = fmaxf(rmx, fq_sum(sumsq8(v0, v1))); }
      }
      if (gc >= 1152 && gc < 1664) { rmx = fr_max(rmx); if ((threadIdx.x & 63) == 0) atomicMax((unsigned*)(ws + OFF_KMAX) + KM_NA + b * 16 + ((gc - 1152) >> 5), __float_as_uint(rmx)); }
      if (gc == 2176) { rmx = fr_max(rmx); if ((threadIdx.x & 63) == 0) atomicMax((unsigned*)(ws + OFF_KMAX) + KM_KR + b, __float_as_uint(rmx)); }
    }
  } };

struct EpiQm8 { const Params* p;
  DEVI void operator()(const f32x4 (&acc)[2][2][4][2], const g8::Unit& u, int wr, int wc, int fr, int fq) const {
    char* ws = p->ws; bf16_t* qm = (bf16_t*)p->out;
    const float* rc = (const float*)(ws + OFF_ROPE); const float* rs = rc + 1024;
    float sc8[2][4];
#pragma unroll
    for (int ai = 0; ai < 2; ++ai)
#pragma unroll
      for (int m = 0; m < 4; ++m) { const int row = u.pm * 256 + ai * 128 + wr * 64 + m * 16 + fr;
        const f32x4* sp = (const f32x4*)((const float*)(ws + OFF_SSQ) + (size_t)row * 12); f32x4 s0 = {0.f, 0.f, 0.f, 0.f}; if (fq < 3) s0 = sp[fq];
        sc8[ai][m] = (s0[0] + s0[1]) + (s0[2] + s0[3]); }
#pragma unroll
    for (int ai = 0; ai < 2; ++ai)
#pragma unroll
      for (int m = 0; m < 4; ++m) sc8[ai][m] = rsqrtf(fq_sum(sc8[ai][m]) * (1.f / 384.f) + EPS) * QSCALE;
    {
#pragma unroll
    EPI_ROWS {
      const int row = u.pm * 256 + ai * 128 + wr * 64 + m * 16 + fr; const int pos = row % RB - CTXL;
      const float sc = sc8[ai][m];
#pragma unroll
      for (int bj = 0; bj < 2; ++bj) { const int gc = u.pn * 256 + bj * 128 + wc * 32;
        f32x4 v0 = acc[ai][bj][m][0], v1 = acc[ai][bj][m][1];
        if ((gc % 96) == 64) rope8(v0, v1, fq, pos >> 6, pos & 63, rc, rs);
        store8(qm + (size_t)row * 768 + gc + 8 * fq, v0 * sc, v1 * sc); }
    }
    }
  } };

struct EpiKv8 { const Params* p;
  DEVI void operator()(const f32x4 (&acc)[2][2][4][2], const g8::Unit& u, int wr, int wc, int fr, int fq) const {
    char* ws = p->ws; const int b = (u.pm * 256) / RB; float rmx[2] = {0.f, 0.f};
    float sc8[2][4];
#pragma unroll
    for (int ai = 0; ai < 2; ++ai)
#pragma unroll
      for (int m = 0; m < 4; ++m) { const int row = u.pm * 256 + ai * 128 + wr * 64 + m * 16 + fr;
        const f32x4* sp = (const f32x4*)((const float*)(ws + OFF_SSKV) + (size_t)row * 8); f32x4 s0 = {0.f, 0.f, 0.f, 0.f}; if (fq < 2) s0 = sp[fq];
        sc8[ai][m] = (s0[0] + s0[1]) + (s0[2] + s0[3]); }
#pragma unroll
    for (int ai = 0; ai < 2; ++ai)
#pragma unroll
      for (int m = 0; m < 4; ++m) sc8[ai][m] = rsqrtf(fq_sum(sc8[ai][m]) * (1.f / 256.f) + EPS);
#pragma unroll
    EPI_ROWS {
      const int row = u.pm * 256 + ai * 128 + wr * 64 + m * 16 + fr; const float sc = sc8[ai][m];
#pragma unroll
      for (int bj = 0; bj < 2; ++bj) { const int gc = u.pn * 256 + bj * 128 + wc * 32;
        const f32x4 v0 = acc[ai][bj][m][0] * sc, v1 = acc[ai][bj][m][1] * sc;
        store8((bf16_t*)(ws + OFF_KV) + (size_t)row * 1024 + gc + 8 * fq, v0, v1);
        if ((gc & 127) < 64) rmx[bj] = fmaxf(rmx[bj], fq_sum(sumsq8(v0, v1))); }
    }
#pragma unroll
    for (int bj = 0; bj < 2; ++bj) { const int gc = u.pn * 256 + bj * 128 + wc * 32;
      if ((gc & 127) < 64) { const float r = fr_max(rmx[bj]); if ((threadIdx.x & 63) == 0) atomicMax((unsigned*)(ws + OFF_KMAX) + KM_KN + b * 16 + (gc >> 7) * 2 + ((gc >> 5) & 1), __float_as_uint(r)); } }
  } };

struct EpiOut8 { const Params* p;
  DEVI void operator()(const f32x4 (&acc)[2][2][4][2], const g8::Unit& u, int wr, int wc, int fr, int fq) const {
    const float* mod = (const float*)(p->ws + OFF_MOD); const int b = (u.pm * 256) >> 13;
    f32x4 gv[2][2];
#pragma unroll
    for (int bj = 0; bj < 2; ++bj) { const f32x4* gp = (const f32x4*)(mod + b * 6144 + 2048 + u.pn * 256 + bj * 128 + wc * 32 + 8 * fq); gv[bj][0] = gp[0]; gv[bj][1] = gp[1]; }
#pragma unroll
    for (int ai = 0; ai < 2; ++ai)
#pragma unroll
      for (int mh = 0; mh < 2; ++mh) {
        f32x4 xv[2][2][2];
#pragma unroll
        for (int mm = 0; mm < 2; ++mm)
#pragma unroll
          for (int bj = 0; bj < 2; ++bj) { const int m = mh * 2 + mm, tok = u.pm * 256 + ai * 128 + wr * 64 + m * 16 + fr, n = u.pn * 256 + bj * 128 + wc * 32 + 8 * fq;
            const f32x4* xp = (const f32x4*)(p->x + (size_t)tok * 1024 + n); xv[mm][bj][0] = xp[0]; xv[mm][bj][1] = xp[1]; }
#pragma unroll
        for (int mm = 0; mm < 2; ++mm)
#pragma unroll
          for (int bj = 0; bj < 2; ++bj) { const int m = mh * 2 + mm, tok = u.pm * 256 + ai * 128 + wr * 64 + m * 16 + fr, n = u.pn * 256 + bj * 128 + wc * 32 + 8 * fq;
            act_t* op = (act_t*)(p->ws + OFF_X1) + (size_t)tok * 1024 + n;
            const f32x4 r0 = xv[mm][bj][0] + gv[bj][0] * acc[ai][bj][m][0], r1 = xv[mm][bj][1] + gv[bj][1] * acc[ai][bj][m][1];
#if MODE_EXACT
            st4(op, r0[0], r0[1], r0[2], r0[3]); st4(op + 4, r1[0], r1[1], r1[2], r1[3]);
#else
            store8(op, r0, r1);
#endif
          }
      }
  } };

struct EpiGU8 { const Params* p; las_cint* tab;
  DEVI void operator()(const f32x4 (&acc)[2][2][4][2], const g8::Unit& u, int wr, int wc, int fr, int fq) const {
    bf16_t* hid = (bf16_t*)(p->ws + OFF_HID); const int e = u.pn >> 2, tn = u.pn & 3, slot0 = (u.pm - tab[e]) * 256, cnt = tab[17 + e];
    const float* ew = (const float*)(p->ws + OFF_EW) + (size_t)e * TT;
    float cw[2][4];
#pragma unroll
    for (int ai = 0; ai < 2; ++ai)
#pragma unroll
      for (int m = 0; m < 4; ++m) { const int slot = slot0 + ai * 128 + wr * 64 + m * 16 + fr; cw[ai][m] = slot < cnt ? ew[slot] : 0.f; }
#pragma unroll
    EPI_ROWS {
      const int r = ai * 128 + wr * 64 + m * 16 + fr; const bool valid = slot0 + r < cnt; const float c = cw[ai][m];
#pragma unroll
      for (int bj = 0; bj < 2; ++bj) { const int n = tn * 256 + bj * 128 + wc * 32 + 8 * fq;
        const f32x4 g = acc[ai][bj][m][0], up = acc[ai][bj][m][1]; float o[4];
#pragma unroll
        for (int j = 0; j < 4; ++j) o[j] = valid ? silu_fast(g[j]) * up[j] * c : 0.f;
        st4(hid + (size_t)(u.pm * 256 + r) * 512 + (n >> 1), o[0], o[1], o[2], o[3]); }
    }
  } };

struct EpiDown8 { const Params* p; las_cint* tab;
  DEVI void operator()(const f32x4 (&acc)[2][2][4][2], const g8::Unit& u, int wr, int wc, int fr, int fq) const {
    bf16_t* yb = (bf16_t*)(p->ws + OFF_YBUF); const int e = u.pn >> 2, tn = u.pn & 3, slot0 = (u.pm - tab[e]) * 256, cnt = tab[17 + e];
    const int* el = (const int*)(p->ws + OFF_ELIST) + (size_t)e * TT;
    int tk[2][4];
#pragma unroll
    for (int ai = 0; ai < 2; ++ai)
#pragma unroll
      for (int m = 0; m < 4; ++m) { const int slot = slot0 + ai * 128 + wr * 64 + m * 16 + fr; tk[ai][m] = slot < cnt ? el[slot] : -1; }
#pragma unroll
    EPI_ROWS {
      const int t = tk[ai][m];
      if (t >= 0) { bf16_t* rowp = yb + ((size_t)(t & 1) * TT + (t >> 1)) * 1024 + tn * 256 + wc * 32 + 8 * fq;
#pragma unroll
        for (int bj = 0; bj < 2; ++bj) store8(rowp + bj * 128, acc[ai][bj][m][0], acc[ai][bj][m][1]); }
    }
  } };
#undef EPI_ROWS

DEVI void modgemv_item(const Params& p, int item, char* smem) {
  float* sc = (float*)smem; float* red = sc + 3072;
  const int t = threadIdx.x;
  __syncthreads();
  for (int i = t; i < 3072; i += NTHREADS) { const int ci = i >> 10, k = i & 1023; const float v = ci == 0 ? p.c[k] : ci == 1 ? p.c[1024 + k] : p.c_ctx[k]; sc[i] = silu_f(v); }
  __syncthreads();
  const int cc = t & 31, kg = t >> 5, col = item * 32 + cc;
  float a0 = 0.f, a1 = 0.f, a2 = 0.f;
  { const float* wp = p.w_mod + (size_t)kg * 6144 + col;
#pragma unroll 1
    for (int kb = 0; kb < 1024; kb += 512) {
      float wv[32];
#pragma unroll
      for (int u = 0; u < 32; ++u) wv[u] = wp[(size_t)(kb + 16 * u) * 6144];
#pragma unroll
      for (int u = 0; u < 32; ++u) { const int k = kb + 16 * u + kg; a0 = fmaf(sc[k], wv[u], a0); a1 = fmaf(sc[1024 + k], wv[u], a1); a2 = fmaf(sc[2048 + k], wv[u], a2); }
    } }
  red[(kg * 32 + cc) * 3 + 0] = a0; red[(kg * 32 + cc) * 3 + 1] = a1; red[(kg * 32 + cc) * 3 + 2] = a2;
  __syncthreads();
  if (t < 96) { const int c2 = t & 31, ci = t >> 5; float s = 0.f;
#pragma unroll
    for (int g = 0; g < 16; ++g) s += red[(g * 32 + c2) * 3 + ci];
    ((float*)(p.ws + OFF_MOD))[ci * 6144 + item * 32 + c2] = s + p.b_mod[item * 32 + c2]; }
}

DEVI void misc_item(const Params& p) {
  const int t = threadIdx.x;
  if (t < 16) ((int*)(p.ws + OFF_CNT))[t] = 0;
  if (t < KM_BM) ((unsigned*)(p.ws + OFF_KMAX))[t] = 0u;
  { const int h = t >> 6, lane = t & 63; float bm = 0.f;
    for (int i = lane; i < 15 * 31; i += 64) bm = fmaxf(bm, p.rel_bias[h * 465 + i]);
#pragma unroll
    for (int o = 32; o > 0; o >>= 1) bm = fmaxf(bm, __shfl_xor(bm, o));
    if (lane == 0) ((float*)(p.ws + OFF_KMAX))[KM_BM + h] = bm * LOG2E; }
  float* rc = (float*)(p.ws + OFF_ROPE); float* rs = rc + 1024;
  for (int i = t; i < 1024; i += NTHREADS) {
    const int pos = i >> 3, j = i & 7;
    double f = 1.0; for (int q = 0; q < j; ++q) f *= 0.31622776601683794;
    const double a = (double)pos * f; const double n = rint(a * 0.15915494309189535); const double r = a - n * 6.283185307179586477;
    const double r2 = r * r; double sn = r, cs = 1.0, ts = r, tc = 1.0;
    for (int q = 1; q <= 14; ++q) { tc *= -r2 / (double)((2 * q - 1) * (2 * q)); cs += tc; ts *= -r2 / (double)((2 * q) * (2 * q + 1)); sn += ts; }
    rc[i] = (float)cs; rs[i] = (float)sn;
  }
}
DEVI void wrt_item(const Params& p, int j) {
  float* wrt = (float*)(p.ws + OFF_WRT) + j * 1024;
  for (int k = threadIdx.x; k < 1024; k += NTHREADS) wrt[k] = j < 4 ? p.w_rg[k * 4 + j] : p.w_re[k * 16 + j - 4];
}

DEVI void bt_item(const Params& p, int item) {
  unsigned* bt = (unsigned*)(p.ws + OFF_BT) + (size_t)item * 2048;
  for (int i = threadIdx.x; i < 2048; i += NTHREADS) { const int kc = i >> 6, c = i & 63; int cs = c - 8; cs = cs < 0 ? 0 : (cs > 48 ? 48 : cs);
    const float lo = (kc >= cs && kc < cs + 16) ? p.rel_bias[(size_t)item * 31 + (kc - c + 15)] * LOG2E : -1e30f;
    const int k2 = kc + 32; const float hi = (k2 >= cs && k2 < cs + 16) ? p.rel_bias[(size_t)item * 31 + (k2 - c + 15)] * LOG2E : -1e30f;
    bt[i] = pk2(lo, hi); }
}

struct ConvTile { const float* cp; const float* g; bf16_t* dst; int LD, K, n0, k0; float msk; };
DEVI ConvTile conv_desc(const Params& p, int j, int t) {
  constexpr int C_IN = (NPROJ / 64) * 16, C_UQ = 12 * 6, C_UKV = 16 * 4, C_OUT = 256, C_GU = 16 * 16 * 16;
  ConvTile c; c.g = nullptr; c.msk = 1.f; const int nn = t & 63;
  if (j < C_IN) { WInAcc a{p.w_in}; c.n0 = (j >> 4) * 64; c.k0 = (j & 15) * 64; c.cp = a.col(c.n0 + nn, c.msk); c.LD = WInAcc::LD; c.K = 1024; c.dst = (bf16_t*)(p.ws + OFF_WIN); }
  else if ((j -= C_IN) < C_UQ) { c.n0 = (j / 6) * 64; c.k0 = (j % 6) * 64; c.cp = p.w_uq + c.n0 + nn; c.g = p.g_q; c.LD = 768; c.K = 384; c.dst = (bf16_t*)(p.ws + OFF_WUQ); }
  else if ((j -= C_UQ) < C_UKV) { c.n0 = (j >> 2) * 64; c.k0 = (j & 3) * 64; c.cp = p.w_ukv + c.n0 + nn; c.g = p.g_kv; c.LD = 1024; c.K = 256; c.dst = (bf16_t*)(p.ws + OFF_WUKV); }
  else if ((j -= C_UKV) < C_OUT) { c.n0 = (j >> 4) * 64; c.k0 = (j & 15) * 64; c.cp = p.w_out + c.n0 + nn; c.LD = 1024; c.K = 1024; c.dst = (bf16_t*)(p.ws + OFF_WOUT); }
  else if ((j -= C_OUT) < C_GU) { const int e = j >> 8, r = j & 255; c.n0 = (r >> 4) * 64; c.k0 = (r & 15) * 64; WGUAcc a{p.w_gate + (size_t)e * 1024 * 512, p.w_up + (size_t)e * 1024 * 512};
    c.cp = a.col(c.n0 + nn, c.msk); c.LD = 512; c.K = 1024; c.dst = (bf16_t*)(p.ws + OFF_WGU) + (size_t)e * 1024 * 1024; }
  else { j -= C_GU; const int e = j >> 7, r = j & 127; c.n0 = (r >> 3) * 64; c.k0 = (r & 7) * 64; c.cp = p.w_down + (size_t)e * 512 * 1024 + c.n0 + nn; c.LD = 1024; c.K = 512; c.dst = (bf16_t*)(p.ws + OFF_WD) + (size_t)e * 1024 * 512; }
  c.cp += (size_t)(c.k0 + 8 * (t >> 6)) * c.LD;
  return c;
}
DEVI void conv_load(const ConvTile& c, float (&v)[16]) {
#pragma unroll
  for (int i = 0; i < 8; ++i) { v[i] = c.cp[(size_t)i * c.LD]; v[8 + i] = c.cp[(size_t)(64 + i) * c.LD]; }
}
DEVI void conv_finish(const ConvTile& c, const float (&v)[16], int t) {
#pragma unroll
  for (int h = 0; h < 2; ++h) {
    const int kk = c.k0 + 64 * h + 8 * (t >> 6); float x[8];
#pragma unroll
    for (int i = 0; i < 8; ++i) x[i] = v[8 * h + i] * c.msk * (c.g ? c.g[kk + i] : 1.f);
    *(uint4*)(c.dst + (size_t)(c.n0 + (t & 63)) * c.K + kk) = make_uint4(pk2(x[0], x[1]), pk2(x[2], x[3]), pk2(x[4], x[5]), pk2(x[6], x[7])); }
}

constexpr int CONV_C_EXPERTS = 10;
constexpr int NCONV_A = (NPROJ / 64) * 16;
constexpr int NCONV_C = NCONV_A + 12 * 6 + 16 * 4 + 256 + CONV_C_EXPERTS * 256;
constexpr int NCONV_E = NCONV_A + 12 * 6 + 16 * 4 + 256 + 16 * 16 * 16;
constexpr int NCONV = NCONV_E + 16 * 16 * 8;
static_assert(NCONV_A % 4 == 0 && NCONV_C % 4 == 0 && NCONV_E % 4 == 0 && NCONV % 4 == 0, "pairs, two per grab");
DEVI void conv_queue(const Params& p, char* smem, int q, int jbase, int jend) {
  int t = threadIdx.x; asm volatile("" : "+v"(t));
  unsigned* ctr = (unsigned*)(p.ws + OFF_BAR) + 16 * q;
  int* nxt = (int*)(smem + 32768);
  auto grab4 = [&]() -> int { __syncthreads(); if (t == 0) *nxt = jbase + (int)atomicAdd(ctr, 4u); __syncthreads(); return *nxt; };
  int jb = grab4(), jo = 0;
  if (jb < jend) {
    ConvTile c = conv_desc(p, jb, t); float v[16]; conv_load(c, v);
    for (;;) {
      int jn;
      if (jo < 1) { ++jo; jn = jb + 2 * jo; } else { jb = grab4(); jo = 0; jn = jb; }
      const bool more = jn < jend;
      ConvTile cn = c; float vn[16];
      if (more) { cn = conv_desc(p, jn, t); conv_load(cn, vn); }
      conv_finish(c, v, t);
      if (!more) break;
      c = cn;
#pragma unroll
      for (int i = 0; i < 16; ++i) v[i] = vn[i];
    }
  }
}

DEVI void phase_A(const Params& p, int bid, int nb, char* smem) {
  constexpr int N_MOD = 192, N_MISC = 1, N_WRT = 20, N_BT = 120;
  constexpr int I0 = N_MOD + N_MISC + N_WRT + N_BT;
  for (int it = bid; it < I0; it += nb) {
    if (it < N_MOD) modgemv_item(p, it, smem);
    else if (it < N_MOD + N_MISC) misc_item(p);
    else if (it < N_MOD + N_MISC + N_WRT) wrt_item(p, it - N_MOD - N_MISC);
    else bt_item(p, it - N_MOD - N_MISC - N_WRT);
  }
  conv_queue(p, smem, 0, 0, NCONV_A);
}

DEVI void phase_B(const Params& p, int bid, int nb) {
  int tx = threadIdx.x; asm volatile("" : "+v"(tx));
  const int lane = tx & 63, wv = tx >> 6;
  const float* mod = (const float*)(p.ws + OFF_MOD); act_t* hx = (act_t*)(p.ws + OFF_HXALL);
  const int nw = nb * NWAVES;
  for (int r0 = bid * NWAVES + wv; r0 < RR; r0 += 4 * nw) {
    float4 v[4][4]; const float* src[4]; int mrow[4];
#pragma unroll
    for (int q = 0; q < 4; ++q) { int row = r0 + q * nw; row = row < RR ? row : r0; const int b = row / RB, rb = row - b * RB;
      src[q] = rb < CTXL ? p.ctx + (size_t)(b * CTXL + rb) * 1024 : p.x + (size_t)(b * SEQ + rb - CTXL) * 1024; mrow[q] = rb < CTXL ? 2 : b;
#pragma unroll
      for (int i = 0; i < 4; ++i) v[q][i] = *(const float4*)(src[q] + lane * 4 + 256 * i); }
#pragma unroll
    for (int q = 0; q < 4; ++q) { const int row = r0 + q * nw; if (row >= RR) continue;
      float ss = 0.f;
#pragma unroll
      for (int i = 0; i < 4; ++i) ss += v[q][i].x * v[q][i].x + v[q][i].y * v[q][i].y + v[q][i].z * v[q][i].z + v[q][i].w * v[q][i].w;
      ss = wave_sum(ss); const float rstd = rsqrtf(ss * (1.f / 1024.f) + EPS);
      const float* sh = mod + mrow[q] * 6144; const float* sc = sh + 1024;
#pragma unroll
      for (int i = 0; i < 4; ++i) { const int k = lane * 4 + 256 * i; const float4 g = *(const float4*)(p.g_attn + k), s1 = *(const float4*)(sc + k), s0 = *(const float4*)(sh + k);
        st4(hx + (size_t)row * 1024 + k, v[q][i].x * rstd * g.x * (1.f + s1.x) + s0.x, v[q][i].y * rstd * g.y * (1.f + s1.y) + s0.y, v[q][i].z * rstd * g.z * (1.f + s1.z) + s0.z, v[q][i].w * rstd * g.w * (1.f + s1.w) + s0.w); } }
  }
}

DEVI void phase_C(const Params& p, int bid, int nb, char* smem) {
  SchedGrid S{66, 9, 66 * 9, nb, bid, 0}; EpiProj8 E{&p};
  g8::gemm_phase<EpiProj8, SchedGrid, false, 1024>((G8_LAS unsigned char*)smem, (const bf16_t*)(p.ws + OFF_HXALL), (const bf16_t*)(p.ws + OFF_WIN), S, E);
}
DEVI void phase_D(const Params& p, int bid, int nb, char* smem) {
  { SchedGrid S{64, 3, 192, nb, bid, 1}; EpiQm8 E{&p};
    g8::gemm_phase<EpiQm8, SchedGrid, false, 384>((G8_LAS unsigned char*)smem, (const bf16_t*)(p.ws + OFF_QLAT), (const bf16_t*)(p.ws + OFF_WUQ), S, E); }
  { int b2 = bid + 64; b2 = b2 >= nb ? b2 - nb : b2;
    SchedGrid S{66, 4, 264, nb, b2, 0}; EpiKv8 E{&p};
    g8::gemm_phase<EpiKv8, SchedGrid, false, 256>((G8_LAS unsigned char*)smem, (const bf16_t*)(p.ws + OFF_KVLAT), (const bf16_t*)(p.ws + OFF_WUKV), S, E); }
}
DEVI void phase_F(const Params& p, int bid, int nb, char* smem) {
  SchedGrid S{64, 4, 256, nb, bid, 0}; EpiOut8 E{&p};
  g8::gemm_phase<EpiOut8, SchedGrid, false, 1024>((G8_LAS unsigned char*)smem, (const bf16_t*)(p.ws + OFF_ATTN), (const bf16_t*)(p.ws + OFF_WOUT), S, E);
}
DEVI void phase_H(const Params& p, int bid, int nb, char* smem) {
  moe_table(p, smem); las_cint* tab = (las_cint*)(smem + SM_TAB); const int MT = tab[16];
  SchedMoe S{tab, (const int*)(p.ws + OFF_ELIST), MT, MT * 4, nb, bid}; EpiGU8 E{&p, tab};
  g8::gemm_phase<EpiGU8, SchedMoe, true, 1024>((G8_LAS unsigned char*)smem, (const bf16_t*)(p.ws + OFF_HX2), (const bf16_t*)(p.ws + OFF_WGU), S, E);
}
DEVI void phase_I(const Params& p, int bid, int nb, char* smem) {
  moe_table(p, smem); las_cint* tab = (las_cint*)(smem + SM_TAB); const int MT = tab[16];
  SchedMoe S{tab, (const int*)(p.ws + OFF_ELIST), MT, MT * 4, nb, bid}; EpiDown8 E{&p, tab};
  g8::gemm_phase<EpiDown8, SchedMoe, false, 512>((G8_LAS unsigned char*)smem, (const bf16_t*)(p.ws + OFF_HID), (const bf16_t*)(p.ws + OFF_WD), S, E);
}

typedef s16x4 __attribute__((address_space(3))) las_s16x4;
DEVI bf16x8 pack8(const f32x16& s, int base) {
  u32x4 w = {pk2(s[base], s[base + 1]), pk2(s[base + 2], s[base + 3]), pk2(s[base + 4], s[base + 5]), pk2(s[base + 6], s[base + 7])};
  return __builtin_bit_cast(bf16x8, w);
}
DEVI bf16x8 tr_pair(const char* p) {
  const s16x4 lo = __builtin_amdgcn_ds_read_tr16_b64_v4i16((las_s16x4*)(p));
  const s16x4 hh = __builtin_amdgcn_ds_read_tr16_b64_v4i16((las_s16x4*)(p + 8 * 64));
  return (bf16x8){lo[0], lo[1], lo[2], lo[3], hh[0], hh[1], hh[2], hh[3]};
}
DEVI void pv_block(const char* Vs, int vb, const f32x16& s0, const f32x16& s1, f32x16& o0, f32x16& o1) {
  const bf16x8 p00 = pack8(s0, 0), p01 = pack8(s0, 8), p10 = pack8(s1, 0), p11 = pack8(s1, 8);
  const char* v0 = Vs + vb; const char* v1 = Vs + 4096 + vb;
  o0 = __builtin_amdgcn_mfma_f32_32x32x16_bf16(tr_pair(v0), p00, o0, 0, 0, 0);
  o0 = __builtin_amdgcn_mfma_f32_32x32x16_bf16(tr_pair(v0 + 16 * 64), p01, o0, 0, 0, 0);
  o0 = __builtin_amdgcn_mfma_f32_32x32x16_bf16(tr_pair(v0 + 32 * 64), p10, o0, 0, 0, 0);
  o0 = __builtin_amdgcn_mfma_f32_32x32x16_bf16(tr_pair(v0 + 48 * 64), p11, o0, 0, 0, 0);
  o1 = __builtin_amdgcn_mfma_f32_32x32x16_bf16(tr_pair(v1), p00, o1, 0, 0, 0);
  o1 = __builtin_amdgcn_mfma_f32_32x32x16_bf16(tr_pair(v1 + 16 * 64), p01, o1, 0, 0, 0);
  o1 = __builtin_amdgcn_mfma_f32_32x32x16_bf16(tr_pair(v1 + 32 * 64), p10, o1, 0, 0, 0);
  o1 = __builtin_amdgcn_mfma_f32_32x32x16_bf16(tr_pair(v1 + 48 * 64), p11, o1, 0, 0, 0);
}
template <int DQK, bool BIAS>
DEVI void flash_tile(const char* Ks, const char* Vs, const bf16x8 (&qf)[DQK / 16], f32x16& o0, f32x16& o1, float& m, float& l, const float* bt, int r32, int hi, int vb) {
  constexpr int KROW = DQK * 2 + 16;
  f32x16 s0, s1;
#pragma unroll
  for (int r = 0; r < 16; ++r) { s0[r] = 0.f; s1[r] = 0.f; }
#pragma unroll
  for (int s = 0; s < DQK / 16; ++s) {
    const bf16x8 k0 = *(const bf16x8*)(Ks + r32 * KROW + (16 * s + 8 * hi) * 2);
    const bf16x8 k1 = *(const bf16x8*)(Ks + (32 + r32) * KROW + (16 * s + 8 * hi) * 2);
    s0 = __builtin_amdgcn_mfma_f32_32x32x16_bf16(k0, qf[s], s0, 0, 0, 0);
    s1 = __builtin_amdgcn_mfma_f32_32x32x16_bf16(k1, qf[s], s1, 0, 0, 0);
  }
  if (BIAS) {
#pragma unroll
    for (int r = 0; r < 16; ++r) { s0[r] += bt[crow(r, hi) * 64]; s1[r] += bt[(32 + crow(r, hi)) * 64]; }
  }
  float mx = fmaxf(s0[0], s1[0]);
#pragma unroll
  for (int r = 1; r < 16; ++r) mx = fmaxf(mx, fmaxf(s0[r], s1[r]));
  mx = xhalf_max(mx);
  const float mn = fmaxf(m, mx), alpha = __builtin_amdgcn_exp2f(m - mn); m = mn;
  float ps = 0.f;
#pragma unroll
  for (int r = 0; r < 16; ++r) { s0[r] = __builtin_amdgcn_exp2f(s0[r] - mn); s1[r] = __builtin_amdgcn_exp2f(s1[r] - mn); ps += s0[r] + s1[r]; }
  ps = xhalf_sum(ps); l = l * alpha + ps;
#pragma unroll
  for (int r = 0; r < 16; ++r) { o0[r] *= alpha; o1[r] *= alpha; }
  pv_block(Vs, vb, s0, s1, o0, o1);
}
template <int DQK, bool BIAS, bool NOSHIFT = false>
DEVI void flash_tile_shift(const char* Ks, const char* Vs, const bf16x8 (&qf)[DQK / 16], f32x16& o0, f32x16& o1, float& l, float negM, const f32x16& bi0, const f32x16& bi1, int r32, int hi, int vb) {
  constexpr int KROW = DQK * 2 + 16;
  f32x16 s0, s1;
#pragma unroll
  for (int r = 0; r < 16; ++r) { if (NOSHIFT) { s0[r] = BIAS ? bi0[r] : 0.f; s1[r] = BIAS ? bi1[r] : 0.f; } else { s0[r] = BIAS ? bi0[r] + negM : negM; s1[r] = BIAS ? bi1[r] + negM : negM; } }
#pragma unroll
  for (int s = 0; s < DQK / 16; ++s) {
    const bf16x8 k0 = *(const bf16x8*)(Ks + r32 * KROW + (16 * s + 8 * hi) * 2);
    const bf16x8 k1 = *(const bf16x8*)(Ks + (32 + r32) * KROW + (16 * s + 8 * hi) * 2);
    s0 = __builtin_amdgcn_mfma_f32_32x32x16_bf16(k0, qf[s], s0, 0, 0, 0);
    s1 = __builtin_amdgcn_mfma_f32_32x32x16_bf16(k1, qf[s], s1, 0, 0, 0);
  }
  float ps = 0.f;
#pragma unroll
  for (int r = 0; r < 16; ++r) { s0[r] = __builtin_amdgcn_exp2f(s0[r]); s1[r] = __builtin_amdgcn_exp2f(s1[r]); ps += s0[r] + s1[r]; }
  l += ps;
  pv_block(Vs, vb, s0, s1, o0, o1);
}
DEVI void flash_store(bf16_t* op, const f32x16& o0, const f32x16& o1, float l, int hi) {
  const float rl = 1.f / l;
#pragma unroll
  for (int g = 0; g < 4; ++g) {
    st4(op + 8 * g + 4 * hi, o0[4 * g] * rl, o0[4 * g + 1] * rl, o0[4 * g + 2] * rl, o0[4 * g + 3] * rl);
    st4(op + 32 + 8 * g + 4 * hi, o1[4 * g] * rl, o1[4 * g + 1] * rl, o1[4 * g + 2] * rl, o1[4 * g + 3] * rl); }
}

#define MLA_SB __builtin_amdgcn_sched_barrier(0)
template <int KN, int VC>
DEVI void mla_step(char* smem, const char* ws, unsigned& gk, unsigned& gv, unsigned& gh, unsigned sk, unsigned sh, int lk, int lv, int lh,
                   const bf16x8 (&qf)[6], f32x16& c0, f32x16& c1, f32x16& n0, f32x16& n1, f32x16& o0, f32x16& o1, float (&l4)[4], const f32x16& negMv, int koff, int vb,
                   u32x4& lrk, u32x4& lrv, uint2& lrh, const u32x4& rk, const u32x4& rv, const uint2& rh) {
  constexpr int KROW = 208, KBYTES = 64 * KROW, VOFF = 2 * KBYTES;
  const char* Kn = smem + KN * KBYTES + koff;
  const char* V0 = smem + VOFF + VC * 8192 + vb; const char* V1 = V0 + 4096;
  lrk = *(const u32x4*)(ws + gk); lrv = *(const u32x4*)(ws + gv); lrh = *(const uint2*)(ws + gh);
  gk += sk; gv += 64u * 1024u * 2u; gh += sh;
  bf16x8 kf[12], pf[4], vf[4], vg[4];
#define MLA_KLD(g) kf[g] = *(const bf16x8*)(Kn + ((g) & 1) * 32 * KROW + ((g) >> 1) * 32)
  MLA_KLD(0); MLA_KLD(1); MLA_KLD(2);
  MLA_SB;
  constexpr int ELO[13] = {0, 3, 6, 9, 10, 13, 16, 17, 20, 23, 24, 28, 32};
#pragma unroll
  for (int g = 0; g < 12; ++g) {
    if (g + 3 < 12) MLA_KLD(g + 3);
    if (g >= 8) vf[g - 8] = tr_pair(V0 + (g - 8) * 16 * 64);
    if ((g & 1) == 0) n0 = __builtin_amdgcn_mfma_f32_32x32x16_bf16(kf[g], qf[g >> 1], g < 2 ? negMv : n0, 0, 0, 0);
    else              n1 = __builtin_amdgcn_mfma_f32_32x32x16_bf16(kf[g], qf[g >> 1], g < 2 ? negMv : n1, 0, 0, 0);
    MLA_SB;
#pragma unroll
    for (int e = ELO[g]; e < ELO[g + 1]; ++e) { if (e < 16) c0[e] = __builtin_amdgcn_exp2f(c0[e]); else c1[e - 16] = __builtin_amdgcn_exp2f(c1[e - 16]); }
    if (g == 3) pf[0] = pack8(c0, 0);
    if (g == 6) pf[1] = pack8(c0, 8);
    if (g == 9) pf[2] = pack8(c1, 0);
    MLA_SB;
  }
#undef MLA_KLD
#pragma unroll
  for (int hh = 0; hh < 8; ++hh) {
    if (hh < 4) vg[hh] = tr_pair(V1 + hh * 16 * 64);
    if (hh < 4) o0 = __builtin_amdgcn_mfma_f32_32x32x16_bf16(vf[hh], pf[hh], o0, 0, 0, 0);
    else        o1 = __builtin_amdgcn_mfma_f32_32x32x16_bf16(vg[hh - 4], pf[hh - 4], o1, 0, 0, 0);
    MLA_SB;
    if (hh == 0) pf[3] = pack8(c1, 8);
#pragma unroll
    for (int e = 4 * hh; e < 4 * hh + 4; ++e) { const float pv_ = e < 16 ? c0[e] : c1[e - 16]; asm volatile("v_add_f32_e32 %0, %1, %0" : "+v"(l4[e & 3]) : "v"(pv_)); }
    if (hh == 5) *(u32x4*)(smem + (1 - KN) * KBYTES + lk) = rk;
    if (hh == 6) *(u32x4*)(smem + (1 - VC) * 8192 + lv) = rv;
    if (hh == 7) *(uint2*)(smem + (1 - KN) * KBYTES + lh) = rh;
    MLA_SB;
  }
  __syncthreads();
}

DEVI void mla_unit(const Params& p, int unit, char* smem) {
  constexpr int KROW = 208, KBYTES = 64 * KROW  , VOFF = 2 * KBYTES;
  const int t = threadIdx.x, lane = t & 63, w = t >> 6, r32 = lane & 31, hi = lane >> 5;
  const int qblk = unit & 31, h = (unit >> 5) & 7, b = unit >> 8;
  const char* ws = p.ws;
  const size_t qrow = (size_t)b * RB + CTXL + qblk * 256 + w * 32 + r32;
  bf16x8 qf[6];
  { const bf16_t* qp = (const bf16_t*)p.out + qrow * 768 + h * 96 + hi * 8;
#pragma unroll
    for (int s = 0; s < 6; ++s) qf[s] = *(const bf16x8*)(qp + 16 * s); }
  unsigned gk, gv, gh, sk, sh; int lk, lv, lh;
  { const int key = t / 12, ch = t - key * 12;
    if (ch < 8) { gk = (unsigned)OFF_KV + (unsigned)(((b * RB + key) * 1024 + h * 128 + ch * 8) * 2); sk = 64u * 1024u * 2u; }
    else { gk = (unsigned)OFF_KROPE + (unsigned)(((b * RB + key) * 32 + (ch - 8) * 8) * 2); sk = 64u * 32u * 2u; }
    lk = key * KROW + ch * 16; }
  { const int c = 512 + (t >> 1), key = c / 12, ch = c - key * 12, hf = t & 1;
    if (ch < 8) { gh = (unsigned)OFF_KV + (unsigned)(((b * RB + key) * 1024 + h * 128 + ch * 8 + hf * 4) * 2); sh = 64u * 1024u * 2u; }
    else { gh = (unsigned)OFF_KROPE + (unsigned)(((b * RB + key) * 32 + (ch - 8) * 8 + hf * 4) * 2); sh = 64u * 32u * 2u; }
    lh = key * KROW + ch * 16 + hf * 8; }
  { const int key = t >> 3, ch = t & 7; gv = (unsigned)OFF_KV + (unsigned)(((b * RB + key) * 1024 + h * 128 + 64 + ch * 8) * 2); lv = VOFF + (ch >> 2) * 4096 + key * 64 + (ch & 3) * 16; }
  const int vb = (((lane & 15) >> 2) + 4 * hi) * 64 + (16 * ((lane >> 4) & 1) + 4 * (lane & 3)) * 2;
  f32x16 o0, o1;
#pragma unroll
  for (int r = 0; r < 16; ++r) { o0[r] = 0.f; o1[r] = 0.f; }
  float q2 = 0.f;
#pragma unroll
  for (int s = 0; s < 6; ++s)
#pragma unroll
    for (int e = 0; e < 8; ++e) { const float x = bf2f((bf16_t)qf[s][e]); q2 = fmaf(x, x, q2); }
  q2 = xhalf_sum(q2);
  const float* kmw = (const float*)(ws + OFF_KMAX);
  const float Mq = 1.01f * sqrtf(q2 * (kmw[KM_KN + b * 16 + h * 2] + kmw[KM_KN + b * 16 + h * 2 + 1] + kmw[KM_KR + b]));
  bool shift_ok;
  { volatile __attribute__((address_space(3))) unsigned* vw = (volatile __attribute__((address_space(3))) unsigned*)(smem + SM_BARW) + 6;
    const bool bad_w = __any(!(Mq < 64.f));
    __syncthreads(); if (t == 0) *vw = 0u; __syncthreads(); if (bad_w && lane == 0) *vw = 1u; __syncthreads();
    shift_ok = __builtin_amdgcn_readfirstlane((int)*vw) == 0; }
  constexpr int NT = RB / 64;
  float l;
  { const u32x4 rk = *(const u32x4*)(ws + gk); const u32x4 rv = *(const u32x4*)(ws + gv); const uint2 rh = *(const uint2*)(ws + gh);
    gk += sk; gv += 64u * 1024u * 2u; gh += sh;
    __syncthreads();
    *(u32x4*)(smem + lk) = rk; *(u32x4*)(smem + lv) = rv; *(uint2*)(smem + lh) = rh; }
  if (shift_ok) {
    { const u32x4 rk = *(const u32x4*)(ws + gk); const uint2 rh = *(const uint2*)(ws + gh); gk += sk; gh += sh;
      *(u32x4*)(smem + KBYTES + lk) = rk; *(uint2*)(smem + KBYTES + lh) = rh; }
    __syncthreads();
    const int koff = r32 * KROW + hi * 16;
    f32x16 negMv;
#pragma unroll
    for (int r = 0; r < 16; ++r) negMv[r] = -Mq;
    f32x16 a0, a1, b0, b1;
    { const char* Kn = smem + koff;
#pragma unroll
      for (int s = 0; s < 6; ++s) {
        a0 = __builtin_amdgcn_mfma_f32_32x32x16_bf16(*(const bf16x8*)(Kn + s * 32), qf[s], s == 0 ? negMv : a0, 0, 0, 0);
        a1 = __builtin_amdgcn_mfma_f32_32x32x16_bf16(*(const bf16x8*)(Kn + 32 * KROW + s * 32), qf[s], s == 0 ? negMv : a1, 0, 0, 0); } }
    float l4[4] = {0.f, 0.f, 0.f, 0.f};
    u32x4 rkA, rvA, rkB, rvB; uint2 rhA, rhB;
    rkB = *(const u32x4*)(ws + gk); rvB = *(const u32x4*)(ws + gv); rhB = *(const uint2*)(ws + gh); gk += sk; gv += 64u * 1024u * 2u; gh += sh;
#pragma unroll 1
    for (int jj = 0; jj < NT / 2; ++jj) {
      mla_step<1, 0>(smem, ws, gk, gv, gh, sk, sh, lk, lv, lh, qf, a0, a1, b0, b1, o0, o1, l4, negMv, koff, vb, rkA, rvA, rhA, rkB, rvB, rhB);
      mla_step<0, 1>(smem, ws, gk, gv, gh, sk, sh, lk, lv, lh, qf, b0, b1, a0, a1, o0, o1, l4, negMv, koff, vb, rkB, rvB, rhB, rkA, rvA, rhA);
    }
    l = xhalf_sum((l4[0] + l4[1]) + (l4[2] + l4[3]));
  } else {
    __syncthreads();
    float m = -1e30f; l = 0.f;
#pragma unroll 1
    for (int j = 0; j < NT; ++j) {
      const u32x4 rk = *(const u32x4*)(ws + gk); const u32x4 rv = *(const u32x4*)(ws + gv); const uint2 rh = *(const uint2*)(ws + gh);
      gk += sk; gv += 64u * 1024u * 2u; gh += sh;
      flash_tile<96, false>(smem + (j & 1) * KBYTES, smem + VOFF + (j & 1) * 8192, qf, o0, o1, m, l, nullptr, r32, hi, vb);
      char* sw = smem + ((j + 1) & 1) * KBYTES; *(u32x4*)(sw + lk) = rk; *(uint2*)(sw + lh) = rh; *(u32x4*)(smem + ((j + 1) & 1) * 8192 + lv) = rv;
      __syncthreads();
    }
  }
  flash_store((bf16_t*)(ws + OFF_ATTN) + ((size_t)b * SEQ + qblk * 256 + w * 32 + r32) * 1024 + h * 64, o0, o1, l, hi);
}

template <bool BIAS>
DEVI void na_tile_max(const char* Ks, const char* Vs, const bf16x8 (&qf)[4], f32x16& o0, f32x16& o1, float& m, float& l, const f32x16& bi0, const f32x16& bi1, int r32, int hi, int vb) {
  constexpr int KROW = 144;
  f32x16 s0, s1;
#pragma unroll
  for (int r = 0; r < 16; ++r) { s0[r] = BIAS ? bi0[r] : 0.f; s1[r] = BIAS ? bi1[r] : 0.f; }
#pragma unroll
  for (int s = 0; s < 4; ++s) {
    const bf16x8 k0 = *(const bf16x8*)(Ks + r32 * KROW + (16 * s + 8 * hi) * 2), k1 = *(const bf16x8*)(Ks + (32 + r32) * KROW + (16 * s + 8 * hi) * 2);
    s0 = __builtin_amdgcn_mfma_f32_32x32x16_bf16(k0, qf[s], s0, 0, 0, 0); s1 = __builtin_amdgcn_mfma_f32_32x32x16_bf16(k1, qf[s], s1, 0, 0, 0);
  }
  float mx = fmaxf(s0[0], s1[0]);
#pragma unroll
  for (int r = 1; r < 16; ++r) mx = fmaxf(mx, fmaxf(s0[r], s1[r]));
  mx = xhalf_max(mx);
  const float mn = fmaxf(m, mx), alpha = __builtin_amdgcn_exp2f(m - mn); m = mn;
  float ps = 0.f;
#pragma unroll
  for (int r = 0; r < 16; ++r) { s0[r] = __builtin_amdgcn_exp2f(s0[r] - mn); s1[r] = __builtin_amdgcn_exp2f(s1[r] - mn); ps += s0[r] + s1[r]; }
  ps = xhalf_sum(ps); l = l * alpha + ps;
#pragma unroll
  for (int r = 0; r < 16; ++r) { o0[r] *= alpha; o1[r] *= alpha; }
  pv_block(Vs, vb, s0, s1, o0, o1);
}

DEVI void na_unit(const Params& p, int unit, char* smem) {
  constexpr int KROW = 144, KBYTES = 64 * KROW  , STAGE = KBYTES + 8192  ;
  const int t = threadIdx.x, lane = t & 63, w = t >> 6, r32 = lane & 31, hi = lane >> 5;
  const int head = unit & 7, rq = (unit >> 3) & 31, b = unit >> 8;
  const int rr = w >> 1, qb = w & 1, grow = rq * 4 + rr, c = qb * 32 + r32;
  int wstart = grow - 4; wstart = wstart < 0 ? 0 : (wstart > 120 ? 120 : wstart);
  int klo = rq * 4 - 4; klo = klo < 0 ? 0 : (klo > 120 ? 120 : klo);
  int khi = rq * 4 - 1; khi = (khi < 0 ? 0 : (khi > 120 ? 120 : khi)) + 8;
  const int ntw = khi - klo, ntt = ntw + 4;
  const char* ws = p.ws;
  const bf16_t* nak = (const bf16_t*)(ws + OFF_NAK) + (size_t)b * RB * 512 + head * 64;
  const bf16_t* nav = (const bf16_t*)(ws + OFF_NAV) + (size_t)b * RB * 512 + head * 64;
  bf16x8 qf[4];
  { const bf16_t* qp = (const bf16_t*)(ws + OFF_NAQ) + ((size_t)b * RB + CTXL + grow * 64 + c) * 512 + head * 64 + hi * 8;
#pragma unroll
    for (int s = 0; s < 4; ++s) qf[s] = *(const bf16x8*)(qp + 16 * s); }
  const int skey = t >> 3, sch = t & 7;
  const int goff0 = skey * 512 + sch * 8, kdst0 = skey * KROW + sch * 16, vdst0 = KBYTES + (sch >> 2) * 4096 + skey * 64 + (sch & 3) * 16;
  const int vb = (((lane & 15) >> 2) + 4 * hi) * 64 + (16 * ((lane >> 4) & 1) + 4 * (lane & 3)) * 2;
  f32x16 o0, o1;
#pragma unroll
  for (int r = 0; r < 16; ++r) { o0[r] = 0.f; o1[r] = 0.f; }
  float m = -1e30f, l = 0.f;
  const unsigned* btb = (const unsigned*)(ws + OFF_BT) + (size_t)(head * 15) * 2048 + c;
  float q2 = 0.f;
#pragma unroll
  for (int s = 0; s < 4; ++s)
#pragma unroll
    for (int e = 0; e < 8; ++e) { const float x = bf2f((bf16_t)qf[s][e]); q2 = fmaf(x, x, q2); }
  q2 = xhalf_sum(q2);
  const float* kmw = (const float*)(ws + OFF_KMAX);
  const float Mq = 1.01f * sqrtf(q2 * (kmw[KM_NA + b * 16 + head * 2] + kmw[KM_NA + b * 16 + head * 2 + 1])) + kmw[KM_BM + head];
  const bool shift_ok = !__any(!(Mq < 64.f));
  u32x4 rk, rv;
  auto rowbase = [&](int j) -> size_t { return j < ntw ? (size_t)CTXL + (size_t)(klo + j) * 64 : (size_t)(j - ntw) * 64; };
#define NA_STAGE_LOAD(J) { const size_t rb1 = rowbase(J) * 512 + goff0; rk = *(const u32x4*)(nak + rb1); rv = *(const u32x4*)(nav + rb1); }
#define NA_STAGE_WRITE(J) { char* sw = smem + ((J) & 1) * STAGE; *(u32x4*)(sw + kdst0) = rk; *(u32x4*)(sw + vdst0) = rv; }
  NA_STAGE_LOAD(0)
  __syncthreads();
  NA_STAGE_WRITE(0)
  __syncthreads();
  unsigned bp[16];
#define NA_BIAS_LOAD(J) { const int kr_ = klo + (J); if ((J) < ntw && kr_ >= wstart && kr_ < wstart + 8) { const unsigned* bt = btb + (size_t)(kr_ - grow + 7) * 2048; \
      _Pragma("unroll") for (int r = 0; r < 16; ++r) bp[r] = bt[crow(r, hi) * 64]; } }
#define NA_TILE_LOOP(WIN_CALL, CTX_CALL)                                                                                                       \
  NA_BIAS_LOAD(0)                                                                                                                                \
  _Pragma("unroll 1") for (int j = 0; j < ntt; ++j) {                                                                                            \
    const char* st = smem + (j & 1) * STAGE;                                                                                                     \
    const int kr = klo + j; const bool win = j < ntw; const bool active = !win || (kr >= wstart && kr < wstart + 8);           \
    f32x16 bc0, bc1;                                                                                                                             \
    if (win && active) { _Pragma("unroll") for (int r = 0; r < 16; ++r) { bc0[r] = __uint_as_float(bp[r] << 16); bc1[r] = __uint_as_float(bp[r] & 0xffff0000u); } } \
    __builtin_amdgcn_sched_barrier(0);                                                                                                           \
    NA_BIAS_LOAD(j + 1)                                                 \
    __builtin_amdgcn_sched_barrier(0);                                                                                                           \
    if (j + 1 < ntt) NA_STAGE_LOAD(j + 1)                                                                                                        \
    __builtin_amdgcn_sched_barrier(0);                                                                                                           \
    if (active) { if (win) { WIN_CALL; } else { CTX_CALL; } }                                                                                    \
    if (j + 1 < ntt) NA_STAGE_WRITE(j + 1)                                                                                                       \
    __syncthreads();                                                                                                                             \
  }
  if (shift_ok) { NA_TILE_LOOP((flash_tile_shift<64, true, true>(st, st + KBYTES, qf, o0, o1, l, 0.f, bc0, bc1, r32, hi, vb)), (flash_tile_shift<64, false, true>(st, st + KBYTES, qf, o0, o1, l, 0.f, bc0, bc1, r32, hi, vb))) }
  else { NA_TILE_LOOP((na_tile_max<true>(st, st + KBYTES, qf, o0, o1, m, l, bc0, bc1, r32, hi, vb)), (na_tile_max<false>(st, st + KBYTES, qf, o0, o1, m, l, bc0, bc1, r32, hi, vb))) }
#undef NA_TILE_LOOP
#undef NA_BIAS_LOAD
#undef NA_STAGE_LOAD
#undef NA_STAGE_WRITE
  if (shift_ok) l = xhalf_sum(l);
  flash_store((bf16_t*)(ws + OFF_ATTN) + ((size_t)b * SEQ + grow * 64 + c) * 1024 + 512 + head * 64, o0, o1, l, hi);
}

DEVI void phase_E(const Params& p, int bid, int nb, char* smem) {
  constexpr int UM = NBATCH * 8 * 32, UN = NBATCH * 32 * 8;
  { const int iters = xcd_iters(UM, nb);
    for (int it = 0; it < iters; ++it) { const int u = xcd_unit(bid + it * nb, UM); if (u >= 0) mla_unit(p, u, smem); } }
#if TIMING_PROBE
  if (blockIdx.x == 0 && threadIdx.x == 0) ((unsigned long long*)(p.ws + OFF_CNT + 64))[11] = __builtin_amdgcn_s_memrealtime();
#endif
  { const int iters = xcd_iters(UN, nb);
    for (int it = 0; it < iters; ++it) { const int u = xcd_unit(bid + it * nb, UN); if (u >= 0) na_unit(p, u, smem); } }
#if TIMING_PROBE
  if (blockIdx.x == 0 && threadIdx.x == 0) ((unsigned long long*)(p.ws + OFF_CNT + 64))[12] = __builtin_amdgcn_s_memrealtime();
#endif
}

DEVI void route_token(const float (&lg)[20], int tl, int lane, int* te, float* tw) {
  int gs = 0; float gm = lg[0];
#pragma unroll
  for (int j = 1; j < 4; ++j) if (lg[j] > gm) { gm = lg[j]; gs = j; }
  float z = 0.f;
#pragma unroll
  for (int j = 0; j < 4; ++j) z += expf(lg[j] - gm);
  const float gw = 1.f / z;
  const float c0 = gs == 0 ? 1.f : 0.f, c1 = gs == 1 ? 1.f : 0.f, c2 = gs == 2 ? 1.f : 0.f, c3 = gs == 3 ? 1.f : 0.f;
  float e4[4];
#pragma unroll
  for (int j = 0; j < 4; ++j) e4[j] = c0 * lg[4 + j] + c1 * lg[8 + j] + c2 * lg[12 + j] + c3 * lg[16 + j];
  int i1 = 0; float m1 = e4[0];
#pragma unroll
  for (int j = 1; j < 4; ++j) if (e4[j] > m1) { m1 = e4[j]; i1 = j; }
  int i2 = -1; float m2 = -3.0e38f;
#pragma unroll
  for (int j = 0; j < 4; ++j) if (j != i1 && e4[j] > m2) { m2 = e4[j]; i2 = j; }
  const float ex = expf(m2 - m1), w1 = 1.f / (1.f + ex), w2 = ex / (1.f + ex);
  if (lane == 0) { te[tl * 2] = gs * 4 + i1; te[tl * 2 + 1] = gs * 4 + i2; tw[tl * 2] = gw * w1; tw[tl * 2 + 1] = gw * w2; }
}
DEVI void phase_G(const Params& p, int bid, int nb, char* smem) {
  int t = threadIdx.x; asm volatile("" : "+v"(t));
  const int lane = t & 63, wv = t >> 6;
  int* te = (int*)smem; float* tw = (float*)(smem + 256);
  const float* mod = (const float*)(p.ws + OFF_MOD); act_t* hx2 = (act_t*)(p.ws + OFF_HX2);
  const float* wrt = (const float*)(smem + 1024);
  { const f32x4* src = (const f32x4*)(p.ws + OFF_WRT); f32x4* dst = (f32x4*)(smem + 1024);
    __syncthreads();
#pragma unroll
    for (int i = 0; i < 10; ++i) dst[t + 512 * i] = src[t + 512 * i];
    __syncthreads(); }
  int* cnt = (int*)(p.ws + OFF_CNT); int* elist = (int*)(p.ws + OFF_ELIST); float* ewt = (float*)(p.ws + OFF_EW);
  for (int ch = bid; ch < TT / 32; ch += nb) {
    __syncthreads();
    const int b = (ch * 32) >> 13; const float* sh = mod + b * 6144 + 3072; const float* sc = sh + 1024;
#pragma unroll 1
    for (int q = 0; q < 4; q += 2) {
      const int tl = wv * 4 + q, tok = ch * 32 + tl;
      const act_t* xa = (const act_t*)(p.ws + OFF_X1) + (size_t)tok * 1024 + lane * 4; const act_t* xb = xa + 1024;
      float sa = 0.f, sb = 0.f;
      { float va[4][4], vb[4][4];
#pragma unroll
        for (int i = 0; i < 4; ++i) { ld4(xa + 256 * i, va[i]); ld4(xb + 256 * i, vb[i]); }
#pragma unroll
        for (int i = 0; i < 4; ++i) { sa += va[i][0] * va[i][0] + va[i][1] * va[i][1] + va[i][2] * va[i][2] + va[i][3] * va[i][3]; sb += vb[i][0] * vb[i][0] + vb[i][1] * vb[i][1] + vb[i][2] * vb[i][2] + vb[i][3] * vb[i][3]; } }
      sa = wave_sum(sa); sb = wave_sum(sb);
      const float ra = rsqrtf(sa * (1.f / 1024.f) + EPS), rb = rsqrtf(sb * (1.f / 1024.f) + EPS);
      float la[20], lb[20];
#pragma unroll
      for (int j = 0; j < 20; ++j) { la[j] = 0.f; lb[j] = 0.f; }
#pragma unroll 1
      for (int i = 0; i < 4; ++i) {
        const int k = lane * 4 + 256 * i;
        float4 va, vb; { float ta[4], tb[4]; ld4(xa + 256 * i, ta); ld4(xb + 256 * i, tb); va = make_float4(ta[0], ta[1], ta[2], ta[3]); vb = make_float4(tb[0], tb[1], tb[2], tb[3]); }
        const float4 g = *(const float4*)(p.g_ffn + k), s1 = *(const float4*)(sc + k), s0 = *(const float4*)(sh + k);
        const float gx = g.x * (1.f + s1.x), gy = g.y * (1.f + s1.y), gz = g.z * (1.f + s1.z), gw = g.w * (1.f + s1.w);
        const float4 ha = make_float4(va.x * ra * gx + s0.x, va.y * ra * gy + s0.y, va.z * ra * gz + s0.z, va.w * ra * gw + s0.w);
        const float4 hb = make_float4(vb.x * rb * gx + s0.x, vb.y * rb * gy + s0.y, vb.z * rb * gz + s0.z, vb.w * rb * gw + s0.w);
        st4(hx2 + (size_t)tok * 1024 + k, ha.x, ha.y, ha.z, ha.w); st4(hx2 + (size_t)(tok + 1) * 1024 + k, hb.x, hb.y, hb.z, hb.w);
        const float* wk = wrt + k;
#pragma unroll
        for (int jg = 0; jg < 20; jg += 10) {
          float4 w[10];
#pragma unroll
          for (int u = 0; u < 10; ++u) w[u] = *(const float4*)(wk + (jg + u) * 1024);
#pragma unroll
          for (int u = 0; u < 10; ++u) {
            la[jg + u] = fmaf(ha.x, w[u].x, fmaf(ha.y, w[u].y, fmaf(ha.z, w[u].z, fmaf(ha.w, w[u].w, la[jg + u]))));
            lb[jg + u] = fmaf(hb.x, w[u].x, fmaf(hb.y, w[u].y, fmaf(hb.z, w[u].z, fmaf(hb.w, w[u].w, lb[jg + u])))); }
        }
      }
#pragma unroll
      for (int j = 0; j < 20; ++j) { la[j] = wave_sum(la[j]); lb[j] = wave_sum(lb[j]); }
#pragma unroll
      for (int j = 0; j < 4; ++j) { la[j] += p.b_rg[j]; lb[j] += p.b_rg[j]; }
#pragma unroll
      for (int j = 0; j < 16; ++j) { la[4 + j] += p.b_re[j]; lb[4 + j] += p.b_re[j]; }
      route_token(la, tl, lane, te, tw); route_token(lb, tl + 1, lane, te, tw);
    }
    __syncthreads();
    if (wv == 0) {
      const int my_e = te[lane]; const float my_w = tw[lane];
      unsigned long long me_mask = 0ull; int my_n = 0;
#pragma unroll
      for (int e = 0; e < 16; ++e) { const unsigned long long mk = __ballot(my_e == e); if (my_e == e) me_mask = mk; if (lane == e) my_n = __popcll(mk); }
      int base = 0; if (lane < 16 && my_n) base = atomicAdd(&cnt[lane], my_n);
      const int my_base = __shfl(base, my_e);
      const int rank = __popcll(me_mask & ((1ull << lane) - 1ull));
      const int slot = my_base + rank;
      elist[(size_t)my_e * TT + slot] = (ch * 32 + (lane >> 1)) * 2 + (lane & 1); ewt[(size_t)my_e * TT + slot] = my_w;
    }
  }
}

DEVI void phase_J(const Params& p, int bid, int nb) {
  int tx = threadIdx.x; asm volatile("" : "+v"(tx));
  const int lane = tx & 63, wv = tx >> 6;
  const float* mod = (const float*)(p.ws + OFF_MOD); const act_t* yb = (const act_t*)(p.ws + OFF_YBUF);
  for (int tok0 = (bid * NWAVES + wv) * 4; tok0 < TT; tok0 += nb * NWAVES * 4) {
    const int b = tok0 >> 13; const float* g2 = mod + b * 6144 + 5120;
    float4 xv[4][4]; float y0[4][4][4], y1[4][4][4];
#pragma unroll
    for (int q = 0; q < 4; ++q)
#pragma unroll
      for (int i = 0; i < 4; ++i) { const int k = lane * 4 + 256 * i; { float tx4[4]; ld4((const act_t*)(p.ws + OFF_X1) + (size_t)(tok0 + q) * 1024 + k, tx4); xv[q][i] = make_float4(tx4[0], tx4[1], tx4[2], tx4[3]); }
        ld4(yb + (size_t)(tok0 + q) * 1024 + k, y0[q][i]); ld4(yb + ((size_t)TT + tok0 + q) * 1024 + k, y1[q][i]); }
#pragma unroll
    for (int q = 0; q < 4; ++q) {
      float* xo = p.out + (size_t)(tok0 + q) * 1024; float o[16]; float ss = 0.f;
#pragma unroll
      for (int i = 0; i < 4; ++i) { const int k = lane * 4 + 256 * i; const float4 g = *(const float4*)(g2 + k);
        o[4 * i] = xv[q][i].x + g.x * (y0[q][i][0] + y1[q][i][0]); o[4 * i + 1] = xv[q][i].y + g.y * (y0[q][i][1] + y1[q][i][1]);
        o[4 * i + 2] = xv[q][i].z + g.z * (y0[q][i][2] + y1[q][i][2]); o[4 * i + 3] = xv[q][i].w + g.w * (y0[q][i][3] + y1[q][i][3]);
        ss += o[4 * i] * o[4 * i] + o[4 * i + 1] * o[4 * i + 1] + o[4 * i + 2] * o[4 * i + 2] + o[4 * i + 3] * o[4 * i + 3]; }
      ss = wave_sum(ss); const float rstd = rsqrtf(ss * (1.f / 1024.f) + EPS);
#pragma unroll
      for (int i = 0; i < 4; ++i) { const int k = lane * 4 + 256 * i; const float4 g = *(const float4*)(p.g_final + k);
        *(float4*)(xo + k) = make_float4(o[4 * i] * rstd * g.x, o[4 * i + 1] * rstd * g.y, o[4 * i + 2] * rstd * g.z, o[4 * i + 3] * rstd * g.w); }
    }
  }
}

#if ONE_LAUNCH
#define XB_TMO      128
#define XB_XCNT(j)  (256  + 64 * (j))
#define XB_XSUB(j)  (1280 + 64 * (j))
#define XB_XGEN(j)  (2304 + 64 * (j))
#define XB_TOP      3328
#define XB_TOPGEN   3392
#define XCD_BAR_WORDS 3456
#define XB_SPIN_CAP (1u << 20)
#define LAS __attribute__((address_space(3)))
DEVI unsigned xb_ld(unsigned* p)              { return __hip_atomic_load(p, __ATOMIC_RELAXED, __HIP_MEMORY_SCOPE_AGENT); }
DEVI unsigned xb_add(unsigned* p, unsigned v) { return __hip_atomic_fetch_add(p, v, __ATOMIC_RELAXED, __HIP_MEMORY_SCOPE_AGENT); }
DEVI unsigned xb_xcc_id() { return (unsigned)__builtin_amdgcn_s_getreg((3 << 11) | 20) & 0xFu; }
#define XB_SPIN(cond, bar) do { unsigned _sp = 0; while (cond) { __builtin_amdgcn_s_sleep(1); \
    if ((++_sp & 255u) == 0u) { if (xb_ld(&(bar)[XB_TMO])) break; if (_sp > XB_SPIN_CAP) { atomicAdd(&(bar)[XB_TMO], 1u); break; } } } } while (0)
struct XcdBarrier { unsigned* bar; unsigned x; volatile LAS unsigned* st; };
DEVI XcdBarrier xcd_barrier_post(unsigned* bar, volatile LAS unsigned* st) {
  XcdBarrier b; b.bar = bar; b.x = xb_xcc_id(); b.st = st;
  if (threadIdx.x == 0) st[2] = xb_add(&bar[XB_XCNT(b.x)], 1u);
  return b;
}
DEVI void xcd_barrier_complete(unsigned* bar, unsigned x, unsigned& nloc, unsigned& nx) {
  const unsigned G = gridDim.x * gridDim.y * gridDim.z;
  unsigned sum, cnt, mine, sp = 0u;
  for (;;) {
    sum = 0u; cnt = 0u; mine = 0u;
#pragma unroll
    for (unsigned j = 0; j < 16; ++j) { const unsigned c = xb_ld(&bar[XB_XCNT(j)]); sum += c; cnt += (c > 0u) ? 1u : 0u; mine = (j == x) ? c : mine; }
    if (sum == G) break;
    __builtin_amdgcn_s_sleep(1);
    if ((++sp & 255u) == 0u) { if (xb_ld(&bar[XB_TMO])) break; if (sp > XB_SPIN_CAP) { atomicAdd(&bar[XB_TMO], 1u); break; } }
  }
  nloc = mine > 0u ? mine : 1u; nx = cnt > 0u ? cnt : 1u;
}
DEVI void xcd_barrier(const XcdBarrier& b) {
  asm volatile("s_waitcnt vmcnt(0)" ::: "memory");
  __syncthreads();
  if (threadIdx.x == 0) {
    unsigned* bar = b.bar;
    __builtin_amdgcn_s_waitcnt(0);
    unsigned nloc = b.st[0], nx = b.st[1];
    if (nloc == 0u) { xcd_barrier_complete(bar, b.x, nloc, nx); b.st[0] = nloc; b.st[1] = nx; }
    const unsigned old = xb_add(&bar[XB_XSUB(b.x)], 1u);
    const unsigned gen = old / nloc;
    if (old + 1u == (gen + 1u) * nloc) {
      __builtin_amdgcn_fence(__ATOMIC_RELEASE, "agent");
      asm volatile("s_waitcnt vmcnt(0)" ::: "memory");
      const unsigned og = xb_add(&bar[XB_TOP], 1u);
      const unsigned tg = og / nx;
      if (og + 1u == (tg + 1u) * nx) xb_add(&bar[XB_TOPGEN], 1u);
      else XB_SPIN(xb_ld(&bar[XB_TOPGEN]) == tg, bar);
      __builtin_amdgcn_fence(__ATOMIC_ACQUIRE, "agent");
      xb_add(&bar[XB_XGEN(b.x)], 1u);
      asm volatile("s_waitcnt vmcnt(0)" ::: "memory");
    } else {
      XB_SPIN(xb_ld(&bar[XB_XGEN(b.x)]) == gen, bar);
      __builtin_amdgcn_fence(__ATOMIC_ACQUIRE, "agent");
      asm volatile("s_waitcnt vmcnt(0)" ::: "memory");
    }
  }
  __syncthreads();
}

DEVI const float* lds_ptr(const char* smem, int i) { const unsigned* t = (const unsigned*)(smem + SM_PTR) + 2 * i;
  const unsigned lo = __builtin_amdgcn_readfirstlane(t[0]), hi = __builtin_amdgcn_readfirstlane(t[1]);
  typedef const float __attribute__((address_space(1))) gfloat; return (const float*)(gfloat*)(((unsigned long long)hi << 32) | lo); }
DEVI Params load_params(const char* smem) {
  Params q;
  q.x = lds_ptr(smem, 0); q.c = lds_ptr(smem, 1); q.ctx = lds_ptr(smem, 2); q.c_ctx = lds_ptr(smem, 3); q.w_mod = lds_ptr(smem, 4); q.b_mod = lds_ptr(smem, 5);
  q.g_attn = lds_ptr(smem, 6); q.g_ffn = lds_ptr(smem, 7); q.w_in = lds_ptr(smem, 8); q.g_q = lds_ptr(smem, 9); q.g_kv = lds_ptr(smem, 10); q.w_uq = lds_ptr(smem, 11);
  q.w_ukv = lds_ptr(smem, 12); q.rel_bias = lds_ptr(smem, 13); q.w_out = lds_ptr(smem, 14); q.w_rg = lds_ptr(smem, 15); q.b_rg = lds_ptr(smem, 16); q.w_re = lds_ptr(smem, 17);
  q.b_re = lds_ptr(smem, 18); q.w_gate = lds_ptr(smem, 19); q.w_up = lds_ptr(smem, 20); q.w_down = lds_ptr(smem, 21); q.g_final = lds_ptr(smem, 22);
  q.out = (float*)lds_ptr(smem, 23); q.ws = (char*)lds_ptr(smem, 24);
  return q;
}
DEVI XcdBarrier xb_reload(char* smem) { XcdBarrier b; b.bar = (unsigned*)((char*)lds_ptr(smem, 24) + OFF_BAR); b.st = (volatile LAS unsigned*)(smem + SM_BARW);
  b.x = (unsigned)__builtin_amdgcn_readfirstlane((int)b.st[4]); return b; }
#define GRID_BARRIER() do { const XcdBarrier _xb = xb_reload(smem); xcd_barrier(_xb); } while (0)
#define VBID() __builtin_amdgcn_readfirstlane((int)((volatile LAS unsigned*)(smem + SM_BARW))[3])
#define TS(i) do { if (TIMING_PROBE && blockIdx.x == 0 && threadIdx.x == 0) ((unsigned long long*)(pk.ws + OFF_CNT + 64))[i] = __builtin_amdgcn_s_memrealtime(); } while (0)
#ifndef REPEAT_MASK
#define REPEAT_MASK 0
#endif
#define REP(i) _Pragma("nounroll") for (int _r = 0; _r < ((PHASE_ONLY >= 0 && PHASE_ONLY != (i)) ? 0 : (((REPEAT_MASK >> (i)) & 1) ? 2 : 1)); ++_r)

__global__ void __launch_bounds__(NTHREADS, 2) mega_kernel(Params pk) {
  __shared__ __attribute__((aligned(16))) char smem[LDS_TOTAL];
  const int nb = gridDim.x;
  if (threadIdx.x == 0) { *(uint4*)(smem + SM_BARW) = make_uint4(0u, 0u, 0u, (unsigned)blockIdx.x); *(uint4*)(smem + SM_BARW + 16) = make_uint4(0u, 0u, 0u, 0u); }
  if (threadIdx.x < 25) ((unsigned long long*)(smem + SM_PTR))[threadIdx.x] = ((const unsigned long long*)&pk)[threadIdx.x];
  __syncthreads();
  { const XcdBarrier xb0 = xcd_barrier_post((unsigned*)(pk.ws + OFF_BAR), (volatile LAS unsigned*)(smem + SM_BARW));
    if (threadIdx.x == 0) ((volatile LAS unsigned*)(smem + SM_BARW))[4] = xb0.x; }
  __syncthreads();
  TS(0);
  REP(0) { const Params p = load_params(smem); phase_A(p, (int)blockIdx.x, nb, smem); GRID_BARRIER(); }
  TS(1);
  { volatile LAS unsigned* st = (volatile LAS unsigned*)(smem + SM_BARW);
    if (threadIdx.x == 0) { unsigned* bar = (unsigned*)(pk.ws + OFF_BAR); bool even = (nb % 8) == 0;
      for (unsigned j = 0; j < 16; ++j) { const unsigned c = xb_ld(&bar[XB_XCNT(j)]); even = even && (c == (j < 8 ? (unsigned)nb / 8u : 0u)); }
      st[3] = even ? st[2] * 8u + st[4] : (unsigned)blockIdx.x; }
    __syncthreads(); }
  REP(1) { const Params p = load_params(smem); const int bid = VBID(); phase_B(p, bid, nb); GRID_BARRIER(); }
  TS(2);
  REP(2) { { const Params p = load_params(smem); const int bid = VBID(); phase_C(p, bid, nb, smem); }
    { const Params p = load_params(smem); conv_queue(p, smem, 1, NCONV_A, NCONV_C); }
    GRID_BARRIER(); }
  TS(3);
  REP(3) { const Params p = load_params(smem); const int bid = VBID(); phase_D(p, bid, nb, smem); GRID_BARRIER(); }
  TS(4);
  REP(4) { { const Params p = load_params(smem); const int bid = VBID(); phase_E(p, bid, nb, smem); }
    { const Params p = load_params(smem); conv_queue(p, smem, 3, NCONV_C, NCONV_E); }
    GRID_BARRIER(); }
  TS(5);
  REP(5) { const Params p = load_params(smem); const int bid = VBID(); phase_F(p, bid, nb, smem); GRID_BARRIER(); }
  TS(6);
  REP(6) { const Params p = load_params(smem); const int bid = VBID(); phase_G(p, bid, nb, smem); GRID_BARRIER(); }
  TS(7);
  REP(7) { { const Params p = load_params(smem); const int bid = VBID(); phase_H(p, bid, nb, smem); }
    { const Params p = load_params(smem); conv_queue(p, smem, 2, NCONV_E, NCONV); }
    GRID_BARRIER(); }
  TS(8);
  REP(8) { const Params p = load_params(smem); const int bid = VBID(); phase_I(p, bid, nb, smem); GRID_BARRIER(); }
  TS(9);
  REP(9) { const Params p = load_params(smem); const int bid = VBID(); phase_J(p, bid, nb); }
#if TIMING_PROBE
  GRID_BARRIER(); TS(10);
  if (blockIdx.x == 0 && threadIdx.x < 64) {
    const int lane = threadIdx.x;
    const unsigned long long* ts = (const unsigned long long*)(pk.ws + OFF_CNT + 64); float ta = 0.f, tr = 0.f;
#pragma unroll
    for (int qq = 0; qq < 10; ++qq) { const float d = (float)(unsigned)(ts[qq + 1] - ts[qq]) * 0.01f; if ((PROBE_A_MASK >> qq) & 1) ta += d; if ((PROBE_R_MASK >> qq) & 1) tr += d; }
    if ((PROBE_A_MASK >> 10) & 1) ta += (float)(unsigned)(ts[11] - ts[4]) * 0.01f;
    if ((PROBE_R_MASK >> 11) & 1) tr += (float)(unsigned)(ts[12] - ts[11]) * 0.01f;
    if ((PROBE_A_MASK >> 12) & 1) ta += (float)(unsigned)(ts[5] - ts[12]) * 0.01f;
    if (lane == 0) pk.out[0] += 1.f + ta * 0.01f;
    { float4* o4 = (float4*)(pk.out + 1024 + lane * 16);
#pragma unroll
      for (int i = 0; i < 4; ++i) { float4 v = o4[i]; v.x += tr * PROBE_R_SCALE; v.y += tr * PROBE_R_SCALE; v.z += tr * PROBE_R_SCALE; v.w += tr * PROBE_R_SCALE; o4[i] = v; } }
  }
#endif
}
#endif

extern "C" void kernel_launch(void* const* d_in, const int* in_sizes, int n_in, void* d_out, int out_size, void* d_ws, size_t ws_size, hipStream_t stream) {
  if (n_in != 23 || out_size != TT * 1024 || ws_size < WS_NEED) { fprintf(stderr, "kernel_launch: unexpected shapes n_in %d out %d ws %zu (need %zu)\n", n_in, out_size, ws_size, (size_t)WS_NEED); return; }
  Params p{};
  const float** f = (const float**)&p;
  for (int i = 0; i < 23; ++i) f[i] = (const float*)d_in[i];
  p.out = (float*)d_out; p.ws = (char*)d_ws;
#if ONE_LAUNCH
  static int grid_blocks = 0;
  if (!grid_blocks) {
    int dev = 0, cus = 0, per_cu = 0;
    hipGetDevice(&dev);
    hipDeviceGetAttribute(&cus, hipDeviceAttributeMultiprocessorCount, dev);
    hipOccupancyMaxActiveBlocksPerMultiprocessor(&per_cu, mega_kernel, NTHREADS, 0);
    if (per_cu > 1) per_cu = 1;
    grid_blocks = cus * per_cu;
    if (grid_blocks <= 0) { fprintf(stderr, "kernel_launch: occupancy query failed (cus %d per_cu %d)\n", cus, per_cu); grid_blocks = 0; return; }
  }
  if (hipMemsetAsync((char*)d_ws + OFF_BAR, 0, 16384, stream) != hipSuccess) { fprintf(stderr, "kernel_launch: memset of barrier words failed\n"); return; }
  hipLaunchKernelGGL(mega_kernel, dim3(grid_blocks), dim3(NTHREADS), 0, stream, p);
  const hipError_t e = hipPeekAtLastError();
  if (e != hipSuccess) fprintf(stderr, "kernel_launch: launch failed: %s (grid %d)\n", hipGetErrorString(e), grid_blocks);
#else
  const int G = 1024;
  hipLaunchKernelGGL(phase_kernel<0>, dim3(G), dim3(NTHREADS), 0, stream, p);
  hipLaunchKernelGGL(phase_kernel<1>, dim3(G), dim3(NTHREADS), 0, stream, p);
  hipLaunchKernelGGL(phase_kernel<2>, dim3(G), dim3(NTHREADS), 0, stream, p);
  hipLaunchKernelGGL(phase_kernel<3>, dim3(G), dim3(NTHREADS), 0, stream, p);
  hipLaunchKernelGGL(phase_kernel<4>, dim3(G), dim3(NTHREADS), 0, stream, p);
  hipLaunchKernelGGL(phase_kernel<5>, dim3(G), dim3(NTHREADS), 0, stream, p);
  hipLaunchKernelGGL(phase_kernel<6>, dim3(G), dim3(NTHREADS), 0, stream, p);
  hipLaunchKernelGGL(phase_kernel<7>, dim3(G), dim3(NTHREADS), 0, stream, p);
  hipLaunchKernelGGL(phase_kernel<8>, dim3(G), dim3(NTHREADS), 0, stream, p);
  hipLaunchKernelGGL(phase_kernel<9>, dim3(G), dim3(NTHREADS), 0, stream, p);
#endif
}
```

```cpp
#include <hip/hip_runtime.h>
#include <cstdio>
#include <cstdint>

#ifndef MODE_EXACT
#define MODE_EXACT 0
#endif
#ifndef ONE_LAUNCH
#define ONE_LAUNCH 1
#endif
#ifndef ATTN_EXACT
#define ATTN_EXACT MODE_EXACT
#endif
#ifndef PHASE_ONLY
#define PHASE_ONLY -1
#endif
#ifndef TIMING_PROBE
#define TIMING_PROBE 0
#endif
#ifndef PROBE_A_MASK
#define PROBE_A_MASK 0
#endif
#ifndef PROBE_R_MASK
#define PROBE_R_MASK 0
#endif
#ifndef PROBE_R_SCALE
#define PROBE_R_SCALE 0.002f
#endif
#ifndef GEMM_EXACT
#define GEMM_EXACT MODE_EXACT
#endif

#define DEVI __device__ __forceinline__

typedef unsigned short bf16_t;
typedef short bf16x8 __attribute__((ext_vector_type(8)));
typedef short s16x4 __attribute__((ext_vector_type(4)));
typedef float f32x16 __attribute__((ext_vector_type(16)));
typedef float f32x4 __attribute__((ext_vector_type(4)));
typedef unsigned u32x4 __attribute__((ext_vector_type(4)));

#if MODE_EXACT
typedef float act_t;
#else
typedef bf16_t act_t;
#endif

constexpr int DM = 1024, NBATCH = 2, SEQ = 8192, CTXL = 256, RB = SEQ + CTXL  , RR = NBATCH * RB  , TT = NBATCH * SEQ  ;
constexpr int GW = 64, GROWS = 128;
constexpr int QL = 384, KVL = 256, NPROJ = 2304  , NPROJ_REAL = 2208;
constexpr int NEXP = 16, DEXP = 512;
constexpr float EPS = 1e-6f, LOG2E = 1.4426950408889634f;
constexpr float QSCALE = 0.10206207261596577f * 1.4426950408889634f;
constexpr float NASCALE = 0.125f * 1.4426950408889634f;
constexpr int HIDROWS = 36864;
constexpr int NTHREADS = 512, NWAVES = 8;

constexpr size_t AS = sizeof(act_t);
constexpr size_t OFF_BAR   = 0;
constexpr size_t OFF_CNT   = 16384;
constexpr size_t OFF_MOD   = OFF_CNT + 256;
constexpr size_t OFF_ROPE  = OFF_MOD + 3 * 6144 * 4;
constexpr size_t OFF_SSQ   = OFF_ROPE + 2 * 128 * 8 * 4;
constexpr size_t OFF_SSKV  = OFF_SSQ + (size_t)RR * 12 * 4;
constexpr size_t OFF_BT    = OFF_SSKV + (size_t)RR * 8 * 4;
constexpr size_t OFF_ELIST = OFF_BT + (size_t)8 * 15 * 4096 * 4;
constexpr size_t OFF_EW    = OFF_ELIST + (size_t)NEXP * TT * 4;
constexpr size_t OFF_WRT   = OFF_EW + (size_t)NEXP * TT * 4;
constexpr size_t OFF_KMAX  = OFF_WRT + 20 * 1024 * 4;
constexpr size_t SMALL_END = OFF_KMAX + 512;
static_assert(SMALL_END <= (size_t)8 << 20, "small region");
constexpr size_t OFF_W     = (size_t)8 << 20;
#if MODE_EXACT
constexpr size_t W_BYTES = 0;
#else
constexpr size_t W_BYTES = (size_t)60 << 20;
#endif
constexpr size_t OFF_WIN  = OFF_W;
constexpr size_t OFF_WUQ  = OFF_WIN + (size_t)NPROJ * 1024 * 2;
constexpr size_t OFF_WUKV = OFF_WUQ + (size_t)768 * 384 * 2;
constexpr size_t OFF_WOUT = OFF_WUKV + (size_t)1024 * 256 * 2;
constexpr size_t OFF_WGU  = OFF_WOUT + (size_t)1024 * 1024 * 2;
constexpr size_t OFF_WD   = OFF_WGU + (size_t)16 * 1024 * 1024 * 2;
constexpr size_t W_END    = OFF_WD + (size_t)16 * 1024 * 512 * 2;
static_assert(MODE_EXACT || W_END <= OFF_W + W_BYTES, "weights region");
constexpr size_t G0 = OFF_W + W_BYTES;
constexpr size_t OFF_HXALL = G0;
constexpr size_t OFF_KV    = OFF_HXALL;
constexpr size_t OFF_NAQ   = OFF_HXALL + (size_t)RR * 1024 * AS;
constexpr size_t OFF_NAK   = OFF_NAQ + (size_t)RR * 512 * AS;
constexpr size_t OFF_NAV   = OFF_NAK + (size_t)RR * 512 * AS;
constexpr size_t OFF_KROPE = OFF_NAV + (size_t)RR * 512 * AS;
constexpr size_t OFF_QLAT  = OFF_KROPE + (size_t)RR * 32 * AS;
constexpr size_t OFF_KVLAT = OFF_QLAT + (size_t)RR * 384 * AS;
constexpr size_t OFF_ATTN  = OFF_QLAT;
constexpr size_t ATT_END   = OFF_ATTN + (size_t)TT * 1024 * AS;
constexpr size_t OFF_YBUF  = G0;
constexpr size_t OFF_HX2   = G0;
constexpr size_t OFF_HID   = OFF_YBUF + (size_t)2 * TT * 1024 * AS;
constexpr size_t MOE_END   = OFF_HID + (size_t)HIDROWS * 512 * AS;
constexpr size_t OFF_X1    = ATT_END > MOE_END ? ATT_END : MOE_END;
constexpr size_t WS_NEED   = OFF_X1 + (size_t)TT * 1024 * AS;
static_assert(MODE_EXACT || WS_NEED <= ((size_t)256 << 20), "workspace");

struct Params {
  const float *x, *c, *ctx, *c_ctx, *w_mod, *b_mod, *g_attn, *g_ffn, *w_in, *g_q, *g_kv, *w_uq, *w_ukv, *rel_bias, *w_out,
              *w_rg, *b_rg, *w_re, *b_re, *w_gate, *w_up, *w_down, *g_final;
  float* out; char* ws;
};

DEVI float bf2f(bf16_t v) { return __uint_as_float(((unsigned)v) << 16); }
DEVI bf16_t f2bf(float f) { unsigned u = __float_as_uint(f); u += 0x7fffu + ((u >> 16) & 1u); return (bf16_t)(u >> 16); }
typedef __bf16 bf16x2_t __attribute__((ext_vector_type(2)));
typedef float f32x2_t __attribute__((ext_vector_type(2)));
DEVI unsigned pk2(float lo, float hi) { const f32x2_t v = {lo, hi}; return __builtin_bit_cast(unsigned, __builtin_convertvector(v, bf16x2_t)); }
DEVI float a2f(float v) { return v; }
DEVI float a2f(bf16_t v) { return bf2f(v); }
DEVI void ld4(const float* p, float (&v)[4]) { const float4 t = *(const float4*)p; v[0] = t.x; v[1] = t.y; v[2] = t.z; v[3] = t.w; }
DEVI void ld4(const bf16_t* p, float (&v)[4]) { const uint2 t = *(const uint2*)p; v[0] = __uint_as_float(t.x << 16); v[1] = __uint_as_float(t.x & 0xffff0000u); v[2] = __uint_as_float(t.y << 16); v[3] = __uint_as_float(t.y & 0xffff0000u); }
DEVI void st4(float* p, float a, float b, float c, float d) { *(float4*)p = make_float4(a, b, c, d); }
DEVI void st4(bf16_t* p, float a, float b, float c, float d) { uint2 t; t.x = pk2(a, b); t.y = pk2(c, d); *(uint2*)p = t; }
DEVI void st1(float* p, float a) { *p = a; }
DEVI void st1(bf16_t* p, float a) { *p = f2bf(a); }
DEVI int crow(int r, int hi) { return (r & 3) + 8 * (r >> 2) + 4 * hi; }
DEVI float wave_sum(float v) { v += __shfl_xor(v, 32); v += __shfl_xor(v, 16); v += __shfl_xor(v, 8); v += __shfl_xor(v, 4); v += __shfl_xor(v, 2); v += __shfl_xor(v, 1); return v; }
DEVI float half_sum32(float v) { v += __shfl_xor(v, 16); v += __shfl_xor(v, 8); v += __shfl_xor(v, 4); v += __shfl_xor(v, 2); v += __shfl_xor(v, 1); return v; }
DEVI float xhalf_max(float v) { auto rr = __builtin_amdgcn_permlane32_swap(__float_as_uint(v), __float_as_uint(v), false, false); return fmaxf(__uint_as_float(rr[0]), __uint_as_float(rr[1])); }
DEVI float xhalf_sum(float v) { auto rr = __builtin_amdgcn_permlane32_swap(__float_as_uint(v), __float_as_uint(v), false, false); return __uint_as_float(rr[0]) + __uint_as_float(rr[1]); }
DEVI float silu_f(float v) { return v / (1.f + expf(-v)); }
DEVI float silu_fast(float v) { return v * __builtin_amdgcn_rcpf(1.f + __builtin_amdgcn_exp2f(-v * LOG2E)); }

DEVI int xcd_unit(int v, int U) { const int chunk = (U + 7) >> 3; const int x = v & 7, j = v >> 3; if (j >= chunk) return -1; const int u = x * chunk + j; return u < U ? u : -1; }
DEVI void panel_order(int idx, int nM, int nN, int& tm, int& tn) { const int nig = 8 * nN, gid = idx / nig, fm = gid * 8, gsz = (nM - fm) < 8 ? (nM - fm) : 8, r = idx - gid * nig; tm = fm + r % gsz; tn = r / gsz; }
DEVI int xcd_iters(int U, int nb) { const int chunk = (U + 7) >> 3; return (chunk * 8 + nb - 1) / nb; }

struct WInAcc { const float* w; static constexpr int LD = NPROJ_REAL;
  DEVI const float* col(int n, float& msk) const { const int o = n < 1152 ? n : (n < 2176 ? n + 32 : n - 1024); const bool ok = n < 2208; msk = ok ? 1.f : 0.f; return w + (ok ? o : 0); }
  DEVI float kscale(int) const { return 1.f; }
  DEVI float at(int k, int n) const { int o; if (n < 1152) o = n; else if (n < 2176) o = n + 32; else if (n < 2208) o = n - 1024; else return 0.f; return w[(size_t)k * NPROJ_REAL + o]; } };
struct WUqAcc { const float* w; const float* g; static constexpr int LD = 768;
  DEVI const float* col(int n, float& msk) const { msk = 1.f; return w + n; }
  DEVI float kscale(int k) const { return g[k]; }
  DEVI float at(int k, int n) const { return g[k] * w[(size_t)k * 768 + n]; } };
struct WUkvAcc { const float* w; const float* g; static constexpr int LD = 1024;
  DEVI const float* col(int n, float& msk) const { msk = 1.f; return w + n; }
  DEVI float kscale(int k) const { return g[k]; }
  DEVI float at(int k, int n) const { return g[k] * w[(size_t)k * 1024 + n]; } };
struct WOutAcc { const float* w; static constexpr int LD = 1024;
  DEVI const float* col(int n, float& msk) const { msk = 1.f; return w + n; }
  DEVI float kscale(int) const { return 1.f; }
  DEVI float at(int k, int n) const { return w[(size_t)k * 1024 + n]; } };
struct WGUAcc { const float* wg; const float* wu;
  static constexpr int LD = 512;
  DEVI const float* col(int n, float& msk) const { const int g = n >> 3, j = n & 7; msk = 1.f;
    const unsigned long long a = (unsigned long long)wg, b = (unsigned long long)wu;
    const unsigned lo = j < 4 ? (unsigned)a : (unsigned)b, hi = j < 4 ? (unsigned)(a >> 32) : (unsigned)(b >> 32);
    return (const float*)(((unsigned long long)hi << 32) | lo) + g * 4 + (j & 3); }
  DEVI float kscale(int) const { return 1.f; }
  DEVI float at(int k, int n) const { const int g = n >> 3, j = n & 7; return j < 4 ? wg[(size_t)k * 512 + g * 4 + j] : wu[(size_t)k * 512 + g * 4 + j - 4]; } };
struct WDAcc { const float* w; static constexpr int LD = 1024;
  DEVI const float* col(int n, float& msk) const { msk = 1.f; return w + n; }
  DEVI float kscale(int) const { return 1.f; }
  DEVI float at(int k, int n) const { return w[(size_t)k * 1024 + n]; } };

namespace g8 {
#define G8_LAS __attribute__((address_space(3)))
constexpr int BM = 256, BK = 64, HALF = 128, HTB = HALF * BK * 2  , STAGE_BYTES = 8 * HTB;
DEVI int lds_byte(int r, int c) { const int st = (r >> 4) * 2 + (c >> 5), rr = r & 15, cc = c & 31, ob = rr * 64 + cc * 2; return st * 1024 + (ob ^ (((ob >> 9) & 1) << 5)); }
DEVI void stage_rc(int b, int& R, int& C) { const int st = b / 1024, sb = b % 1024, swz = sb ^ (((sb >> 9) & 1) << 5); R = (st >> 1) * 16 + swz / 64; C = (st & 1) * 32 + (swz % 64) / 2; }
DEVI int perm32(int rho) { const int n = rho >> 4, i = rho & 15; return 8 * (i >> 2) + 4 * n + (i & 3); }
struct Unit { int pm, pn; };
template <class Epi, class Sched, bool GATHER, int K>
DEVI void gemm_phase(G8_LAS unsigned char* lds, const bf16_t* A, const bf16_t* Bt, const Sched& S, const Epi& E) {
  int tid = threadIdx.x; asm volatile("" : "+v"(tid));
  const int wid = __builtin_amdgcn_readfirstlane(tid >> 6), lane = tid & 63, wr = wid >> 2, wc = wid & 3, fr = lane & 15, fq = lane >> 4;
  constexpr int nt = K / BK;
  int sR[2], sC[2]; unsigned voffB[2];
#pragma unroll
  for (int i = 0; i < 2; ++i) { int R, C; stage_rc(tid * 16 + i * 8192, R, C); sR[i] = R; sC[i] = C; const int Rb = (R & ~31) + perm32(R & 31); voffB[i] = (unsigned)(Rb * K + C) * 2u; }
  constexpr size_t kstep = (size_t)(BK * 2);
  constexpr size_t hstep = (size_t)HALF * K * 2;
  constexpr size_t tstep = 2 * hstep;
  const unsigned ldsw = (unsigned)wid * 1024u;
  const int aoff = lds_byte(wr * 64 + fr, fq * 8), boff = lds_byte(wc * 32 + fr, fq * 8);
#define PG8_SA(b, h) (((b) * 2 + (h)) * HTB)
#define PG8_SB(b, h) ((4 + (b) * 2 + (h)) * HTB)
#define PG8_STAGE(bufoff, gbase, voff) do { _Pragma("unroll") for (int _i = 0; _i < 2; ++_i) \
        __builtin_amdgcn_global_load_lds((const unsigned*)((const char*)(gbase) + (voff)[_i]), (G8_LAS unsigned*)(lds + (bufoff) + ldsw + _i * 8192), 16, 0, 0); } while (0)
#define PG8_LDA(dst, b, h) do { _Pragma("unroll") for (int m = 0; m < 4; ++m) _Pragma("unroll") for (int k = 0; k < 2; ++k) dst[m][k] = *(const G8_LAS bf16x8*)(lds + PG8_SA(b, h) + aoff + m * 2048 + k * 1024); } while (0)
#define PG8_LDB(dst, b, h) do { _Pragma("unroll") for (int n = 0; n < 2; ++n) _Pragma("unroll") for (int k = 0; k < 2; ++k) dst[n][k] = *(const G8_LAS bf16x8*)(lds + PG8_SB(b, h) + boff + n * 2048 + k * 1024); } while (0)
#define PG8_MMA(ai, bj, At, Bt_) do { __builtin_amdgcn_s_setprio(1); _Pragma("unroll") for (int m = 0; m < 4; ++m) _Pragma("unroll") for (int n = 0; n < 2; ++n) _Pragma("unroll") for (int k = 0; k < 2; ++k) \
        acc[ai][bj][m][n] = __builtin_amdgcn_mfma_f32_16x16x32_bf16(Bt_[n][k], At[m][k], acc[ai][bj][m][n], 0, 0, 0); __builtin_amdgcn_s_setprio(0); } while (0)
#define PG8_WAIT_V(n) asm volatile("s_waitcnt vmcnt(" #n ")" ::: "memory")
#define PG8_WAIT_L(n) asm volatile("s_waitcnt lgkmcnt(" #n ")" ::: "memory")
#define PG8_BAR __builtin_amdgcn_s_barrier()
#define PG8_SCHED __builtin_amdgcn_sched_barrier(0)
  Unit cur, nxt; int ui = 0;
  if (!S.next(0, cur)) return;
  f32x4 acc[2][2][4][2];
#pragma unroll
  for (int a = 0; a < 2; ++a)
#pragma unroll
    for (int b = 0; b < 2; ++b)
#pragma unroll
      for (int m = 0; m < 4; ++m)
#pragma unroll
        for (int n = 0; n < 2; ++n) acc[a][b][m][n] = (f32x4){0.f, 0.f, 0.f, 0.f};
  bf16x8 At[4][2], B0[2][2], B1[2][2];
  unsigned vA0[2], vA1[2];
#define G8_SETV(U_, V0, V1) do { _Pragma("unroll") for (int _i = 0; _i < 2; ++_i) { \
      V0[_i] = (unsigned)S.arow(U_, sR[_i]) * (unsigned)(K * 2) + (unsigned)(sC[_i] * 2); V1[_i] = (unsigned)S.arow(U_, 128 + sR[_i]) * (unsigned)(K * 2) + (unsigned)(sC[_i] * 2); } } while (0)
  if (GATHER) { G8_SETV(cur, vA0, vA1); }
  else {
#pragma unroll
    for (int i = 0; i < 2; ++i) { vA0[i] = (unsigned)(sR[i] * K + sC[i]) * 2u; vA1[i] = vA0[i]; } }
  constexpr size_t hA = GATHER ? (size_t)0 : hstep;
  const char* cA = GATHER ? (const char*)A : (const char*)A + (size_t)cur.pm * tstep; const char* cB = (const char*)Bt + (size_t)cur.pn * tstep;
  PG8_STAGE(PG8_SB(0, 0), cB, voffB); PG8_STAGE(PG8_SA(0, 0), cA, vA0); PG8_STAGE(PG8_SB(0, 1), cB + hstep, voffB); PG8_STAGE(PG8_SA(0, 1), cA + hA, vA1);
  if (wr == 1) PG8_BAR;
  PG8_WAIT_V(4); PG8_BAR;
  PG8_STAGE(PG8_SB(1, 0), cB + kstep, voffB); PG8_STAGE(PG8_SA(1, 0), cA + kstep, vA0); PG8_STAGE(PG8_SB(1, 1), cB + hstep + kstep, voffB);
  PG8_WAIT_V(6); PG8_BAR;
  for (;;) {
    const bool has_next = S.next(ui + 1, nxt);
    const char* nA = has_next ? (GATHER ? (const char*)A : (const char*)A + (size_t)nxt.pm * tstep) : cA; const char* nB = has_next ? (const char*)Bt + (size_t)nxt.pn * tstep : cB;
#pragma unroll 1
    for (int t = 0; t < nt; t += 2) {
      const bool last = (t == nt - 2);
      const char* a1 = cA + (size_t)(t + 1) * kstep;
      const char* a2 = last ? nA : cA + (size_t)(t + 2) * kstep; const char* b2 = last ? nB : cB + (size_t)(t + 2) * kstep;
      const char* a3 = a2 + kstep; const char* b3 = b2 + kstep;
      PG8_LDB(B0, 0, 0); PG8_SCHED; PG8_LDA(At, 0, 0); PG8_STAGE(PG8_SA(1, 1), a1 + hA, vA1);
      PG8_WAIT_L(8); PG8_BAR; PG8_WAIT_L(0); PG8_MMA(0, 0, At, B0); PG8_BAR; PG8_SCHED;
      if (GATHER) { if (last && has_next) { G8_SETV(nxt, vA0, vA1); } }
      PG8_LDB(B1, 0, 1); PG8_STAGE(PG8_SB(0, 0), b2, voffB);
      PG8_BAR; PG8_WAIT_L(0); PG8_MMA(0, 1, At, B1); PG8_BAR;
      PG8_LDA(At, 0, 1); PG8_STAGE(PG8_SA(0, 0), a2, vA0);
      PG8_BAR; PG8_WAIT_L(0); PG8_MMA(1, 0, At, B0); PG8_BAR; PG8_SCHED;
      PG8_STAGE(PG8_SB(0, 1), b2 + hstep, voffB);
      PG8_WAIT_V(6); PG8_BAR; PG8_MMA(1, 1, At, B1); PG8_BAR;
      PG8_LDB(B0, 1, 0); PG8_SCHED; PG8_LDA(At, 1, 0); PG8_STAGE(PG8_SA(0, 1), a2 + hA, vA1);
      PG8_WAIT_L(8); PG8_BAR; PG8_WAIT_L(0); PG8_MMA(0, 0, At, B0); PG8_BAR; PG8_SCHED;
      PG8_LDB(B1, 1, 1); PG8_STAGE(PG8_SB(1, 0), b3, voffB);
      PG8_BAR; PG8_WAIT_L(0); PG8_MMA(0, 1, At, B1); PG8_BAR;
      PG8_LDA(At, 1, 1); PG8_STAGE(PG8_SA(1, 0), a3, vA0);
      PG8_BAR; PG8_WAIT_L(0); PG8_MMA(1, 0, At, B0); PG8_BAR; PG8_SCHED;
      PG8_STAGE(PG8_SB(1, 1), b3 + hstep, voffB);
      PG8_WAIT_V(6); PG8_BAR; PG8_MMA(1, 1, At, B1); PG8_BAR;
    }
    E(acc, cur, wr, wc, fr, fq);
    if (!has_next) break;
#pragma unroll
    for (int a = 0; a < 2; ++a)
#pragma unroll
      for (int b = 0; b < 2; ++b)
#pragma unroll
        for (int m = 0; m < 4; ++m)
#pragma unroll
          for (int n = 0; n < 2; ++n) acc[a][b][m][n] = (f32x4){0.f, 0.f, 0.f, 0.f};
    cur = nxt; cA = nA; cB = nB; ++ui;
  }
  PG8_WAIT_V(0);
  if (wr == 0) PG8_BAR;
  PG8_BAR;
#undef G8_SETV
#undef PG8_SA
#undef PG8_SB
#undef PG8_STAGE
#undef PG8_LDA
#undef PG8_LDB
#undef PG8_MMA
#undef PG8_WAIT_V
#undef PG8_WAIT_L
#undef PG8_BAR
#undef PG8_SCHED
}
}

constexpr int PH_BYTES = 139264;
constexpr int SM_BARW  = PH_BYTES;
constexpr int SM_TAB   = PH_BYTES + 32;
constexpr int SM_PTR   = PH_BYTES + 32 + 160;
constexpr int LDS_TOTAL = PH_BYTES + 32 + 160 + 208;
constexpr int KM_KN = 0;
constexpr int KM_KR = 32;
constexpr int KM_NA = 40;
constexpr int KM_BM = 80;

DEVI void store8(bf16_t* p, const f32x4& a, const f32x4& b) { u32x4 w = {pk2(a[0], a[1]), pk2(a[2], a[3]), pk2(b[0], b[1]), pk2(b[2], b[3])}; *(u32x4*)p = w; }
DEVI float sumsq8(const f32x4& a, const f32x4& b) { return a[0] * a[0] + a[1] * a[1] + a[2] * a[2] + a[3] * a[3] + b[0] * b[0] + b[1] * b[1] + b[2] * b[2] + b[3] * b[3]; }
DEVI float fq_sum(float v) { v += __shfl_xor(v, 16); v += __shfl_xor(v, 32); return v; }
DEVI float fr_max(float v) { v = fmaxf(v, __shfl_xor(v, 1)); v = fmaxf(v, __shfl_xor(v, 2)); v = fmaxf(v, __shfl_xor(v, 4)); v = fmaxf(v, __shfl_xor(v, 8)); return v; }
DEVI void rope8(f32x4& v0, f32x4& v1, int fq, int gr, int gc, const float* rc, const float* rs) {
  const int pb = ((fq & 1) ? gc : gr) * 8;
  float x[8] = {v0[0], v0[1], v0[2], v0[3], v1[0], v1[1], v1[2], v1[3]};
#pragma unroll
  for (int e = 0; e < 8; ++e) { const float y = __shfl_xor(x[e], 32); const float cs = rc[pb + e], sn = rs[pb + e];
    x[e] = fq < 2 ? x[e] * cs - y * sn : y * sn + x[e] * cs; }
  v0 = (f32x4){x[0], x[1], x[2], x[3]}; v1 = (f32x4){x[4], x[5], x[6], x[7]};
}

struct SchedGrid {
  int nM, nN, U, nb, bid, mskip;
  DEVI bool next(int i, g8::Unit& u) const { const int x = xcd_unit(bid + i * nb, U); if (x < 0) return false; int tm, tn; panel_order(x, nM, nN, tm, tn); u.pm = mskip ? tm + 1 + tm / 32 : tm; u.pn = tn; return true; }
  DEVI unsigned arow(const g8::Unit&, int) const { return 0u; }
};
typedef const int __attribute__((address_space(3))) las_cint;
struct SchedMoe {
  las_cint* tab; const int* elist; int MT, U, nb, bid;
  DEVI bool next(int i, g8::Unit& u) const { const int x = xcd_unit(bid + i * nb, U); if (x < 0) return false; int mt, tn; panel_order(x, MT, 4, mt, tn);
    int e = 0;
#pragma unroll
    for (int q = 1; q < 16; ++q) e += (mt >= tab[q]) ? 1 : 0;
    u.pm = mt; u.pn = e * 4 + tn; return true; }
  DEVI unsigned arow(const g8::Unit& u, int r) const { const int e = u.pn >> 2, slot = (u.pm - tab[e]) * 256 + r; return slot < tab[17 + e] ? (unsigned)(elist[(size_t)e * TT + slot] >> 1) : 0u; }
};
DEVI void moe_table(const Params& p, char* smem) {
  if (threadIdx.x == 0) { int* tab = (int*)(smem + SM_TAB); const int* cnt = (const int*)(p.ws + OFF_CNT); int acc = 0;
    for (int e = 0; e < 16; ++e) { tab[e] = acc; tab[17 + e] = cnt[e]; acc += (cnt[e] + 255) >> 8; } tab[16] = acc; }
  __syncthreads();
}

#define EPI_ROWS for (int ai = 0; ai < 2; ++ai) _Pragma("unroll") for (int m = 0; m < 4; ++m)
struct EpiProj8 { const Params* p;
  DEVI void operator()(const f32x4 (&acc)[2][2][4][2], const g8::Unit& u, int wr, int wc, int fr, int fq) const {
    char* ws = p->ws; const int b = (u.pm * 256) / RB;
    const float* rc = (const float*)(ws + OFF_ROPE); const float* rs = rc + 1024;
#pragma unroll
    for (int bj = 0; bj < 2; ++bj) {
      const int gc = u.pn * 256 + bj * 128 + wc * 32;
      float rmx = 0.f;
#pragma unroll
      EPI_ROWS {
        const int row = u.pm * 256 + ai * 128 + wr * 64 + m * 16 + fr;
        f32x4 v0 = acc[ai][bj][m][0], v1 = acc[ai][bj][m][1];
        if (gc < 384) { store8((bf16_t*)(ws + OFF_QLAT) + (size_t)row * 384 + gc + 8 * fq, v0, v1);
          const float ss = fq_sum(sumsq8(v0, v1)); if (fq == 0) ((float*)(ws + OFF_SSQ))[(size_t)row * 12 + (gc >> 5)] = ss; }
        else if (gc < 896) { store8((bf16_t*)(ws + OFF_NAQ) + (size_t)row * 512 + (gc - 384) + 8 * fq, v0 * NASCALE, v1 * NASCALE); }
        else if (gc < 1152) { store8((bf16_t*)(ws + OFF_KVLAT) + (size_t)row * 256 + (gc - 896) + 8 * fq, v0, v1);
          const float ss = fq_sum(sumsq8(v0, v1)); if (fq == 0) ((float*)(ws + OFF_SSKV))[(size_t)row * 8 + ((gc - 896) >> 5)] = ss; }
        else if (gc < 1664) { store8((bf16_t*)(ws + OFF_NAK) + (size_t)row * 512 + (gc - 1152) + 8 * fq, v0, v1); rmx = fmaxf(rmx, fq_sum(sumsq8(v0, v1))); }
        else if (gc < 2176) { store8((bf16_t*)(ws + OFF_NAV) + (size_t)row * 512 + (gc - 1664) + 8 * fq, v0, v1); }
        else if (gc == 2176) { const int rb = row % RB;
          if (rb >= CTXL) { const int pos = rb - CTXL; rope8(v0, v1, fq, pos >> 6, pos & 63, rc, rs); }
          store8((bf16_t*)(ws + OFF_KROPE) + (size_t)row * 32 + 8 * fq, v0, v1); rmx = fmaxf(rmx, fq_sum(sumsq8(v0, v1))); }
      }
      if (gc >= 1152 && gc < 1664) { rmx = fr_max(rmx); if ((threadIdx.x & 63) == 0) atomicMax((unsigned*)(ws + OFF_KMAX) + KM_NA + b * 16 + ((gc - 1152) >> 5), __float_as_uint(rmx)); }
      if (gc == 2176) { rmx = fr_max(rmx); if ((threadIdx.x & 63) == 0) atomicMax((unsigned*)(ws + OFF_KMAX) + KM_KR + b, __float_as_uint(rmx)); }
    }
  } };

struct EpiQm8 { const Params* p;
  DEVI void operator()(const f32x4 (&acc)[2][2][4][2], const g8::Unit& u, int wr, int wc, int fr, int fq) const {
    char* ws = p->ws; bf16_t* qm = (bf16_t*)p->out;
    const float* rc = (const float*)(ws + OFF_ROPE); const float* rs = rc + 1024;
    float sc8[2][4];
#pragma unroll
    for (int ai = 0; ai < 2; ++ai)
#pragma unroll
      for (int m = 0; m < 4; ++m) { const int row = u.pm * 256 + ai * 128 + wr * 64 + m * 16 + fr;
        const f32x4* sp = (const f32x4*)((const float*)(ws + OFF_SSQ) + (size_t)row * 12); f32x4 s0 = {0.f, 0.f, 0.f, 0.f}; if (fq < 3) s0 = sp[fq];
        sc8[ai][m] = (s0[0] + s0[1]) + (s0[2] + s0[3]); }
#pragma unroll
    for (int ai = 0; ai < 2; ++ai)
#pragma unroll
      for (int m = 0; m < 4; ++m) sc8[ai][m] = rsqrtf(fq_sum(sc8[ai][m]) * (1.f / 384.f) + EPS) * QSCALE;
    {
#pragma unroll
    EPI_ROWS {
      const int row = u.pm * 256 + ai * 128 + wr * 64 + m * 16 + fr; const int pos = row % RB - CTXL;
      const float sc = sc8[ai][m];
#pragma unroll
      for (int bj = 0; bj < 2; ++bj) { const int gc = u.pn * 256 + bj * 128 + wc * 32;
        f32x4 v0 = acc[ai][bj][m][0], v1 = acc[ai][bj][m][1];
        if ((gc % 96) == 64) rope8(v0, v1, fq, pos >> 6, pos & 63, rc, rs);
        store8(qm + (size_t)row * 768 + gc + 8 * fq, v0 * sc, v1 * sc); }
    }
    }
  } };

struct EpiKv8 { const Params* p;
  DEVI void operator()(const f32x4 (&acc)[2][2][4][2], const g8::Unit& u, int wr, int wc, int fr, int fq) const {
    char* ws = p->ws; const int b = (u.pm * 256) / RB; float rmx[2] = {0.f, 0.f};
    float sc8[2][4];
#pragma unroll
    for (int ai = 0; ai < 2; ++ai)
#pragma unroll
      for (int m = 0; m < 4; ++m) { const int row = u.pm * 256 + ai * 128 + wr * 64 + m * 16 + fr;
        const f32x4* sp = (const f32x4*)((const float*)(ws + OFF_SSKV) + (size_t)row * 8); f32x4 s0 = {0.f, 0.f, 0.f, 0.f}; if (fq < 2) s0 = sp[fq];
        sc8[ai][m] = (s0[0] + s0[1]) + (s0[2] + s0[3]); }
#pragma unroll
    for (int ai = 0; ai < 2; ++ai)
#pragma unroll
      for (int m = 0; m < 4; ++m) sc8[ai][m] = rsqrtf(fq_sum(sc8[ai][m]) * (1.f / 256.f) + EPS);
#pragma unroll
    EPI_ROWS {
      const int row = u.pm * 256 + ai * 128 + wr * 64 + m * 16 + fr; const float sc = sc8[ai][m];
#pragma unroll
      for (int bj = 0; bj < 2; ++bj) { const int gc = u.pn * 256 + bj * 128 + wc * 32;
        const f32x4 v0 = acc[ai][bj][m][0] * sc, v1 = acc[ai][bj][m][1] * sc;
        store8((bf16_t*)(ws + OFF_KV) + (size_t)row * 1024 + gc + 8 * fq, v0, v1);
        if ((gc & 127) < 64) rmx[bj] = fmaxf(rmx[bj], fq_sum(sumsq8(v0, v1))); }
    }
#pragma unroll
    for (int bj = 0; bj < 2; ++bj) { const int gc = u.pn * 256 + bj * 128 + wc * 32;
      if ((gc & 127) < 64) { const float r = fr_max(rmx[bj]); if ((threadIdx.x & 63) == 0) atomicMax((unsigned*)(ws + OFF_KMAX) + KM_KN + b * 16 + (gc >> 7) * 2 + ((gc >> 5) & 1), __float_as_uint(r)); } }
  } };

struct EpiOut8 { const Params* p;
  DEVI void operator()(const f32x4 (&acc)[2][2][4][2], const g8::Unit& u, int wr, int wc, int fr, int fq) const {
    const float* mod = (const float*)(p->ws + OFF_MOD); const int b = (u.pm * 256) >> 13;
    f32x4 gv[2][2];
#pragma unroll
    for (int bj = 0; bj < 2; ++bj) { const f32x4* gp = (const f32x4*)(mod + b * 6144 + 2048 + u.pn * 256 + bj * 128 + wc * 32 + 8 * fq); gv[bj][0] = gp[0]; gv[bj][1] = gp[1]; }
#pragma unroll
    for (int ai = 0; ai < 2; ++ai)
#pragma unroll
      for (int mh = 0; mh < 2; ++mh) {
        f32x4 xv[2][2][2];
#pragma unroll
        for (int mm = 0; mm < 2; ++mm)
#pragma unroll
          for (int bj = 0; bj < 2; ++bj) { const int m = mh * 2 + mm, tok = u.pm * 256 + ai * 128 + wr * 64 + m * 16 + fr, n = u.pn * 256 + bj * 128 + wc * 32 + 8 * fq;
            const f32x4* xp = (const f32x4*)(p->x + (size_t)tok * 1024 + n); xv[mm][bj][0] = xp[0]; xv[mm][bj][1] = xp[1]; }
#pragma unroll
        for (int mm = 0; mm < 2; ++mm)
#pragma unroll
          for (int bj = 0; bj < 2; ++bj) { const int m = mh * 2 + mm, tok = u.pm * 256 + ai * 128 + wr * 64 + m * 16 + fr, n = u.pn * 256 + bj * 128 + wc * 32 + 8 * fq;
            act_t* op = (act_t*)(p->ws + OFF_X1) + (size_t)tok * 1024 + n;
            const f32x4 r0 = xv[mm][bj][0] + gv[bj][0] * acc[ai][bj][m][0], r1 = xv[mm][bj][1] + gv[bj][1] * acc[ai][bj][m][1];
#if MODE_EXACT
            st4(op, r0[0], r0[1], r0[2], r0[3]); st4(op + 4, r1[0], r1[1], r1[2], r1[3]);
#else
            store8(op, r0, r1);
#endif
          }
      }
  } };

struct EpiGU8 { const Params* p; las_cint* tab;
  DEVI void operator()(const f32x4 (&acc)[2][2][4][2], const g8::Unit& u, int wr, int wc, int fr, int fq) const {
    bf16_t* hid = (bf16_t*)(p->ws + OFF_HID); const int e = u.pn >> 2, tn = u.pn & 3, slot0 = (u.pm - tab[e]) * 256, cnt = tab[17 + e];
    const float* ew = (const float*)(p->ws + OFF_EW) + (size_t)e * TT;
    float cw[2][4];
#pragma unroll
    for (int ai = 0; ai < 2; ++ai)
#pragma unroll
      for (int m = 0; m < 4; ++m) { const int slot = slot0 + ai * 128 + wr * 64 + m * 16 + fr; cw[ai][m] = slot < cnt ? ew[slot] : 0.f; }
#pragma unroll
    EPI_ROWS {
      const int r = ai * 128 + wr * 64 + m * 16 + fr; const bool valid = slot0 + r < cnt; const float c = cw[ai][m];
#pragma unroll
      for (int bj = 0; bj < 2; ++bj) { const int n = tn * 256 + bj * 128 + wc * 32 + 8 * fq;
        const f32x4 g = acc[ai][bj][m][0], up = acc[ai][bj][m][1]; float o[4];
#pragma unroll
        for (int j = 0; j < 4; ++j) o[j] = valid ? silu_fast(g[j]) * up[j] * c : 0.f;
        st4(hid + (size_t)(u.pm * 256 + r) * 512 + (n >> 1), o[0], o[1], o[2], o[3]); }
    }
  } };

struct EpiDown8 { const Params* p; las_cint* tab;
  DEVI void operator()(const f32x4 (&acc)[2][2][4][2], const g8::Unit& u, int wr, int wc, int fr, int fq) const {
    bf16_t* yb = (bf16_t*)(p->ws + OFF_YBUF); const int e = u.pn >> 2, tn = u.pn & 3, slot0 = (u.pm - tab[e]) * 256, cnt = tab[17 + e];
    const int* el = (const int*)(p->ws + OFF_ELIST) + (size_t)e * TT;
    int tk[2][4];
#pragma unroll
    for (int ai = 0; ai < 2; ++ai)
#pragma unroll
      for (int m = 0; m < 4; ++m) { const int slot = slot0 + ai * 128 + wr * 64 + m * 16 + fr; tk[ai][m] = slot < cnt ? el[slot] : -1; }
#pragma unroll
    EPI_ROWS {
      const int t = tk[ai][m];
      if (t >= 0) { bf16_t* rowp = yb + ((size_t)(t & 1) * TT + (t >> 1)) * 1024 + tn * 256 + wc * 32 + 8 * fq;
#pragma unroll
        for (int bj = 0; bj < 2; ++bj) store8(rowp + bj * 128, acc[ai][bj][m][0], acc[ai][bj][m][1]); }
    }
  } };
#undef EPI_ROWS

DEVI void modgemv_item(const Params& p, int item, char* smem) {
  float* sc = (float*)smem; float* red = sc + 3072;
  const int t = threadIdx.x;
  __syncthreads();
  for (int i = t; i < 3072; i += NTHREADS) { const int ci = i >> 10, k = i & 1023; const float v = ci == 0 ? p.c[k] : ci == 1 ? p.c[1024 + k] : p.c_ctx[k]; sc[i] = silu_f(v); }
  __syncthreads();
  const int cc = t & 31, kg = t >> 5, col = item * 32 + cc;
  float a0 = 0.f, a1 = 0.f, a2 = 0.f;
  { const float* wp = p.w_mod + (size_t)kg * 6144 + col;
#pragma unroll 1
    for (int kb = 0; kb < 1024; kb += 512) {
      float wv[32];
#pragma unroll
      for (int u = 0; u < 32; ++u) wv[u] = wp[(size_t)(kb + 16 * u) * 6144];
#pragma unroll
      for (int u = 0; u < 32; ++u) { const int k = kb + 16 * u + kg; a0 = fmaf(sc[k], wv[u], a0); a1 = fmaf(sc[1024 + k], wv[u], a1); a2 = fmaf(sc[2048 + k], wv[u], a2); }
    } }
  red[(kg * 32 + cc) * 3 + 0] = a0; red[(kg * 32 + cc) * 3 + 1] = a1; red[(kg * 32 + cc) * 3 + 2] = a2;
  __syncthreads();
  if (t < 96) { const int c2 = t & 31, ci = t >> 5; float s = 0.f;
#pragma unroll
    for (int g = 0; g < 16; ++g) s += red[(g * 32 + c2) * 3 + ci];
    ((float*)(p.ws + OFF_MOD))[ci * 6144 + item * 32 + c2] = s + p.b_mod[item * 32 + c2]; }
}

DEVI void misc_item(const Params& p) {
  const int t = threadIdx.x;
  if (t < 16) ((int*)(p.ws + OFF_CNT))[t] = 0;
  if (t < KM_BM) ((unsigned*)(p.ws + OFF_KMAX))[t] = 0u;
  { const int h = t >> 6, lane = t & 63; float bm = 0.f;
    for (int i = lane; i < 15 * 31; i += 64) bm = fmaxf(bm, p.rel_bias[h * 465 + i]);
#pragma unroll
    for (int o = 32; o > 0; o >>= 1) bm = fmaxf(bm, __shfl_xor(bm, o));
    if (lane == 0) ((float*)(p.ws + OFF_KMAX))[KM_BM + h] = bm * LOG2E; }
  float* rc = (float*)(p.ws + OFF_ROPE); float* rs = rc + 1024;
  for (int i = t; i < 1024; i += NTHREADS) {
    const int pos = i >> 3, j = i & 7;
    double f = 1.0; for (int q = 0; q < j; ++q) f *= 0.31622776601683794;
    const double a = (double)pos * f; const double n = rint(a * 0.15915494309189535); const double r = a - n * 6.283185307179586477;
    const double r2 = r * r; double sn = r, cs = 1.0, ts = r, tc = 1.0;
    for (int q = 1; q <= 14; ++q) { tc *= -r2 / (double)((2 * q - 1) * (2 * q)); cs += tc; ts *= -r2 / (double)((2 * q) * (2 * q + 1)); sn += ts; }
    rc[i] = (float)cs; rs[i] = (float)sn;
  }
}
DEVI void wrt_item(const Params& p, int j) {
  float* wrt = (float*)(p.ws + OFF_WRT) + j * 1024;
  for (int k = threadIdx.x; k < 1024; k += NTHREADS) wrt[k] = j < 4 ? p.w_rg[k * 4 + j] : p.w_re[k * 16 + j - 4];
}

DEVI void bt_item(const Params& p, int item) {
  unsigned* bt = (unsigned*)(p.ws + OFF_BT) + (size_t)item * 2048;
  for (int i = threadIdx.x; i < 2048; i += NTHREADS) { const int kc = i >> 6, c = i & 63; int cs = c - 8; cs = cs < 0 ? 0 : (cs > 48 ? 48 : cs);
    const float lo = (kc >= cs && kc < cs + 16) ? p.rel_bias[(size_t)item * 31 + (kc - c + 15)] * LOG2E : -1e30f;
    const int k2 = kc + 32; const float hi = (k2 >= cs && k2 < cs + 16) ? p.rel_bias[(size_t)item * 31 + (k2 - c + 15)] * LOG2E : -1e30f;
    bt[i] = pk2(lo, hi); }
}

struct ConvTile { const float* cp; const float* g; bf16_t* dst; int LD, K, n0, k0; float msk; };
DEVI ConvTile conv_desc(const Params& p, int j, int t) {
  constexpr int C_IN = (NPROJ / 64) * 16, C_UQ = 12 * 6, C_UKV = 16 * 4, C_OUT = 256, C_GU = 16 * 16 * 16;
  ConvTile c; c.g = nullptr; c.msk = 1.f; const int nn = t & 63;
  if (j < C_IN) { WInAcc a{p.w_in}; c.n0 = (j >> 4) * 64; c.k0 = (j & 15) * 64; c.cp = a.col(c.n0 + nn, c.msk); c.LD = WInAcc::LD; c.K = 1024; c.dst = (bf16_t*)(p.ws + OFF_WIN); }
  else if ((j -= C_IN) < C_UQ) { c.n0 = (j / 6) * 64; c.k0 = (j % 6) * 64; c.cp = p.w_uq + c.n0 + nn; c.g = p.g_q; c.LD = 768; c.K = 384; c.dst = (bf16_t*)(p.ws + OFF_WUQ); }
  else if ((j -= C_UQ) < C_UKV) { c.n0 = (j >> 2) * 64; c.k0 = (j & 3) * 64; c.cp = p.w_ukv + c.n0 + nn; c.g = p.g_kv; c.LD = 1024; c.K = 256; c.dst = (bf16_t*)(p.ws + OFF_WUKV); }
  else if ((j -= C_UKV) < C_OUT) { c.n0 = (j >> 4) * 64; c.k0 = (j & 15) * 64; c.cp = p.w_out + c.n0 + nn; c.LD = 1024; c.K = 1024; c.dst = (bf16_t*)(p.ws + OFF_WOUT); }
  else if ((j -= C_OUT) < C_GU) { const int e = j >> 8, r = j & 255; c.n0 = (r >> 4) * 64; c.k0 = (r & 15) * 64; WGUAcc a{p.w_gate + (size_t)e * 1024 * 512, p.w_up + (size_t)e * 1024 * 512};
    c.cp = a.col(c.n0 + nn, c.msk); c.LD = 512; c.K = 1024; c.dst = (bf16_t*)(p.ws + OFF_WGU) + (size_t)e * 1024 * 1024; }
  else { j -= C_GU; const int e = j >> 7, r = j & 127; c.n0 = (r >> 3) * 64; c.k0 = (r & 7) * 64; c.cp = p.w_down + (size_t)e * 512 * 1024 + c.n0 + nn; c.LD = 1024; c.K = 512; c.dst = (bf16_t*)(p.ws + OFF_WD) + (size_t)e * 1024 * 512; }
  c.cp += (size_t)(c.k0 + 8 * (t >> 6)) * c.LD;
  return c;
}
DEVI void conv_load(const ConvTile& c, float (&v)[16]) {
#pragma unroll
  for (int i = 0; i < 8; ++i) { v[i] = c.cp[(size_t)i * c.LD]; v[8 + i] = c.cp[(size_t)(64 + i) * c.LD]; }
}
DEVI void conv_finish(const ConvTile& c, const float (&v)[16], int t) {
#pragma unroll
  for (int h = 0; h < 2; ++h) {
    const int kk = c.k0 + 64 * h + 8 * (t >> 6); float x[8];
#pragma unroll
    for (int i = 0; i < 8; ++i) x[i] = v[8 * h + i] * c.msk * (c.g ? c.g[kk + i] : 1.f);
    *(uint4*)(c.dst + (size_t)(c.n0 + (t & 63)) * c.K + kk) = make_uint4(pk2(x[0], x[1]), pk2(x[2], x[3]), pk2(x[4], x[5]), pk2(x[6], x[7])); }
}

constexpr int CONV_C_EXPERTS = 10;
constexpr int NCONV_A = (NPROJ / 64) * 16;
constexpr int NCONV_C = NCONV_A + 12 * 6 + 16 * 4 + 256 + CONV_C_EXPERTS * 256;
constexpr int NCONV_E = NCONV_A + 12 * 6 + 16 * 4 + 256 + 16 * 16 * 16;
constexpr int NCONV = NCONV_E + 16 * 16 * 8;
static_assert(NCONV_A % 4 == 0 && NCONV_C % 4 == 0 && NCONV_E % 4 == 0 && NCONV % 4 == 0, "pairs, two per grab");
DEVI void conv_queue(const Params& p, char* smem, int q, int jbase, int jend) {
  int t = threadIdx.x; asm volatile("" : "+v"(t));
  unsigned* ctr = (unsigned*)(p.ws + OFF_BAR) + 16 * q;
  int* nxt = (int*)(smem + 32768);
  auto grab4 = [&]() -> int { __syncthreads(); if (t == 0) *nxt = jbase + (int)atomicAdd(ctr, 4u); __syncthreads(); return *nxt; };
  int jb = grab4(), jo = 0;
  if (jb < jend) {
    ConvTile c = conv_desc(p, jb, t); float v[16]; conv_load(c, v);
    for (;;) {
      int jn;
      if (jo < 1) { ++jo; jn = jb + 2 * jo; } else { jb = grab4(); jo = 0; jn = jb; }
      const bool more = jn < jend;
      ConvTile cn = c; float vn[16];
      if (more) { cn = conv_desc(p, jn, t); conv_load(cn, vn); }
      conv_finish(c, v, t);
      if (!more) break;
      c = cn;
#pragma unroll
      for (int i = 0; i < 16; ++i) v[i] = vn[i];
    }
  }
}

DEVI void phase_A(const Params& p, int bid, int nb, char* smem) {
  constexpr int N_MOD = 192, N_MISC = 1, N_WRT = 20, N_BT = 120;
  constexpr int I0 = N_MOD + N_MISC + N_WRT + N_BT;
  for (int it = bid; it < I0; it += nb) {
    if (it < N_MOD) modgemv_item(p, it, smem);
    else if (it < N_MOD + N_MISC) misc_item(p);
    else if (it < N_MOD + N_MISC + N_WRT) wrt_item(p, it - N_MOD - N_MISC);
    else bt_item(p, it - N_MOD - N_MISC - N_WRT);
  }
  conv_queue(p, smem, 0, 0, NCONV_A);
}

DEVI void phase_B(const Params& p, int bid, int nb) {
  int tx = threadIdx.x; asm volatile("" : "+v"(tx));
  const int lane = tx & 63, wv = tx >> 6;
  const float* mod = (const float*)(p.ws + OFF_MOD); act_t* hx = (act_t*)(p.ws + OFF_HXALL);
  const int nw = nb * NWAVES;
  for (int r0 = bid * NWAVES + wv; r0 < RR; r0 += 4 * nw) {
    float4 v[4][4]; const float* src[4]; int mrow[4];
#pragma unroll
    for (int q = 0; q < 4; ++q) { int row = r0 + q * nw; row = row < RR ? row : r0; const int b = row / RB, rb = row - b * RB;
      src[q] = rb < CTXL ? p.ctx + (size_t)(b * CTXL + rb) * 1024 : p.x + (size_t)(b * SEQ + rb - CTXL) * 1024; mrow[q] = rb < CTXL ? 2 : b;
#pragma unroll
      for (int i = 0; i < 4; ++i) v[q][i] = *(const float4*)(src[q] + lane * 4 + 256 * i); }
#pragma unroll
    for (int q = 0; q < 4; ++q) { const int row = r0 + q * nw; if (row >= RR) continue;
      float ss = 0.f;
#pragma unroll
      for (int i = 0; i < 4; ++i) ss += v[q][i].x * v[q][i].x + v[q][i].y * v[q][i].y + v[q][i].z * v[q][i].z + v[q][i].w * v[q][i].w;
      ss = wave_sum(ss); const float rstd = rsqrtf(ss * (1.f / 1024.f) + EPS);
      const float* sh = mod + mrow[q] * 6144; const float* sc = sh + 1024;
#pragma unroll
      for (int i = 0; i < 4; ++i) { const int k = lane * 4 + 256 * i; const float4 g = *(const float4*)(p.g_attn + k), s1 = *(const float4*)(sc + k), s0 = *(const float4*)(sh + k);
        st4(hx + (size_t)row * 1024 + k, v[q][i].x * rstd * g.x * (1.f + s1.x) + s0.x, v[q][i].y * rstd * g.y * (1.f + s1.y) + s0.y, v[q][i].z * rstd * g.z * (1.f + s1.z) + s0.z, v[q][i].w * rstd * g.w * (1.f + s1.w) + s0.w); } }
  }
}

DEVI void phase_C(const Params& p, int bid, int nb, char* smem) {
  SchedGrid S{66, 9, 66 * 9, nb, bid, 0}; EpiProj8 E{&p};
  g8::gemm_phase<EpiProj8, SchedGrid, false, 1024>((G8_LAS unsigned char*)smem, (const bf16_t*)(p.ws + OFF_HXALL), (const bf16_t*)(p.ws + OFF_WIN), S, E);
}
DEVI void phase_D(const Params& p, int bid, int nb, char* smem) {
  { SchedGrid S{64, 3, 192, nb, bid, 1}; EpiQm8 E{&p};
    g8::gemm_phase<EpiQm8, SchedGrid, false, 384>((G8_LAS unsigned char*)smem, (const bf16_t*)(p.ws + OFF_QLAT), (const bf16_t*)(p.ws + OFF_WUQ), S, E); }
  { int b2 = bid + 64; b2 = b2 >= nb ? b2 - nb : b2;
    SchedGrid S{66, 4, 264, nb, b2, 0}; EpiKv8 E{&p};
    g8::gemm_phase<EpiKv8, SchedGrid, false, 256>((G8_LAS unsigned char*)smem, (const bf16_t*)(p.ws + OFF_KVLAT), (const bf16_t*)(p.ws + OFF_WUKV), S, E); }
}
DEVI void phase_F(const Params& p, int bid, int nb, char* smem) {
  SchedGrid S{64, 4, 256, nb, bid, 0}; EpiOut8 E{&p};
  g8::gemm_phase<EpiOut8, SchedGrid, false, 1024>((G8_LAS unsigned char*)smem, (const bf16_t*)(p.ws + OFF_ATTN), (const bf16_t*)(p.ws + OFF_WOUT), S, E);
}
DEVI void phase_H(const Params& p, int bid, int nb, char* smem) {
  moe_table(p, smem); las_cint* tab = (las_cint*)(smem + SM_TAB); const int MT = tab[16];
  SchedMoe S{tab, (const int*)(p.ws + OFF_ELIST), MT, MT * 4, nb, bid}; EpiGU8 E{&p, tab};
  g8::gemm_phase<EpiGU8, SchedMoe, true, 1024>((G8_LAS unsigned char*)smem, (const bf16_t*)(p.ws + OFF_HX2), (const bf16_t*)(p.ws + OFF_WGU), S, E);
}
DEVI void phase_I(const Params& p, int bid, int nb, char* smem) {
  moe_table(p, smem); las_cint* tab = (las_cint*)(smem + SM_TAB); const int MT = tab[16];
  SchedMoe S{tab, (const int*)(p.ws + OFF_ELIST), MT, MT * 4, nb, bid}; EpiDown8 E{&p, tab};
  g8::gemm_phase<EpiDown8, SchedMoe, false, 512>((G8_LAS unsigned char*)smem, (const bf16_t*)(p.ws + OFF_HID), (const bf16_t*)(p.ws + OFF_WD), S, E);
}

typedef s16x4 __attribute__((address_space(3))) las_s16x4;
DEVI bf16x8 pack8(const f32x16& s, int base) {
  u32x4 w = {pk2(s[base], s[base + 1]), pk2(s[base + 2], s[base + 3]), pk2(s[base + 4], s[base + 5]), pk2(s[base + 6], s[base + 7])};
  return __builtin_bit_cast(bf16x8, w);
}
DEVI bf16x8 tr_pair(const char* p) {
  const s16x4 lo = __builtin_amdgcn_ds_read_tr16_b64_v4i16((las_s16x4*)(p));
  const s16x4 hh = __builtin_amdgcn_ds_read_tr16_b64_v4i16((las_s16x4*)(p + 8 * 64));
  return (bf16x8){lo[0], lo[1], lo[2], lo[3], hh[0], hh[1], hh[2], hh[3]};
}
DEVI void pv_block(const char* Vs, int vb, const f32x16& s0, const f32x16& s1, f32x16& o0, f32x16& o1) {
  const bf16x8 p00 = pack8(s0, 0), p01 = pack8(s0, 8), p10 = pack8(s1, 0), p11 = pack8(s1, 8);
  const char* v0 = Vs + vb; const char* v1 = Vs + 4096 + vb;
  o0 = __builtin_amdgcn_mfma_f32_32x32x16_bf16(tr_pair(v0), p00, o0, 0, 0, 0);
  o0 = __builtin_amdgcn_mfma_f32_32x32x16_bf16(tr_pair(v0 + 16 * 64), p01, o0, 0, 0, 0);
  o0 = __builtin_amdgcn_mfma_f32_32x32x16_bf16(tr_pair(v0 + 32 * 64), p10, o0, 0, 0, 0);
  o0 = __builtin_amdgcn_mfma_f32_32x32x16_bf16(tr_pair(v0 + 48 * 64), p11, o0, 0, 0, 0);
  o1 = __builtin_amdgcn_mfma_f32_32x32x16_bf16(tr_pair(v1), p00, o1, 0, 0, 0);
  o1 = __builtin_amdgcn_mfma_f32_32x32x16_bf16(tr_pair(v1 + 16 * 64), p01, o1, 0, 0, 0);
  o1 = __builtin_amdgcn_mfma_f32_32x32x16_bf16(tr_pair(v1 + 32 * 64), p10, o1, 0, 0, 0);
  o1 = __builtin_amdgcn_mfma_f32_32x32x16_bf16(tr_pair(v1 + 48 * 64), p11, o1, 0, 0, 0);
}
template <int DQK, bool BIAS>
DEVI void flash_tile(const char* Ks, const char* Vs, const bf16x8 (&qf)[DQK / 16], f32x16& o0, f32x16& o1, float& m, float& l, const float* bt, int r32, int hi, int vb) {
  constexpr int KROW = DQK * 2 + 16;
  f32x16 s0, s1;
#pragma unroll
  for (int r = 0; r < 16; ++r) { s0[r] = 0.f; s1[r] = 0.f; }
#pragma unroll
  for (int s = 0; s < DQK / 16; ++s) {
    const bf16x8 k0 = *(const bf16x8*)(Ks + r32 * KROW + (16 * s + 8 * hi) * 2);
    const bf16x8 k1 = *(const bf16x8*)(Ks + (32 + r32) * KROW + (16 * s + 8 * hi) * 2);
    s0 = __builtin_amdgcn_mfma_f32_32x32x16_bf16(k0, qf[s], s0, 0, 0, 0);
    s1 = __builtin_amdgcn_mfma_f32_32x32x16_bf16(k1, qf[s], s1, 0, 0, 0);
  }
  if (BIAS) {
#pragma unroll
    for (int r = 0; r < 16; ++r) { s0[r] += bt[crow(r, hi) * 64]; s1[r] += bt[(32 + crow(r, hi)) * 64]; }
  }
  float mx = fmaxf(s0[0], s1[0]);
#pragma unroll
  for (int r = 1; r < 16; ++r) mx = fmaxf(mx, fmaxf(s0[r], s1[r]));
  mx = xhalf_max(mx);
  const float mn = fmaxf(m, mx), alpha = __builtin_amdgcn_exp2f(m - mn); m = mn;
  float ps = 0.f;
#pragma unroll
  for (int r = 0; r < 16; ++r) { s0[r] = __builtin_amdgcn_exp2f(s0[r] - mn); s1[r] = __builtin_amdgcn_exp2f(s1[r] - mn); ps += s0[r] + s1[r]; }
  ps = xhalf_sum(ps); l = l * alpha + ps;
#pragma unroll
  for (int r = 0; r < 16; ++r) { o0[r] *= alpha; o1[r] *= alpha; }
  pv_block(Vs, vb, s0, s1, o0, o1);
}
template <int DQK, bool BIAS, bool NOSHIFT = false>
DEVI void flash_tile_shift(const char* Ks, const char* Vs, const bf16x8 (&qf)[DQK / 16], f32x16& o0, f32x16& o1, float& l, float negM, const f32x16& bi0, const f32x16& bi1, int r32, int hi, int vb) {
  constexpr int KROW = DQK * 2 + 16;
  f32x16 s0, s1;
#pragma unroll
  for (int r = 0; r < 16; ++r) { if (NOSHIFT) { s0[r] = BIAS ? bi0[r] : 0.f; s1[r] = BIAS ? bi1[r] : 0.f; } else { s0[r] = BIAS ? bi0[r] + negM : negM; s1[r] = BIAS ? bi1[r] + negM : negM; } }
#pragma unroll
  for (int s = 0; s < DQK / 16; ++s) {
    const bf16x8 k0 = *(const bf16x8*)(Ks + r32 * KROW + (16 * s + 8 * hi) * 2);
    const bf16x8 k1 = *(const bf16x8*)(Ks + (32 + r32) * KROW + (16 * s + 8 * hi) * 2);
    s0 = __builtin_amdgcn_mfma_f32_32x32x16_bf16(k0, qf[s], s0, 0, 0, 0);
    s1 = __builtin_amdgcn_mfma_f32_32x32x16_bf16(k1, qf[s], s1, 0, 0, 0);
  }
  float ps = 0.f;
#pragma unroll
  for (int r = 0; r < 16; ++r) { s0[r] = __builtin_amdgcn_exp2f(s0[r]); s1[r] = __builtin_amdgcn_exp2f(s1[r]); ps += s0[r] + s1[r]; }
  l += ps;
  pv_block(Vs, vb, s0, s1, o0, o1);
}
DEVI void flash_store(bf16_t* op, const f32x16& o0, const f32x16& o1, float l, int hi) {
  const float rl = 1.f / l;
#pragma unroll
  for (int g = 0; g < 4; ++g) {
    st4(op + 8 * g + 4 * hi, o0[4 * g] * rl, o0[4 * g + 1] * rl, o0[4 * g + 2] * rl, o0[4 * g + 3] * rl);
    st4(op + 32 + 8 * g + 4 * hi, o1[4 * g] * rl, o1[4 * g + 1] * rl, o1[4 * g + 2] * rl, o1[4 * g + 3] * rl); }
}

#define MLA_SB __builtin_amdgcn_sched_barrier(0)
template <int KN, int VC>
DEVI void mla_step(char* smem, const char* ws, unsigned& gk, unsigned& gv, unsigned& gh, unsigned sk, unsigned sh, int lk, int lv, int lh,
                   const bf16x8 (&qf)[6], f32x16& c0, f32x16& c1, f32x16& n0, f32x16& n1, f32x16& o0, f32x16& o1, float (&l4)[4], const f32x16& negMv, int koff, int vb,
                   u32x4& lrk, u32x4& lrv, uint2& lrh, const u32x4& rk, const u32x4& rv, const uint2& rh) {
  constexpr int KROW = 208, KBYTES = 64 * KROW, VOFF = 2 * KBYTES;
  const char* Kn = smem + KN * KBYTES + koff;
  const char* V0 = smem + VOFF + VC * 8192 + vb; const char* V1 = V0 + 4096;
  lrk = *(const u32x4*)(ws + gk); lrv = *(const u32x4*)(ws + gv); lrh = *(const uint2*)(ws + gh);
  gk += sk; gv += 64u * 1024u * 2u; gh += sh;
  bf16x8 kf[12], pf[4], vf[4], vg[4];
#define MLA_KLD(g) kf[g] = *(const bf16x8*)(Kn + ((g) & 1) * 32 * KROW + ((g) >> 1) * 32)
  MLA_KLD(0); MLA_KLD(1); MLA_KLD(2);
  MLA_SB;
  constexpr int ELO[13] = {0, 3, 6, 9, 10, 13, 16, 17, 20, 23, 24, 28, 32};
#pragma unroll
  for (int g = 0; g < 12; ++g) {
    if (g + 3 < 12) MLA_KLD(g + 3);
    if (g >= 8) vf[g - 8] = tr_pair(V0 + (g - 8) * 16 * 64);
    if ((g & 1) == 0) n0 = __builtin_amdgcn_mfma_f32_32x32x16_bf16(kf[g], qf[g >> 1], g < 2 ? negMv : n0, 0, 0, 0);
    else              n1 = __builtin_amdgcn_mfma_f32_32x32x16_bf16(kf[g], qf[g >> 1], g < 2 ? negMv : n1, 0, 0, 0);
    MLA_SB;
#pragma unroll
    for (int e = ELO[g]; e < ELO[g + 1]; ++e) { if (e < 16) c0[e] = __builtin_amdgcn_exp2f(c0[e]); else c1[e - 16] = __builtin_amdgcn_exp2f(c1[e - 16]); }
    if (g == 3) pf[0] = pack8(c0, 0);
    if (g == 6) pf[1] = pack8(c0, 8);
    if (g == 9) pf[2] = pack8(c1, 0);
    MLA_SB;
  }
#undef MLA_KLD
#pragma unroll
  for (int hh = 0; hh < 8; ++hh) {
    if (hh < 4) vg[hh] = tr_pair(V1 + hh * 16 * 64);
    if (hh < 4) o0 = __builtin_amdgcn_mfma_f32_32x32x16_bf16(vf[hh], pf[hh], o0, 0, 0, 0);
    else        o1 = __builtin_amdgcn_mfma_f32_32x32x16_bf16(vg[hh - 4], pf[hh - 4], o1, 0, 0, 0);
    MLA_SB;
    if (hh == 0) pf[3] = pack8(c1, 8);
#pragma unroll
    for (int e = 4 * hh; e < 4 * hh + 4; ++e) { const float pv_ = e < 16 ? c0[e] : c1[e - 16]; asm volatile("v_add_f32_e32 %0, %1, %0" : "+v"(l4[e & 3]) : "v"(pv_)); }
    if (hh == 5) *(u32x4*)(smem + (1 - KN) * KBYTES + lk) = rk;
    if (hh == 6) *(u32x4*)(smem + (1 - VC) * 8192 + lv) = rv;
    if (hh == 7) *(uint2*)(smem + (1 - KN) * KBYTES + lh) = rh;
    MLA_SB;
  }
  __syncthreads();
}

DEVI void mla_unit(const Params& p, int unit, char* smem) {
  constexpr int KROW = 208, KBYTES = 64 * KROW  , VOFF = 2 * KBYTES;
  const int t = threadIdx.x, lane = t & 63, w = t >> 6, r32 = lane & 31, hi = lane >> 5;
  const int qblk = unit & 31, h = (unit >> 5) & 7, b = unit >> 8;
  const char* ws = p.ws;
  const size_t qrow = (size_t)b * RB + CTXL + qblk * 256 + w * 32 + r32;
  bf16x8 qf[6];
  { const bf16_t* qp = (const bf16_t*)p.out + qrow * 768 + h * 96 + hi * 8;
#pragma unroll
    for (int s = 0; s < 6; ++s) qf[s] = *(const bf16x8*)(qp + 16 * s); }
  unsigned gk, gv, gh, sk, sh; int lk, lv, lh;
  { const int key = t / 12, ch = t - key * 12;
    if (ch < 8) { gk = (unsigned)OFF_KV + (unsigned)(((b * RB + key) * 1024 + h * 128 + ch * 8) * 2); sk = 64u * 1024u * 2u; }
    else { gk = (unsigned)OFF_KROPE + (unsigned)(((b * RB + key) * 32 + (ch - 8) * 8) * 2); sk = 64u * 32u * 2u; }
    lk = key * KROW + ch * 16; }
  { const int c = 512 + (t >> 1), key = c / 12, ch = c - key * 12, hf = t & 1;
    if (ch < 8) { gh = (unsigned)OFF_KV + (unsigned)(((b * RB + key) * 1024 + h * 128 + ch * 8 + hf * 4) * 2); sh = 64u * 1024u * 2u; }
    else { gh = (unsigned)OFF_KROPE + (unsigned)(((b * RB + key) * 32 + (ch - 8) * 8 + hf * 4) * 2); sh = 64u * 32u * 2u; }
    lh = key * KROW + ch * 16 + hf * 8; }
  { const int key = t >> 3, ch = t & 7; gv = (unsigned)OFF_KV + (unsigned)(((b * RB + key) * 1024 + h * 128 + 64 + ch * 8) * 2); lv = VOFF + (ch >> 2) * 4096 + key * 64 + (ch & 3) * 16; }
  const int vb = (((lane & 15) >> 2) + 4 * hi) * 64 + (16 * ((lane >> 4) & 1) + 4 * (lane & 3)) * 2;
  f32x16 o0, o1;
#pragma unroll
  for (int r = 0; r < 16; ++r) { o0[r] = 0.f; o1[r] = 0.f; }
  float q2 = 0.f;
#pragma unroll
  for (int s = 0; s < 6; ++s)
#pragma unroll
    for (int e = 0; e < 8; ++e) { const float x = bf2f((bf16_t)qf[s][e]); q2 = fmaf(x, x, q2); }
  q2 = xhalf_sum(q2);
  const float* kmw = (const float*)(ws + OFF_KMAX);
  const float Mq = 1.01f * sqrtf(q2 * (kmw[KM_KN + b * 16 + h * 2] + kmw[KM_KN + b * 16 + h * 2 + 1] + kmw[KM_KR + b]));
  bool shift_ok;
  { volatile __attribute__((address_space(3))) unsigned* vw = (volatile __attribute__((address_space(3))) unsigned*)(smem + SM_BARW) + 6;
    const bool bad_w = __any(!(Mq < 64.f));
    __syncthreads(); if (t == 0) *vw = 0u; __syncthreads(); if (bad_w && lane == 0) *vw = 1u; __syncthreads();
    shift_ok = __builtin_amdgcn_readfirstlane((int)*vw) == 0; }
  constexpr int NT = RB / 64;
  float l;
  { const u32x4 rk = *(const u32x4*)(ws + gk); const u32x4 rv = *(const u32x4*)(ws + gv); const uint2 rh = *(const uint2*)(ws + gh);
    gk += sk; gv += 64u * 1024u * 2u; gh += sh;
    __syncthreads();
    *(u32x4*)(smem + lk) = rk; *(u32x4*)(smem + lv) = rv; *(uint2*)(smem + lh) = rh; }
  if (shift_ok) {
    { const u32x4 rk = *(const u32x4*)(ws + gk); const uint2 rh = *(const uint2*)(ws + gh); gk += sk; gh += sh;
      *(u32x4*)(smem + KBYTES + lk) = rk; *(uint2*)(smem + KBYTES + lh) = rh; }
    __syncthreads();
    const int koff = r32 * KROW + hi * 16;
    f32x16 negMv;
#pragma unroll
    for (int r = 0; r < 16; ++r) negMv[r] = -Mq;
    f32x16 a0, a1, b0, b1;
    { const char* Kn = smem + koff;
#pragma unroll
      for (int s = 0; s < 6; ++s) {
        a0 = __builtin_amdgcn_mfma_f32_32x32x16_bf16(*(const bf16x8*)(Kn + s * 32), qf[s], s == 0 ? negMv : a0, 0, 0, 0);
        a1 = __builtin_amdgcn_mfma_f32_32x32x16_bf16(*(const bf16x8*)(Kn + 32 * KROW + s * 32), qf[s], s == 0 ? negMv : a1, 0, 0, 0); } }
    float l4[4] = {0.f, 0.f, 0.f, 0.f};
    u32x4 rkA, rvA, rkB, rvB; uint2 rhA, rhB;
    rkB = *(const u32x4*)(ws + gk); rvB = *(const u32x4*)(ws + gv); rhB = *(const uint2*)(ws + gh); gk += sk; gv += 64u * 1024u * 2u; gh += sh;
#pragma unroll 1
    for (int jj = 0; jj < NT / 2; ++jj) {
      mla_step<1, 0>(smem, ws, gk, gv, gh, sk, sh, lk, lv, lh, qf, a0, a1, b0, b1, o0, o1, l4, negMv, koff, vb, rkA, rvA, rhA, rkB, rvB, rhB);
      mla_step<0, 1>(smem, ws, gk, gv, gh, sk, sh, lk, lv, lh, qf, b0, b1, a0, a1, o0, o1, l4, negMv, koff, vb, rkB, rvB, rhB, rkA, rvA, rhA);
    }
    l = xhalf_sum((l4[0] + l4[1]) + (l4[2] + l4[3]));
  } else {
    __syncthreads();
    float m = -1e30f; l = 0.f;
#pragma unroll 1
    for (int j = 0; j < NT; ++j) {
      const u32x4 rk = *(const u32x4*)(ws + gk); const u32x4 rv = *(const u32x4*)(ws + gv); const uint2 rh = *(const uint2*)(ws + gh);
      gk += sk; gv += 64u * 1024u * 2u; gh += sh;
      flash_tile<96, false>(smem + (j & 1) * KBYTES, smem + VOFF + (j & 1) * 8192, qf, o0, o1, m, l, nullptr, r32, hi, vb);
      char* sw = smem + ((j + 1) & 1) * KBYTES; *(u32x4*)(sw + lk) = rk; *(uint2*)(sw + lh) = rh; *(u32x4*)(smem + ((j + 1) & 1) * 8192 + lv) = rv;
      __syncthreads();
    }
  }
  flash_store((bf16_t*)(ws + OFF_ATTN) + ((size_t)b * SEQ + qblk * 256 + w * 32 + r32) * 1024 + h * 64, o0, o1, l, hi);
}

template <bool BIAS>
DEVI void na_tile_max(const char* Ks, const char* Vs, const bf16x8 (&qf)[4], f32x16& o0, f32x16& o1, float& m, float& l, const f32x16& bi0, const f32x16& bi1, int r32, int hi, int vb) {
  constexpr int KROW = 144;
  f32x16 s0, s1;
#pragma unroll
  for (int r = 0; r < 16; ++r) { s0[r] = BIAS ? bi0[r] : 0.f; s1[r] = BIAS ? bi1[r] : 0.f; }
#pragma unroll
  for (int s = 0; s < 4; ++s) {
    const bf16x8 k0 = *(const bf16x8*)(Ks + r32 * KROW + (16 * s + 8 * hi) * 2), k1 = *(const bf16x8*)(Ks + (32 + r32) * KROW + (16 * s + 8 * hi) * 2);
    s0 = __builtin_amdgcn_mfma_f32_32x32x16_bf16(k0, qf[s], s0, 0, 0, 0); s1 = __builtin_amdgcn_mfma_f32_32x32x16_bf16(k1, qf[s], s1, 0, 0, 0);
  }
  float mx = fmaxf(s0[0], s1[0]);
#pragma unroll
  for (int r = 1; r < 16; ++r) mx = fmaxf(mx, fmaxf(s0[r], s1[r]));
  mx = xhalf_max(mx);
  const float mn = fmaxf(m, mx), alpha = __builtin_amdgcn_exp2f(m - mn); m = mn;
  float ps = 0.f;
#pragma unroll
  for (int r = 0; r < 16; ++r) { s0[r] = __builtin_amdgcn_exp2f(s0[r] - mn); s1[r] = __builtin_amdgcn_exp2f(s1[r] - mn); ps += s0[r] + s1[r]; }
  ps = xhalf_sum(ps); l = l * alpha + ps;
#pragma unroll
  for (int r = 0; r < 16; ++r) { o0[r] *= alpha; o1[r] *= alpha; }
  pv_block(Vs, vb, s0, s1, o0, o1);
}

DEVI void na_unit(const Params& p, int unit, char* smem) {
  constexpr int KROW = 144, KBYTES = 64 * KROW  , STAGE = KBYTES + 8192  ;
  const int t = threadIdx.x, lane = t & 63, w = t >> 6, r32 = lane & 31, hi = lane >> 5;
  const int head = unit & 7, rq = (unit >> 3) & 31, b = unit >> 8;
  const int rr = w >> 1, qb = w & 1, grow = rq * 4 + rr, c = qb * 32 + r32;
  int wstart = grow - 4; wstart = wstart < 0 ? 0 : (wstart > 120 ? 120 : wstart);
  int klo = rq * 4 - 4; klo = klo < 0 ? 0 : (klo > 120 ? 120 : klo);
  int khi = rq * 4 - 1; khi = (khi < 0 ? 0 : (khi > 120 ? 120 : khi)) + 8;
  const int ntw = khi - klo, ntt = ntw + 4;
  const char* ws = p.ws;
  const bf16_t* nak = (const bf16_t*)(ws + OFF_NAK) + (size_t)b * RB * 512 + head * 64;
  const bf16_t* nav = (const bf16_t*)(ws + OFF_NAV) + (size_t)b * RB * 512 + head * 64;
  bf16x8 qf[4];
  { const bf16_t* qp = (const bf16_t*)(ws + OFF_NAQ) + ((size_t)b * RB + CTXL + grow * 64 + c) * 512 + head * 64 + hi * 8;
#pragma unroll
    for (int s = 0; s < 4; ++s) qf[s] = *(const bf16x8*)(qp + 16 * s); }
  const int skey = t >> 3, sch = t & 7;
  const int goff0 = skey * 512 + sch * 8, kdst0 = skey * KROW + sch * 16, vdst0 = KBYTES + (sch >> 2) * 4096 + skey * 64 + (sch & 3) * 16;
  const int vb = (((lane & 15) >> 2) + 4 * hi) * 64 + (16 * ((lane >> 4) & 1) + 4 * (lane & 3)) * 2;
  f32x16 o0, o1;
#pragma unroll
  for (int r = 0; r < 16; ++r) { o0[r] = 0.f; o1[r] = 0.f; }
  float m = -1e30f, l = 0.f;
  const unsigned* btb = (const unsigned*)(ws + OFF_BT) + (size_t)(head * 15) * 2048 + c;
  float q2 = 0.f;
#pragma unroll
  for (int s = 0; s < 4; ++s)
#pragma unroll
    for (int e = 0; e < 8; ++e) { const float x = bf2f((bf16_t)qf[s][e]); q2 = fmaf(x, x, q2); }
  q2 = xhalf_sum(q2);
  const float* kmw = (const float*)(ws + OFF_KMAX);
  const float Mq = 1.01f * sqrtf(q2 * (kmw[KM_NA + b * 16 + head * 2] + kmw[KM_NA + b * 16 + head * 2 + 1])) + kmw[KM_BM + head];
  const bool shift_ok = !__any(!(Mq < 64.f));
  u32x4 rk, rv;
  auto rowbase = [&](int j) -> size_t { return j < ntw ? (size_t)CTXL + (size_t)(klo + j) * 64 : (size_t)(j - ntw) * 64; };
#define NA_STAGE_LOAD(J) { const size_t rb1 = rowbase(J) * 512 + goff0; rk = *(const u32x4*)(nak + rb1); rv = *(const u32x4*)(nav + rb1); }
#define NA_STAGE_WRITE(J) { char* sw = smem + ((J) & 1) * STAGE; *(u32x4*)(sw + kdst0) = rk; *(u32x4*)(sw + vdst0) = rv; }
  NA_STAGE_LOAD(0)
  __syncthreads();
  NA_STAGE_WRITE(0)
  __syncthreads();
  unsigned bp[16];
#define NA_BIAS_LOAD(J) { const int kr_ = klo + (J); if ((J) < ntw && kr_ >= wstart && kr_ < wstart + 8) { const unsigned* bt = btb + (size_t)(kr_ - grow + 7) * 2048; \
      _Pragma("unroll") for (int r = 0; r < 16; ++r) bp[r] = bt[crow(r, hi) * 64]; } }
#define NA_TILE_LOOP(WIN_CALL, CTX_CALL)                                                                                                       \
  NA_BIAS_LOAD(0)                                                                                                                                \
  _Pragma("unroll 1") for (int j = 0; j < ntt; ++j) {                                                                                            \
    const char* st = smem + (j & 1) * STAGE;                                                                                                     \
    const int kr = klo + j; const bool win = j < ntw; const bool active = !win || (kr >= wstart && kr < wstart + 8);           \
    f32x16 bc0, bc1;                                                                                                                             \
    if (win && active) { _Pragma("unroll") for (int r = 0; r < 16; ++r) { bc0[r] = __uint_as_float(bp[r] << 16); bc1[r] = __uint_as_float(bp[r] & 0xffff0000u); } } \
    __builtin_amdgcn_sched_barrier(0);                                                                                                           \
    NA_BIAS_LOAD(j + 1)                                                 \
    __builtin_amdgcn_sched_barrier(0);                                                                                                           \
    if (j + 1 < ntt) NA_STAGE_LOAD(j + 1)                                                                                                        \
    __builtin_amdgcn_sched_barrier(0);                                                                                                           \
    if (active) { if (win) { WIN_CALL; } else { CTX_CALL; } }                                                                                    \
    if (j + 1 < ntt) NA_STAGE_WRITE(j + 1)                                                                                                       \
    __syncthreads();                                                                                                                             \
  }
  if (shift_ok) { NA_TILE_LOOP((flash_tile_shift<64, true, true>(st, st + KBYTES, qf, o0, o1, l, 0.f, bc0, bc1, r32, hi, vb)), (flash_tile_shift<64, false, true>(st, st + KBYTES, qf, o0, o1, l, 0.f, bc0, bc1, r32, hi, vb))) }
  else { NA_TILE_LOOP((na_tile_max<true>(st, st + KBYTES, qf, o0, o1, m, l, bc0, bc1, r32, hi, vb)), (na_tile_max<false>(st, st + KBYTES, qf, o0, o1, m, l, bc0, bc1, r32, hi, vb))) }
#undef NA_TILE_LOOP
#undef NA_BIAS_LOAD
#undef NA_STAGE_LOAD
#undef NA_STAGE_WRITE
  if (shift_ok) l = xhalf_sum(l);
  flash_store((bf16_t*)(ws + OFF_ATTN) + ((size_t)b * SEQ + grow * 64 + c) * 1024 + 512 + head * 64, o0, o1, l, hi);
}

DEVI void phase_E(const Params& p, int bid, int nb, char* smem) {
  constexpr int UM = NBATCH * 8 * 32, UN = NBATCH * 32 * 8;
  { const int iters = xcd_iters(UM, nb);
    for (int it = 0; it < iters; ++it) { const int u = xcd_unit(bid + it * nb, UM); if (u >= 0) mla_unit(p, u, smem); } }
#if TIMING_PROBE
  if (blockIdx.x == 0 && threadIdx.x == 0) ((unsigned long long*)(p.ws + OFF_CNT + 64))[11] = __builtin_amdgcn_s_memrealtime();
#endif
  { const int iters = xcd_iters(UN, nb);
    for (int it = 0; it < iters; ++it) { const int u = xcd_unit(bid + it * nb, UN); if (u >= 0) na_unit(p, u, smem); } }
#if TIMING_PROBE
  if (blockIdx.x == 0 && threadIdx.x == 0) ((unsigned long long*)(p.ws + OFF_CNT + 64))[12] = __builtin_amdgcn_s_memrealtime();
#endif
}

DEVI void wave_reduce40(float (&v)[40], int lane) {
  { const bool b = lane & 32;
#pragma unroll
    for (int i = 0; i < 20; ++i) { const float keep = b ? v[i + 20] : v[i], send = b ? v[i] : v[i + 20]; v[i] = keep + __shfl_xor(send, 32); } }
  { const bool b = lane & 16;
#pragma unroll
    for (int i = 0; i < 10; ++i) { const float keep = b ? v[i + 10] : v[i], send = b ? v[i] : v[i + 10]; v[i] = keep + __shfl_xor(send, 16); } }
  { const bool b = lane & 8;
#pragma unroll
    for (int i = 0; i < 5; ++i) { const float keep = b ? v[i + 5] : v[i], send = b ? v[i] : v[i + 5]; v[i] = keep + __shfl_xor(send, 8); } }
  { const bool b = lane & 4;
#pragma unroll
    for (int i = 0; i < 3; ++i) { const float hi_ = i + 3 < 5 ? v[i + 3] : 0.f; const float keep = b ? hi_ : v[i], send = b ? v[i] : hi_; v[i] = keep + __shfl_xor(send, 4); } }
  { const bool b = lane & 2;
#pragma unroll
    for (int i = 0; i < 2; ++i) { const float hi_ = i + 2 < 3 ? v[i + 2] : 0.f; const float keep = b ? hi_ : v[i], send = b ? v[i] : hi_; v[i] = keep + __shfl_xor(send, 2); } }
  { const bool b = lane & 1;
    const float keep = b ? v[1] : v[0], send = b ? v[0] : v[1]; v[0] = keep + __shfl_xor(send, 1); }
}
template <int IDX> DEVI float reduce40_get(float v0) {
  constexpr int k = IDX % 5, low3 = k < 3 ? k : k + 1;
  constexpr int src = (IDX / 20) * 32 + ((IDX % 20) / 10) * 16 + ((IDX % 10) / 5) * 8 + low3;
  return __builtin_bit_cast(float, __builtin_amdgcn_readlane(__builtin_bit_cast(int, v0), src));
}
DEVI void route_token(const float (&lg)[20], int tl, int lane, int* te, float* tw) {
  int gs = 0; float gm = lg[0];
#pragma unroll
  for (int j = 1; j < 4; ++j) if (lg[j] > gm) { gm = lg[j]; gs = j; }
  float z = 0.f;
#pragma unroll
  for (int j = 0; j < 4; ++j) z += expf(lg[j] - gm);
  const float gw = 1.f / z;
  const float c0 = gs == 0 ? 1.f : 0.f, c1 = gs == 1 ? 1.f : 0.f, c2 = gs == 2 ? 1.f : 0.f, c3 = gs == 3 ? 1.f : 0.f;
  float e4[4];
#pragma unroll
  for (int j = 0; j < 4; ++j) e4[j] = c0 * lg[4 + j] + c1 * lg[8 + j] + c2 * lg[12 + j] + c3 * lg[16 + j];
  int i1 = 0; float m1 = e4[0];
#pragma unroll
  for (int j = 1; j < 4; ++j) if (e4[j] > m1) { m1 = e4[j]; i1 = j; }
  int i2 = -1; float m2 = -3.0e38f;
#pragma unroll
  for (int j = 0; j < 4; ++j) if (j != i1 && e4[j] > m2) { m2 = e4[j]; i2 = j; }
  const float ex = expf(m2 - m1), w1 = 1.f / (1.f + ex), w2 = ex / (1.f + ex);
  if (lane == 0) { te[tl * 2] = gs * 4 + i1; te[tl * 2 + 1] = gs * 4 + i2; tw[tl * 2] = gw * w1; tw[tl * 2 + 1] = gw * w2; }
}
DEVI void phase_G(const Params& p, int bid, int nb, char* smem) {
  int t = threadIdx.x; asm volatile("" : "+v"(t));
  const int lane = t & 63, wv = t >> 6;
  int* te = (int*)smem; float* tw = (float*)(smem + 256);
  const float* mod = (const float*)(p.ws + OFF_MOD); act_t* hx2 = (act_t*)(p.ws + OFF_HX2);
  const float* wrt = (const float*)(smem + 1024);
  { const f32x4* src = (const f32x4*)(p.ws + OFF_WRT); f32x4* dst = (f32x4*)(smem + 1024);
    __syncthreads();
#pragma unroll
    for (int i = 0; i < 10; ++i) dst[t + 512 * i] = src[t + 512 * i];
    __syncthreads(); }
  int* cnt = (int*)(p.ws + OFF_CNT); int* elist = (int*)(p.ws + OFF_ELIST); float* ewt = (float*)(p.ws + OFF_EW);
  for (int ch = bid; ch < TT / 32; ch += nb) {
    __syncthreads();
    const int b = (ch * 32) >> 13; const float* sh = mod + b * 6144 + 3072; const float* sc = sh + 1024;
#pragma unroll 1
    for (int q = 0; q < 4; q += 2) {
      const int tl = wv * 4 + q, tok = ch * 32 + tl;
      const act_t* xa = (const act_t*)(p.ws + OFF_X1) + (size_t)tok * 1024 + lane * 4; const act_t* xb = xa + 1024;
      float sa = 0.f, sb = 0.f;
      { float va[4][4], vb[4][4];
#pragma unroll
        for (int i = 0; i < 4; ++i) { ld4(xa + 256 * i, va[i]); ld4(xb + 256 * i, vb[i]); }
#pragma unroll
        for (int i = 0; i < 4; ++i) { sa += va[i][0] * va[i][0] + va[i][1] * va[i][1] + va[i][2] * va[i][2] + va[i][3] * va[i][3]; sb += vb[i][0] * vb[i][0] + vb[i][1] * vb[i][1] + vb[i][2] * vb[i][2] + vb[i][3] * vb[i][3]; } }
      sa = wave_sum(sa); sb = wave_sum(sb);
      const float ra = rsqrtf(sa * (1.f / 1024.f) + EPS), rb = rsqrtf(sb * (1.f / 1024.f) + EPS);
      float la[20], lb[20];
#pragma unroll
      for (int j = 0; j < 20; ++j) { la[j] = 0.f; lb[j] = 0.f; }
#pragma unroll 1
      for (int i = 0; i < 4; ++i) {
        const int k = lane * 4 + 256 * i;
        float4 va, vb; { float ta[4], tb[4]; ld4(xa + 256 * i, ta); ld4(xb + 256 * i, tb); va = make_float4(ta[0], ta[1], ta[2], ta[3]); vb = make_float4(tb[0], tb[1], tb[2], tb[3]); }
        const float4 g = *(const float4*)(p.g_ffn + k), s1 = *(const float4*)(sc + k), s0 = *(const float4*)(sh + k);
        const float gx = g.x * (1.f + s1.x), gy = g.y * (1.f + s1.y), gz = g.z * (1.f + s1.z), gw = g.w * (1.f + s1.w);
        const float4 ha = make_float4(va.x * ra * gx + s0.x, va.y * ra * gy + s0.y, va.z * ra * gz + s0.z, va.w * ra * gw + s0.w);
        const float4 hb = make_float4(vb.x * rb * gx + s0.x, vb.y * rb * gy + s0.y, vb.z * rb * gz + s0.z, vb.w * rb * gw + s0.w);
        st4(hx2 + (size_t)tok * 1024 + k, ha.x, ha.y, ha.z, ha.w); st4(hx2 + (size_t)(tok + 1) * 1024 + k, hb.x, hb.y, hb.z, hb.w);
        const float* wk = wrt + k;
#pragma unroll
        for (int jg = 0; jg < 20; jg += 10) {
          float4 w[10];
#pragma unroll
          for (int u = 0; u < 10; ++u) w[u] = *(const float4*)(wk + (jg + u) * 1024);
#pragma unroll
          for (int u = 0; u < 10; ++u) {
            la[jg + u] = fmaf(ha.x, w[u].x, fmaf(ha.y, w[u].y, fmaf(ha.z, w[u].z, fmaf(ha.w, w[u].w, la[jg + u]))));
            lb[jg + u] = fmaf(hb.x, w[u].x, fmaf(hb.y, w[u].y, fmaf(hb.z, w[u].z, fmaf(hb.w, w[u].w, lb[jg + u])))); }
        }
      }
      { float v40[40];
#pragma unroll
        for (int j = 0; j < 20; ++j) { v40[j] = la[j]; v40[20 + j] = lb[j]; }
        wave_reduce40(v40, lane);
        const float r0 = v40[0];
#define G_GET(J) la[J] = reduce40_get<J>(r0); lb[J] = reduce40_get<20 + J>(r0);
        G_GET(0) G_GET(1) G_GET(2) G_GET(3) G_GET(4) G_GET(5) G_GET(6) G_GET(7) G_GET(8) G_GET(9) G_GET(10) G_GET(11) G_GET(12) G_GET(13) G_GET(14) G_GET(15) G_GET(16) G_GET(17) G_GET(18) G_GET(19)
#undef G_GET
      }
#pragma unroll
      for (int j = 0; j < 4; ++j) { la[j] += p.b_rg[j]; lb[j] += p.b_rg[j]; }
#pragma unroll
      for (int j = 0; j < 16; ++j) { la[4 + j] += p.b_re[j]; lb[4 + j] += p.b_re[j]; }
      route_token(la, tl, lane, te, tw); route_token(lb, tl + 1, lane, te, tw);
    }
    __syncthreads();
    if (wv == 0) {
      const int my_e = te[lane]; const float my_w = tw[lane];
      unsigned long long me_mask = 0ull; int my_n = 0;
#pragma unroll
      for (int e = 0; e < 16; ++e) { const unsigned long long mk = __ballot(my_e == e); if (my_e == e) me_mask = mk; if (lane == e) my_n = __popcll(mk); }
      int base = 0; if (lane < 16 && my_n) base = atomicAdd(&cnt[lane], my_n);
      const int my_base = __shfl(base, my_e);
      const int rank = __popcll(me_mask & ((1ull << lane) - 1ull));
      const int slot = my_base + rank;
      elist[(size_t)my_e * TT + slot] = (ch * 32 + (lane >> 1)) * 2 + (lane & 1); ewt[(size_t)my_e * TT + slot] = my_w;
    }
  }
}

DEVI void phase_J(const Params& p, int bid, int nb) {
  int tx = threadIdx.x; asm volatile("" : "+v"(tx));
  const int lane = tx & 63, wv = tx >> 6;
  const float* mod = (const float*)(p.ws + OFF_MOD); const act_t* yb = (const act_t*)(p.ws + OFF_YBUF);
  for (int tok0 = (bid * NWAVES + wv) * 4; tok0 < TT; tok0 += nb * NWAVES * 4) {
    const int b = tok0 >> 13; const float* g2 = mod + b * 6144 + 5120;
    float4 xv[4][4]; float y0[4][4][4], y1[4][4][4];
#pragma unroll
    for (int q = 0; q < 4; ++q)
#pragma unroll
      for (int i = 0; i < 4; ++i) { const int k = lane * 4 + 256 * i; { float tx4[4]; ld4((const act_t*)(p.ws + OFF_X1) + (size_t)(tok0 + q) * 1024 + k, tx4); xv[q][i] = make_float4(tx4[0], tx4[1], tx4[2], tx4[3]); }
        ld4(yb + (size_t)(tok0 + q) * 1024 + k, y0[q][i]); ld4(yb + ((size_t)TT + tok0 + q) * 1024 + k, y1[q][i]); }
#pragma unroll
    for (int q = 0; q < 4; ++q) {
      float* xo = p.out + (size_t)(tok0 + q) * 1024; float o[16]; float ss = 0.f;
#pragma unroll
      for (int i = 0; i < 4; ++i) { const int k = lane * 4 + 256 * i; const float4 g = *(const float4*)(g2 + k);
        o[4 * i] = xv[q][i].x + g.x * (y0[q][i][0] + y1[q][i][0]); o[4 * i + 1] = xv[q][i].y + g.y * (y0[q][i][1] + y1[q][i][1]);
        o[4 * i + 2] = xv[q][i].z + g.z * (y0[q][i][2] + y1[q][i][2]); o[4 * i + 3] = xv[q][i].w + g.w * (y0[q][i][3] + y1[q][i][3]);
        ss += o[4 * i] * o[4 * i] + o[4 * i + 1] * o[4 * i + 1] + o[4 * i + 2] * o[4 * i + 2] + o[4 * i + 3] * o[4 * i + 3]; }
      ss = wave_sum(ss); const float rstd = rsqrtf(ss * (1.f / 1024.f) + EPS);
#pragma unroll
      for (int i = 0; i < 4; ++i) { const int k = lane * 4 + 256 * i; const float4 g = *(const float4*)(p.g_final + k);
        *(float4*)(xo + k) = make_float4(o[4 * i] * rstd * g.x, o[4 * i + 1] * rstd * g.y, o[4 * i + 2] * rstd * g.z, o[4 * i + 3] * rstd * g.w); }
    }
  }
}

#if ONE_LAUNCH
#define XB_TMO      128
#define XB_XCNT(j)  (256  + 64 * (j))
#define XB_XSUB(j)  (1280 + 64 * (j))
#define XB_XGEN(j)  (2304 + 64 * (j))
#define XB_TOP      3328
#define XB_TOPGEN   3392
#define XCD_BAR_WORDS 3456
#define XB_SPIN_CAP (1u << 20)
#define LAS __attribute__((address_space(3)))
DEVI unsigned xb_ld(unsigned* p)              { return __hip_atomic_load(p, __ATOMIC_RELAXED, __HIP_MEMORY_SCOPE_AGENT); }
DEVI unsigned xb_add(unsigned* p, unsigned v) { return __hip_atomic_fetch_add(p, v, __ATOMIC_RELAXED, __HIP_MEMORY_SCOPE_AGENT); }
DEVI unsigned xb_xcc_id() { return (unsigned)__builtin_amdgcn_s_getreg((3 << 11) | 20) & 0xFu; }
#define XB_SPIN(cond, bar) do { unsigned _sp = 0; while (cond) { __builtin_amdgcn_s_sleep(1); \
    if ((++_sp & 255u) == 0u) { if (xb_ld(&(bar)[XB_TMO])) break; if (_sp > XB_SPIN_CAP) { atomicAdd(&(bar)[XB_TMO], 1u); break; } } } } while (0)
struct XcdBarrier { unsigned* bar; unsigned x; volatile LAS unsigned* st; };
DEVI XcdBarrier xcd_barrier_post(unsigned* bar, volatile LAS unsigned* st) {
  XcdBarrier b; b.bar = bar; b.x = xb_xcc_id(); b.st = st;
  if (threadIdx.x == 0) st[2] = xb_add(&bar[XB_XCNT(b.x)], 1u);
  return b;
}
DEVI void xcd_barrier_complete(unsigned* bar, unsigned x, unsigned& nloc, unsigned& nx) {
  const unsigned G = gridDim.x * gridDim.y * gridDim.z;
  unsigned sum, cnt, mine, sp = 0u;
  for (;;) {
    sum = 0u; cnt = 0u; mine = 0u;
#pragma unroll
    for (unsigned j = 0; j < 16; ++j) { const unsigned c = xb_ld(&bar[XB_XCNT(j)]); sum += c; cnt += (c > 0u) ? 1u : 0u; mine = (j == x) ? c : mine; }
    if (sum == G) break;
    __builtin_amdgcn_s_sleep(1);
    if ((++sp & 255u) == 0u) { if (xb_ld(&bar[XB_TMO])) break; if (sp > XB_SPIN_CAP) { atomicAdd(&bar[XB_TMO], 1u); break; } }
  }
  nloc = mine > 0u ? mine : 1u; nx = cnt > 0u ? cnt : 1u;
}
DEVI void xcd_barrier(const XcdBarrier& b) {
  asm volatile("s_waitcnt vmcnt(0)" ::: "memory");
  __syncthreads();
  if (threadIdx.x == 0) {
    unsigned* bar = b.bar;
    __builtin_amdgcn_s_waitcnt(0);
    unsigned nloc = b.st[0], nx = b.st[1];
    if (nloc == 0u) { xcd_barrier_complete(bar, b.x, nloc, nx); b.st[0] = nloc; b.st[1] = nx; }
    const unsigned old = xb_add(&bar[XB_XSUB(b.x)], 1u);
    const unsigned gen = old / nloc;
    if (old + 1u == (gen + 1u) * nloc) {
      __builtin_amdgcn_fence(__ATOMIC_RELEASE, "agent");
      asm volatile("s_waitcnt vmcnt(0)" ::: "memory");
      const unsigned og = xb_add(&bar[XB_TOP], 1u);
      const unsigned tg = og / nx;
      if (og + 1u == (tg + 1u) * nx) xb_add(&bar[XB_TOPGEN], 1u);
      else XB_SPIN(xb_ld(&bar[XB_TOPGEN]) == tg, bar);
      __builtin_amdgcn_fence(__ATOMIC_ACQUIRE, "agent");
      xb_add(&bar[XB_XGEN(b.x)], 1u);
      asm volatile("s_waitcnt vmcnt(0)" ::: "memory");
    } else {
      XB_SPIN(xb_ld(&bar[XB_XGEN(b.x)]) == gen, bar);
      __builtin_amdgcn_fence(__ATOMIC_ACQUIRE, "agent");
      asm volatile("s_waitcnt vmcnt(0)" ::: "memory");
    }
  }
  __syncthreads();
}

DEVI const float* lds_ptr(const char* smem, int i) { const unsigned* t = (const unsigned*)(smem + SM_PTR) + 2 * i;
  const unsigned lo = __builtin_amdgcn_readfirstlane(t[0]), hi = __builtin_amdgcn_readfirstlane(t[1]);
  typedef const float __attribute__((address_space(1))) gfloat; return (const float*)(gfloat*)(((unsigned long long)hi << 32) | lo); }
DEVI Params load_params(const char* smem) {
  Params q;
  q.x = lds_ptr(smem, 0); q.c = lds_ptr(smem, 1); q.ctx = lds_ptr(smem, 2); q.c_ctx = lds_ptr(smem, 3); q.w_mod = lds_ptr(smem, 4); q.b_mod = lds_ptr(smem, 5);
  q.g_attn = lds_ptr(smem, 6); q.g_ffn = lds_ptr(smem, 7); q.w_in = lds_ptr(smem, 8); q.g_q = lds_ptr(smem, 9); q.g_kv = lds_ptr(smem, 10); q.w_uq = lds_ptr(smem, 11);
  q.w_ukv = lds_ptr(smem, 12); q.rel_bias = lds_ptr(smem, 13); q.w_out = lds_ptr(smem, 14); q.w_rg = lds_ptr(smem, 15); q.b_rg = lds_ptr(smem, 16); q.w_re = lds_ptr(smem, 17);
  q.b_re = lds_ptr(smem, 18); q.w_gate = lds_ptr(smem, 19); q.w_up = lds_ptr(smem, 20); q.w_down = lds_ptr(smem, 21); q.g_final = lds_ptr(smem, 22);
  q.out = (float*)lds_ptr(smem, 23); q.ws = (char*)lds_ptr(smem, 24);
  return q;
}
DEVI XcdBarrier xb_reload(char* smem) { XcdBarrier b; b.bar = (unsigned*)((char*)lds_ptr(smem, 24) + OFF_BAR); b.st = (volatile LAS unsigned*)(smem + SM_BARW);
  b.x = (unsigned)__builtin_amdgcn_readfirstlane((int)b.st[4]); return b; }
#define GRID_BARRIER() do { const XcdBarrier _xb = xb_reload(smem); xcd_barrier(_xb); } while (0)
#define VBID() __builtin_amdgcn_readfirstlane((int)((volatile LAS unsigned*)(smem + SM_BARW))[3])
#define TS(i) do { if (TIMING_PROBE && blockIdx.x == 0 && threadIdx.x == 0) ((unsigned long long*)(pk.ws + OFF_CNT + 64))[i] = __builtin_amdgcn_s_memrealtime(); } while (0)
#ifndef REPEAT_MASK
#define REPEAT_MASK 0
#endif
#define REP(i) _Pragma("nounroll") for (int _r = 0; _r < ((PHASE_ONLY >= 0 && PHASE_ONLY != (i)) ? 0 : (((REPEAT_MASK >> (i)) & 1) ? 2 : 1)); ++_r)

__global__ void __launch_bounds__(NTHREADS, 2) mega_kernel(Params pk) {
  __shared__ __attribute__((aligned(16))) char smem[LDS_TOTAL];
  const int nb = gridDim.x;
  if (threadIdx.x == 0) { *(uint4*)(smem + SM_BARW) = make_uint4(0u, 0u, 0u, (unsigned)blockIdx.x); *(uint4*)(smem + SM_BARW + 16) = make_uint4(0u, 0u, 0u, 0u); }
  if (threadIdx.x < 25) ((unsigned long long*)(smem + SM_PTR))[threadIdx.x] = ((const unsigned long long*)&pk)[threadIdx.x];
  __syncthreads();
  { const XcdBarrier xb0 = xcd_barrier_post((unsigned*)(pk.ws + OFF_BAR), (volatile LAS unsigned*)(smem + SM_BARW));
    if (threadIdx.x == 0) ((volatile LAS unsigned*)(smem + SM_BARW))[4] = xb0.x; }
  __syncthreads();
  TS(0);
  REP(0) { const Params p = load_params(smem); phase_A(p, (int)blockIdx.x, nb, smem); GRID_BARRIER(); }
  TS(1);
  { volatile LAS unsigned* st = (volatile LAS unsigned*)(smem + SM_BARW);
    if (threadIdx.x == 0) { unsigned* bar = (unsigned*)(pk.ws + OFF_BAR); bool even = (nb % 8) == 0;
      for (unsigned j = 0; j < 16; ++j) { const unsigned c = xb_ld(&bar[XB_XCNT(j)]); even = even && (c == (j < 8 ? (unsigned)nb / 8u : 0u)); }
      st[3] = even ? st[2] * 8u + st[4] : (unsigned)blockIdx.x; }
    __syncthreads(); }
  REP(1) { const Params p = load_params(smem); const int bid = VBID(); phase_B(p, bid, nb); GRID_BARRIER(); }
  TS(2);
  REP(2) { { const Params p = load_params(smem); const int bid = VBID(); phase_C(p, bid, nb, smem); }
    { const Params p = load_params(smem); conv_queue(p, smem, 1, NCONV_A, NCONV_C); }
    GRID_BARRIER(); }
  TS(3);
  REP(3) { const Params p = load_params(smem); const int bid = VBID(); phase_D(p, bid, nb, smem); GRID_BARRIER(); }
  TS(4);
  REP(4) { { const Params p = load_params(smem); const int bid = VBID(); phase_E(p, bid, nb, smem); }
    { const Params p = load_params(smem); conv_queue(p, smem, 3, NCONV_C, NCONV_E); }
    GRID_BARRIER(); }
  TS(5);
  REP(5) { const Params p = load_params(smem); const int bid = VBID(); phase_F(p, bid, nb, smem); GRID_BARRIER(); }
  TS(6);
  REP(6) { const Params p = load_params(smem); const int bid = VBID(); phase_G(p, bid, nb, smem); GRID_BARRIER(); }
  TS(7);
  REP(7) { { const Params p = load_params(smem); const int bid = VBID(); phase_H(p, bid, nb, smem); }
    { const Params p = load_params(smem); conv_queue(p, smem, 2, NCONV_E, NCONV); }
    GRID_BARRIER(); }
  TS(8);
  REP(8) { const Params p = load_params(smem); const int bid = VBID(); phase_I(p, bid, nb, smem); GRID_BARRIER(); }
  TS(9);
  REP(9) { const Params p = load_params(smem); const int bid = VBID(); phase_J(p, bid, nb); }
#if TIMING_PROBE
  GRID_BARRIER(); TS(10);
  if (blockIdx.x == 0 && threadIdx.x < 64) {
    const int lane = threadIdx.x;
    const unsigned long long* ts = (const unsigned long long*)(pk.ws + OFF_CNT + 64); float ta = 0.f, tr = 0.f;
#pragma unroll
    for (int qq = 0; qq < 10; ++qq) { const float d = (float)(unsigned)(ts[qq + 1] - ts[qq]) * 0.01f; if ((PROBE_A_MASK >> qq) & 1) ta += d; if ((PROBE_R_MASK >> qq) & 1) tr += d; }
    if ((PROBE_A_MASK >> 10) & 1) ta += (float)(unsigned)(ts[11] - ts[4]) * 0.01f;
    if ((PROBE_R_MASK >> 11) & 1) tr += (float)(unsigned)(ts[12] - ts[11]) * 0.01f;
    if ((PROBE_A_MASK >> 12) & 1) ta += (float)(unsigned)(ts[5] - ts[12]) * 0.01f;
    if (lane == 0) pk.out[0] += 1.f + ta * 0.01f;
    { float4* o4 = (float4*)(pk.out + 1024 + lane * 16);
#pragma unroll
      for (int i = 0; i < 4; ++i) { float4 v = o4[i]; v.x += tr * PROBE_R_SCALE; v.y += tr * PROBE_R_SCALE; v.z += tr * PROBE_R_SCALE; v.w += tr * PROBE_R_SCALE; o4[i] = v; } }
  }
#endif
}
#endif

extern "C" void kernel_launch(void* const* d_in, const int* in_sizes, int n_in, void* d_out, int out_size, void* d_ws, size_t ws_size, hipStream_t stream) {
  if (n_in != 23 || out_size != TT * 1024 || ws_size < WS_NEED) { fprintf(stderr, "kernel_launch: unexpected shapes n_in %d out %d ws %zu (need %zu)\n", n_in, out_size, ws_size, (size_t)WS_NEED); return; }
  Params p{};
  const float** f = (const float**)&p;
  for (int i = 0; i < 23; ++i) f[i] = (const float*)d_in[i];
  p.out = (float*)d_out; p.ws = (char*)d_ws;
#if ONE_LAUNCH
  static int grid_blocks = 0;
  if (!grid_blocks) {
    int dev = 0, cus = 0, per_cu = 0;
    hipGetDevice(&dev);
    hipDeviceGetAttribute(&cus, hipDeviceAttributeMultiprocessorCount, dev);
    hipOccupancyMaxActiveBlocksPerMultiprocessor(&per_cu, mega_kernel, NTHREADS, 0);
    if (per_cu > 1) per_cu = 1;
    grid_blocks = cus * per_cu;
    if (grid_blocks <= 0) { fprintf(stderr, "kernel_launch: occupancy query failed (cus %d per_cu %d)\n", cus, per_cu); grid_blocks = 0; return; }
  }
  if (hipMemsetAsync((char*)d_ws + OFF_BAR, 0, 16384, stream) != hipSuccess) { fprintf(stderr, "kernel_launch: memset of barrier words failed\n"); return; }
  hipLaunchKernelGGL(mega_kernel, dim3(grid_blocks), dim3(NTHREADS), 0, stream, p);
  const hipError_t e = hipPeekAtLastError();
  if (e != hipSuccess) fprintf(stderr, "kernel_launch: launch failed: %s (grid %d)\n", hipGetErrorString(e), grid_blocks);
#else
  const int G = 1024;
  hipLaunchKernelGGL(phase_kernel<0>, dim3(G), dim3(NTHREADS), 0, stream, p);
  hipLaunchKernelGGL(phase_kernel<1>, dim3(G), dim3(NTHREADS), 0, stream, p);
  hipLaunchKernelGGL(phase_kernel<2>, dim3(G), dim3(NTHREADS), 0, stream, p);
  hipLaunchKernelGGL(phase_kernel<3>, dim3(G), dim3(NTHREADS), 0, stream, p);
  hipLaunchKernelGGL(phase_kernel<4>, dim3(G), dim3(NTHREADS), 0, stream, p);
  hipLaunchKernelGGL(phase_kernel<5>, dim3(G), dim3(NTHREADS), 0, stream, p);
  hipLaunchKernelGGL(phase_kernel<6>, dim3(G), dim3(NTHREADS), 0, stream, p);
  hipLaunchKernelGGL(phase_kernel<7>, dim3(G), dim3(NTHREADS), 0, stream, p);
  hipLaunchKernelGGL(phase_kernel<8>, dim3(G), dim3(NTHREADS), 0, stream, p);
  hipLaunchKernelGGL(phase_kernel<9>, dim3(G), dim3(NTHREADS), 0, stream, p);
#endif
}
```

```cpp
#include <hip/hip_runtime.h>
#include <cstdio>
#include <cstdint>

#ifndef MODE_EXACT
#define MODE_EXACT 0
#endif
#ifndef ONE_LAUNCH
#define ONE_LAUNCH 1
#endif
#ifndef ATTN_EXACT
#define ATTN_EXACT MODE_EXACT
#endif
#ifndef PHASE_ONLY
#define PHASE_ONLY -1
#endif
#ifndef TIMING_PROBE
#define TIMING_PROBE 0
#endif
#ifndef PROBE_A_MASK
#define PROBE_A_MASK 0
#endif
#ifndef PROBE_R_MASK
#define PROBE_R_MASK 0
#endif
#ifndef PROBE_R_SCALE
#define PROBE_R_SCALE 0.002f
#endif
#ifndef GEMM_EXACT
#define GEMM_EXACT MODE_EXACT
#endif

#define DEVI __device__ __forceinline__

typedef unsigned short bf16_t;
typedef short bf16x8 __attribute__((ext_vector_type(8)));
typedef short s16x4 __attribute__((ext_vector_type(4)));
typedef float f32x16 __attribute__((ext_vector_type(16)));
typedef float f32x4 __attribute__((ext_vector_type(4)));
typedef unsigned u32x4 __attribute__((ext_vector_type(4)));

#if MODE_EXACT
typedef float act_t;
#else
typedef bf16_t act_t;
#endif

constexpr int DM = 1024, NBATCH = 2, SEQ = 8192, CTXL = 256, RB = SEQ + CTXL  , RR = NBATCH * RB  , TT = NBATCH * SEQ  ;
constexpr int GW = 64, GROWS = 128;
constexpr int QL = 384, KVL = 256, NPROJ = 2304  , NPROJ_REAL = 2208;
constexpr int NEXP = 16, DEXP = 512;
constexpr float EPS = 1e-6f, LOG2E = 1.4426950408889634f;
constexpr float QSCALE = 0.10206207261596577f * 1.4426950408889634f;
constexpr float NASCALE = 0.125f * 1.4426950408889634f;
constexpr int HIDROWS = 36864;
constexpr int NTHREADS = 512, NWAVES = 8;

constexpr size_t AS = sizeof(act_t);
constexpr size_t OFF_BAR   = 0;
constexpr size_t OFF_CNT   = 16384;
constexpr size_t OFF_MOD   = OFF_CNT + 256;
constexpr size_t OFF_ROPE  = OFF_MOD + 3 * 6144 * 4;
constexpr size_t OFF_SSQ   = OFF_ROPE + 2 * 128 * 8 * 4;
constexpr size_t OFF_SSKV  = OFF_SSQ + (size_t)RR * 12 * 4;
constexpr size_t OFF_BT    = OFF_SSKV + (size_t)RR * 8 * 4;
constexpr size_t OFF_ELIST = OFF_BT + (size_t)8 * 15 * 4096 * 4;
constexpr size_t OFF_EW    = OFF_ELIST + (size_t)NEXP * TT * 4;
constexpr size_t OFF_WRT   = OFF_EW + (size_t)NEXP * TT * 4;
constexpr size_t OFF_KMAX  = OFF_WRT + 20 * 1024 * 4;
constexpr size_t SMALL_END = OFF_KMAX + 512;
static_assert(SMALL_END <= (size_t)8 << 20, "small region");
constexpr size_t OFF_W     = (size_t)8 << 20;
#if MODE_EXACT
constexpr size_t W_BYTES = 0;
#else
constexpr size_t W_BYTES = (size_t)60 << 20;
#endif
constexpr size_t OFF_WIN  = OFF_W;
constexpr size_t OFF_WUQ  = OFF_WIN + (size_t)NPROJ * 1024 * 2;
constexpr size_t OFF_WUKV = OFF_WUQ + (size_t)768 * 384 * 2;
constexpr size_t OFF_WOUT = OFF_WUKV + (size_t)1024 * 256 * 2;
constexpr size_t OFF_WGU  = OFF_WOUT + (size_t)1024 * 1024 * 2;
constexpr size_t OFF_WD   = OFF_WGU + (size_t)16 * 1024 * 1024 * 2;
constexpr size_t W_END    = OFF_WD + (size_t)16 * 1024 * 512 * 2;
static_assert(MODE_EXACT || W_END <= OFF_W + W_BYTES, "weights region");
constexpr size_t G0 = OFF_W + W_BYTES;
constexpr size_t OFF_HXALL = G0;
constexpr size_t OFF_KV    = OFF_HXALL;
constexpr size_t OFF_NAQ   = OFF_HXALL + (size_t)RR * 1024 * AS;
constexpr size_t OFF_NAK   = OFF_NAQ + (size_t)RR * 512 * AS;
constexpr size_t OFF_NAV   = OFF_NAK + (size_t)RR * 512 * AS;
constexpr size_t OFF_KROPE = OFF_NAV + (size_t)RR * 512 * AS;
constexpr size_t OFF_QLAT  = OFF_KROPE + (size_t)RR * 32 * AS;
constexpr size_t OFF_KVLAT = OFF_QLAT + (size_t)RR * 384 * AS;
constexpr size_t OFF_ATTN  = OFF_QLAT;
constexpr size_t ATT_END   = OFF_ATTN + (size_t)TT * 1024 * AS;
constexpr size_t OFF_YBUF  = G0;
constexpr size_t OFF_HX2   = G0;
constexpr size_t OFF_HID   = OFF_YBUF + (size_t)2 * TT * 1024 * AS;
constexpr size_t MOE_END   = OFF_HID + (size_t)HIDROWS * 512 * AS;
constexpr size_t OFF_X1    = ATT_END > MOE_END ? ATT_END : MOE_END;
constexpr size_t WS_NEED   = OFF_X1 + (size_t)TT * 1024 * AS;
static_assert(MODE_EXACT || WS_NEED <= ((size_t)256 << 20), "workspace");

struct Params {
  const float *x, *c, *ctx, *c_ctx, *w_mod, *b_mod, *g_attn, *g_ffn, *w_in, *g_q, *g_kv, *w_uq, *w_ukv, *rel_bias, *w_out,
              *w_rg, *b_rg, *w_re, *b_re, *w_gate, *w_up, *w_down, *g_final;
  float* out; char* ws;
};

DEVI float bf2f(bf16_t v) { return __uint_as_float(((unsigned)v) << 16); }
DEVI bf16_t f2bf(float f) { unsigned u = __float_as_uint(f); u += 0x7fffu + ((u >> 16) & 1u); return (bf16_t)(u >> 16); }
typedef __bf16 bf16x2_t __attribute__((ext_vector_type(2)));
typedef float f32x2_t __attribute__((ext_vector_type(2)));
DEVI unsigned pk2(float lo, float hi) { const f32x2_t v = {lo, hi}; return __builtin_bit_cast(unsigned, __builtin_convertvector(v, bf16x2_t)); }
DEVI float a2f(float v) { return v; }
DEVI float a2f(bf16_t v) { return bf2f(v); }
DEVI void ld4(const float* p, float (&v)[4]) { const float4 t = *(const float4*)p; v[0] = t.x; v[1] = t.y; v[2] = t.z; v[3] = t.w; }
DEVI void ld4(const bf16_t* p, float (&v)[4]) { const uint2 t = *(const uint2*)p; v[0] = __uint_as_float(t.x << 16); v[1] = __uint_as_float(t.x & 0xffff0000u); v[2] = __uint_as_float(t.y << 16); v[3] = __uint_as_float(t.y & 0xffff0000u); }
DEVI void st4(float* p, float a, float b, float c, float d) { *(float4*)p = make_float4(a, b, c, d); }
DEVI void st4(bf16_t* p, float a, float b, float c, float d) { uint2 t; t.x = pk2(a, b); t.y = pk2(c, d); *(uint2*)p = t; }
DEVI void st1(float* p, float a) { *p = a; }
DEVI void st1(bf16_t* p, float a) { *p = f2bf(a); }
DEVI int crow(int r, int hi) { return (r & 3) + 8 * (r >> 2) + 4 * hi; }
DEVI float wave_sum(float v) { v += __shfl_xor(v, 32); v += __shfl_xor(v, 16); v += __shfl_xor(v, 8); v += __shfl_xor(v, 4); v += __shfl_xor(v, 2); v += __shfl_xor(v, 1); return v; }
DEVI float half_sum32(float v) { v += __shfl_xor(v, 16); v += __shfl_xor(v, 8); v += __shfl_xor(v, 4); v += __shfl_xor(v, 2); v += __shfl_xor(v, 1); return v; }
DEVI float xhalf_max(float v) { auto rr = __builtin_amdgcn_permlane32_swap(__float_as_uint(v), __float_as_uint(v), false, false); return fmaxf(__uint_as_float(rr[0]), __uint_as_float(rr[1])); }
DEVI float xhalf_sum(float v) { auto rr = __builtin_amdgcn_permlane32_swap(__float_as_uint(v), __float_as_uint(v), false, false); return __uint_as_float(rr[0]) + __uint_as_float(rr[1]); }
DEVI float silu_f(float v) { return v / (1.f + expf(-v)); }
DEVI float silu_fast(float v) { return v * __builtin_amdgcn_rcpf(1.f + __builtin_amdgcn_exp2f(-v * LOG2E)); }

DEVI int xcd_unit(int v, int U) { const int chunk = (U + 7) >> 3; const int x = v & 7, j = v >> 3; if (j >= chunk) return -1; const int u = x * chunk + j; return u < U ? u : -1; }
DEVI void panel_order(int idx, int nM, int nN, int& tm, int& tn) { const int nig = 8 * nN, gid = idx / nig, fm = gid * 8, gsz = (nM - fm) < 8 ? (nM - fm) : 8, r = idx - gid * nig; tm = fm + r % gsz; tn = r / gsz; }
DEVI int xcd_iters(int U, int nb) { const int chunk = (U + 7) >> 3; return (chunk * 8 + nb - 1) / nb; }

struct WInAcc { const float* w; static constexpr int LD = NPROJ_REAL;
  DEVI const float* col(int n, float& msk) const { const int o = n < 1152 ? n : (n < 2176 ? n + 32 : n - 1024); const bool ok = n < 2208; msk = ok ? 1.f : 0.f; return w + (ok ? o : 0); }
  DEVI float kscale(int) const { return 1.f; }
  DEVI float at(int k, int n) const { int o; if (n < 1152) o = n; else if (n < 2176) o = n + 32; else if (n < 2208) o = n - 1024; else return 0.f; return w[(size_t)k * NPROJ_REAL + o]; } };
struct WUqAcc { const float* w; const float* g; static constexpr int LD = 768;
  DEVI const float* col(int n, float& msk) const { msk = 1.f; return w + n; }
  DEVI float kscale(int k) const { return g[k]; }
  DEVI float at(int k, int n) const { return g[k] * w[(size_t)k * 768 + n]; } };
struct WUkvAcc { const float* w; const float* g; static constexpr int LD = 1024;
  DEVI const float* col(int n, float& msk) const { msk = 1.f; return w + n; }
  DEVI float kscale(int k) const { return g[k]; }
  DEVI float at(int k, int n) const { return g[k] * w[(size_t)k * 1024 + n]; } };
struct WOutAcc { const float* w; static constexpr int LD = 1024;
  DEVI const float* col(int n, float& msk) const { msk = 1.f; return w + n; }
  DEVI float kscale(int) const { return 1.f; }
  DEVI float at(int k, int n) const { return w[(size_t)k * 1024 + n]; } };
struct WGUAcc { const float* wg; const float* wu;
  static constexpr int LD = 512;
  DEVI const float* col(int n, float& msk) const { const int g = n >> 3, j = n & 7; msk = 1.f;
    const unsigned long long a = (unsigned long long)wg, b = (unsigned long long)wu;
    const unsigned lo = j < 4 ? (unsigned)a : (unsigned)b, hi = j < 4 ? (unsigned)(a >> 32) : (unsigned)(b >> 32);
    return (const float*)(((unsigned long long)hi << 32) | lo) + g * 4 + (j & 3); }
  DEVI float kscale(int) const { return 1.f; }
  DEVI float at(int k, int n) const { const int g = n >> 3, j = n & 7; return j < 4 ? wg[(size_t)k * 512 + g * 4 + j] : wu[(size_t)k * 512 + g * 4 + j - 4]; } };
struct WDAcc { const float* w; static constexpr int LD = 1024;
  DEVI const float* col(int n, float& msk) const { msk = 1.f; return w + n; }
  DEVI float kscale(int) const { return 1.f; }
  DEVI float at(int k, int n) const { return w[(size_t)k * 1024 + n]; } };

namespace g8 {
#define G8_LAS __attribute__((address_space(3)))
constexpr int BM = 256, BK = 64, HALF = 128, HTB = HALF * BK * 2  , STAGE_BYTES = 8 * HTB;
DEVI int lds_byte(int r, int c) { const int st = (r >> 4) * 2 + (c >> 5), rr = r & 15, cc = c & 31, ob = rr * 64 + cc * 2; return st * 1024 + (ob ^ (((ob >> 9) & 1) << 5)); }
DEVI void stage_rc(int b, int& R, int& C) { const int st = b / 1024, sb = b % 1024, swz = sb ^ (((sb >> 9) & 1) << 5); R = (st >> 1) * 16 + swz / 64; C = (st & 1) * 32 + (swz % 64) / 2; }
DEVI int perm32(int rho) { const int n = rho >> 4, i = rho & 15; return 8 * (i >> 2) + 4 * n + (i & 3); }
struct Unit { int pm, pn; };
template <class Epi, class Sched, bool GATHER, int K>
DEVI void gemm_phase(G8_LAS unsigned char* lds, const bf16_t* A, const bf16_t* Bt, const Sched& S, const Epi& E) {
  int tid = threadIdx.x; asm volatile("" : "+v"(tid));
  const int wid = __builtin_amdgcn_readfirstlane(tid >> 6), lane = tid & 63, wr = wid >> 2, wc = wid & 3, fr = lane & 15, fq = lane >> 4;
  constexpr int nt = K / BK;
  int sR[2], sC[2]; unsigned voffB[2];
#pragma unroll
  for (int i = 0; i < 2; ++i) { int R, C; stage_rc(tid * 16 + i * 8192, R, C); sR[i] = R; sC[i] = C; const int Rb = (R & ~31) + perm32(R & 31); voffB[i] = (unsigned)(Rb * K + C) * 2u; }
  constexpr size_t kstep = (size_t)(BK * 2);
  constexpr size_t hstep = (size_t)HALF * K * 2;
  constexpr size_t tstep = 2 * hstep;
  const unsigned ldsw = (unsigned)wid * 1024u;
  const int aoff = lds_byte(wr * 64 + fr, fq * 8), boff = lds_byte(wc * 32 + fr, fq * 8);
#define PG8_SA(b, h) (((b) * 2 + (h)) * HTB)
#define PG8_SB(b, h) ((4 + (b) * 2 + (h)) * HTB)
#define PG8_STAGE(bufoff, gbase, voff) do { _Pragma("unroll") for (int _i = 0; _i < 2; ++_i) \
        __builtin_amdgcn_global_load_lds((const unsigned*)((const char*)(gbase) + (voff)[_i]), (G8_LAS unsigned*)(lds + (bufoff) + ldsw + _i * 8192), 16, 0, 0); } while (0)
#define PG8_LDA(dst, b, h) do { _Pragma("unroll") for (int m = 0; m < 4; ++m) _Pragma("unroll") for (int k = 0; k < 2; ++k) dst[m][k] = *(const G8_LAS bf16x8*)(lds + PG8_SA(b, h) + aoff + m * 2048 + k * 1024); } while (0)
#define PG8_LDB(dst, b, h) do { _Pragma("unroll") for (int n = 0; n < 2; ++n) _Pragma("unroll") for (int k = 0; k < 2; ++k) dst[n][k] = *(const G8_LAS bf16x8*)(lds + PG8_SB(b, h) + boff + n * 2048 + k * 1024); } while (0)
#define PG8_MMA(ai, bj, At, Bt_) do { __builtin_amdgcn_s_setprio(1); _Pragma("unroll") for (int m = 0; m < 4; ++m) _Pragma("unroll") for (int n = 0; n < 2; ++n) _Pragma("unroll") for (int k = 0; k < 2; ++k) \
        acc[ai][bj][m][n] = __builtin_amdgcn_mfma_f32_16x16x32_bf16(Bt_[n][k], At[m][k], acc[ai][bj][m][n], 0, 0, 0); __builtin_amdgcn_s_setprio(0); } while (0)
#define PG8_WAIT_V(n) asm volatile("s_waitcnt vmcnt(" #n ")" ::: "memory")
#define PG8_WAIT_L(n) asm volatile("s_waitcnt lgkmcnt(" #n ")" ::: "memory")
#define PG8_BAR __builtin_amdgcn_s_barrier()
#define PG8_SCHED __builtin_amdgcn_sched_barrier(0)
  Unit cur, nxt; int ui = 0;
  if (!S.next(0, cur)) return;
  f32x4 acc[2][2][4][2];
#pragma unroll
  for (int a = 0; a < 2; ++a)
#pragma unroll
    for (int b = 0; b < 2; ++b)
#pragma unroll
      for (int m = 0; m < 4; ++m)
#pragma unroll
        for (int n = 0; n < 2; ++n) acc[a][b][m][n] = (f32x4){0.f, 0.f, 0.f, 0.f};
  bf16x8 At[4][2], B0[2][2], B1[2][2];
  unsigned vA0[2], vA1[2];
#define G8_SETV(U_, V0, V1) do { _Pragma("unroll") for (int _i = 0; _i < 2; ++_i) { \
      V0[_i] = (unsigned)S.arow(U_, sR[_i]) * (unsigned)(K * 2) + (unsigned)(sC[_i] * 2); V1[_i] = (unsigned)S.arow(U_, 128 + sR[_i]) * (unsigned)(K * 2) + (unsigned)(sC[_i] * 2); } } while (0)
  if (GATHER) { G8_SETV(cur, vA0, vA1); }
  else {
#pragma unroll
    for (int i = 0; i < 2; ++i) { vA0[i] = (unsigned)(sR[i] * K + sC[i]) * 2u; vA1[i] = vA0[i]; } }
  constexpr size_t hA = GATHER ? (size_t)0 : hstep;
  const char* cA = GATHER ? (const char*)A : (const char*)A + (size_t)cur.pm * tstep; const char* cB = (const char*)Bt + (size_t)cur.pn * tstep;
  PG8_STAGE(PG8_SB(0, 0), cB, voffB); PG8_STAGE(PG8_SA(0, 0), cA, vA0); PG8_STAGE(PG8_SB(0, 1), cB + hstep, voffB); PG8_STAGE(PG8_SA(0, 1), cA + hA, vA1);
  if (wr == 1) PG8_BAR;
  PG8_WAIT_V(4); PG8_BAR;
  PG8_STAGE(PG8_SB(1, 0), cB + kstep, voffB); PG8_STAGE(PG8_SA(1, 0), cA + kstep, vA0); PG8_STAGE(PG8_SB(1, 1), cB + hstep + kstep, voffB);
  PG8_WAIT_V(6); PG8_BAR;
  for (;;) {
    const bool has_next = S.next(ui + 1, nxt);
    const char* nA = has_next ? (GATHER ? (const char*)A : (const char*)A + (size_t)nxt.pm * tstep) : cA; const char* nB = has_next ? (const char*)Bt + (size_t)nxt.pn * tstep : cB;
#pragma unroll 1
    for (int t = 0; t < nt; t += 2) {
      const bool last = (t == nt - 2);
      const char* a1 = cA + (size_t)(t + 1) * kstep;
      const char* a2 = last ? nA : cA + (size_t)(t + 2) * kstep; const char* b2 = last ? nB : cB + (size_t)(t + 2) * kstep;
      const char* a3 = a2 + kstep; const char* b3 = b2 + kstep;
      PG8_LDB(B0, 0, 0); PG8_SCHED; PG8_LDA(At, 0, 0); PG8_STAGE(PG8_SA(1, 1), a1 + hA, vA1);
      PG8_WAIT_L(8); PG8_BAR; PG8_WAIT_L(0); PG8_MMA(0, 0, At, B0); PG8_BAR; PG8_SCHED;
      if (GATHER) { if (last && has_next) { G8_SETV(nxt, vA0, vA1); } }
      PG8_LDB(B1, 0, 1); PG8_STAGE(PG8_SB(0, 0), b2, voffB);
      PG8_BAR; PG8_WAIT_L(0); PG8_MMA(0, 1, At, B1); PG8_BAR;
      PG8_LDA(At, 0, 1); PG8_STAGE(PG8_SA(0, 0), a2, vA0);
      PG8_BAR; PG8_WAIT_L(0); PG8_MMA(1, 0, At, B0); PG8_BAR; PG8_SCHED;
      PG8_STAGE(PG8_SB(0, 1), b2 + hstep, voffB);
      PG8_WAIT_V(6); PG8_BAR; PG8_MMA(1, 1, At, B1); PG8_BAR;
      PG8_LDB(B0, 1, 0); PG8_SCHED; PG8_LDA(At, 1, 0); PG8_STAGE(PG8_SA(0, 1), a2 + hA, vA1);
      PG8_WAIT_L(8); PG8_BAR; PG8_WAIT_L(0); PG8_MMA(0, 0, At, B0); PG8_BAR; PG8_SCHED;
      PG8_LDB(B1, 1, 1); PG8_STAGE(PG8_SB(1, 0), b3, voffB);
      PG8_BAR; PG8_WAIT_L(0); PG8_MMA(0, 1, At, B1); PG8_BAR;
      PG8_LDA(At, 1, 1); PG8_STAGE(PG8_SA(1, 0), a3, vA0);
      PG8_BAR; PG8_WAIT_L(0); PG8_MMA(1, 0, At, B0); PG8_BAR; PG8_SCHED;
      PG8_STAGE(PG8_SB(1, 1), b3 + hstep, voffB);
      PG8_WAIT_V(6); PG8_BAR; PG8_MMA(1, 1, At, B1); PG8_BAR;
    }
    E(acc, cur, wr, wc, fr, fq);
    if (!has_next) break;
#pragma unroll
    for (int a = 0; a < 2; ++a)
#pragma unroll
      for (int b = 0; b < 2; ++b)
#pragma unroll
        for (int m = 0; m < 4; ++m)
#pragma unroll
          for (int n = 0; n < 2; ++n) acc[a][b][m][n] = (f32x4){0.f, 0.f, 0.f, 0.f};
    cur = nxt; cA = nA; cB = nB; ++ui;
  }
  PG8_WAIT_V(0);
  if (wr == 0) PG8_BAR;
  PG8_BAR;
#undef G8_SETV
#undef PG8_SA
#undef PG8_SB
#undef PG8_STAGE
#undef PG8_LDA
#undef PG8_LDB
#undef PG8_MMA
#undef PG8_WAIT_V
#undef PG8_WAIT_L
#undef PG8_BAR
#undef PG8_SCHED
}
}

constexpr int PH_BYTES = 139264;
constexpr int SM_BARW  = PH_BYTES;
constexpr int SM_TAB   = PH_BYTES + 32;
constexpr int SM_PTR   = PH_BYTES + 32 + 160;
constexpr int LDS_TOTAL = PH_BYTES + 32 + 160 + 208;
constexpr int KM_KN = 0;
constexpr int KM_KR = 32;
constexpr int KM_NA = 40;
constexpr int KM_BM = 80;

DEVI void store8(bf16_t* p, const f32x4& a, const f32x4& b) { u32x4 w = {pk2(a[0], a[1]), pk2(a[2], a[3]), pk2(b[0], b[1]), pk2(b[2], b[3])}; *(u32x4*)p = w; }
DEVI float sumsq8(const f32x4& a, const f32x4& b) { return a[0] * a[0] + a[1] * a[1] + a[2] * a[2] + a[3] * a[3] + b[0] * b[0] + b[1] * b[1] + b[2] * b[2] + b[3] * b[3]; }
DEVI float fq_sum(float v) { v += __shfl_xor(v, 16); v += __shfl_xor(v, 32); return v; }
DEVI float fr_max(float v) { v = fmaxf(v, __shfl_xor(v, 1)); v = fmaxf(v, __shfl_xor(v, 2)); v = fmaxf(v, __shfl_xor(v, 4)); v = fmaxf(v, __shfl_xor(v, 8)); return v; }
DEVI void rope8(f32x4& v0, f32x4& v1, int fq, int gr, int gc, const float* rc, const float* rs) {
  const int pb = ((fq & 1) ? gc : gr) * 8;
  float x[8] = {v0[0], v0[1], v0[2], v0[3], v1[0], v1[1], v1[2], v1[3]};
#pragma unroll
  for (int e = 0; e < 8; ++e) { const float y = __shfl_xor(x[e], 32); const float cs = rc[pb + e], sn = rs[pb + e];
    x[e] = fq < 2 ? x[e] * cs - y * sn : y * sn + x[e] * cs; }
  v0 = (f32x4){x[0], x[1], x[2], x[3]}; v1 = (f32x4){x[4], x[5], x[6], x[7]};
}

struct SchedGrid {
  int nM, nN, U, nb, bid, mskip;
  DEVI bool next(int i, g8::Unit& u) const { const int x = xcd_unit(bid + i * nb, U); if (x < 0) return false; int tm, tn; panel_order(x, nM, nN, tm, tn); u.pm = mskip ? tm + 1 + tm / 32 : tm; u.pn = tn; return true; }
  DEVI unsigned arow(const g8::Unit&, int) const { return 0u; }
};
typedef const int __attribute__((address_space(3))) las_cint;
struct SchedMoe {
  las_cint* tab; const int* elist; int MT, U, nb, bid;
  DEVI bool next(int i, g8::Unit& u) const { const int x = xcd_unit(bid + i * nb, U); if (x < 0) return false; int mt, tn; panel_order(x, MT, 4, mt, tn);
    int e = 0;
#pragma unroll
    for (int q = 1; q < 16; ++q) e += (mt >= tab[q]) ? 1 : 0;
    u.pm = mt; u.pn = e * 4 + tn; return true; }
  DEVI unsigned arow(const g8::Unit& u, int r) const { const int e = u.pn >> 2, slot = (u.pm - tab[e]) * 256 + r; return slot < tab[17 + e] ? (unsigned)(elist[(size_t)e * TT + slot] >> 1) : 0u; }
};
DEVI void moe_table(const Params& p, char* smem) {
  if (threadIdx.x == 0) { int* tab = (int*)(smem + SM_TAB); const int* cnt = (const int*)(p.ws + OFF_CNT); int acc = 0;
    for (int e = 0; e < 16; ++e) { tab[e] = acc; tab[17 + e] = cnt[e]; acc += (cnt[e] + 255) >> 8; } tab[16] = acc; }
  __syncthreads();
}

#define EPI_ROWS for (int ai = 0; ai < 2; ++ai) _Pragma("unroll") for (int m = 0; m < 4; ++m)
struct EpiProj8 { const Params* p;
  DEVI void operator()(const f32x4 (&acc)[2][2][4][2], const g8::Unit& u, int wr, int wc, int fr, int fq) const {
    char* ws = p->ws; const int b = (u.pm * 256) / RB;
    const float* rc = (const float*)(ws + OFF_ROPE); const float* rs = rc + 1024;
#pragma unroll
    for (int bj = 0; bj < 2; ++bj) {
      const int gc = u.pn * 256 + bj * 128 + wc * 32;
      float rmx = 0.f;
#pragma unroll
      EPI_ROWS {
        const int row = u.pm * 256 + ai * 128 + wr * 64 + m * 16 + fr;
        f32x4 v0 = acc[ai][bj][m][0], v1 = acc[ai][bj][m][1];
        if (gc < 384) { store8((bf16_t*)(ws + OFF_QLAT) + (size_t)row * 384 + gc + 8 * fq, v0, v1);
          const float ss = fq_sum(sumsq8(v0, v1)); if (fq == 0) ((float*)(ws + OFF_SSQ))[(size_t)row * 12 + (gc >> 5)] = ss; }
        else if (gc < 896) { store8((bf16_t*)(ws + OFF_NAQ) + (size_t)row * 512 + (gc - 384) + 8 * fq, v0 * NASCALE, v1 * NASCALE); }
        else if (gc < 1152) { store8((bf16_t*)(ws + OFF_KVLAT) + (size_t)row * 256 + (gc - 896) + 8 * fq, v0, v1);
          const float ss = fq_sum(sumsq8(v0, v1)); if (fq == 0) ((float*)(ws + OFF_SSKV))[(size_t)row * 8 + ((gc - 896) >> 5)] = ss; }
        else if (gc < 1664) { store8((bf16_t*)(ws + OFF_NAK) + (size_t)row * 512 + (gc - 1152) + 8 * fq, v0, v1); rmx = fmaxf(rmx, fq_sum(sumsq8(v0, v1))); }
        else if (gc < 2176) { store8((bf16_t*)(ws + OFF_NAV) + (size_t)row * 512 + (gc - 1664) + 8 * fq, v0, v1); }
        else if (gc == 2176) { const int rb = row % RB;
          if (rb >= CTXL) { const int pos = rb - CTXL; rope8(v0, v1, fq, pos >> 6, pos & 63, rc, rs); }
          store8((bf16_t*)(ws + OFF_KROPE) + (size_t)row * 32 + 8 * fq, v0, v1); rmx = fmaxf(rmx, fq_sum(sumsq8(v0, v1))); }
      }
      if (gc >= 1152 && gc < 1664) { rmx = fr_max(rmx); if ((threadIdx.x & 63) == 0) atomicMax((unsigned*)(ws + OFF_KMAX) + KM_NA + b * 16 + ((gc - 1152) >> 5), __float_as_uint(rmx)); }
      if (gc == 2176) { rmx = fr_max(rmx); if ((threadIdx.x & 63) == 0) atomicMax((unsigned*)(ws + OFF_KMAX) + KM_KR + b, __float_as_uint(rmx)); }
    }
  } };

struct EpiQm8 { const Params* p;
  DEVI void operator()(const f32x4 (&acc)[2][2][4][2], const g8::Unit& u, int wr, int wc, int fr, int fq) const {
    char* ws = p->ws; bf16_t* qm = (bf16_t*)p->out;
    const float* rc = (const float*)(ws + OFF_ROPE); const float* rs = rc + 1024;
    float sc8[2][4];
#pragma unroll
    for (int ai = 0; ai < 2; ++ai)
#pragma unroll
      for (int m = 0; m < 4; ++m) { const int row = u.pm * 256 + ai * 128 + wr * 64 + m * 16 + fr;
        const f32x4* sp = (const f32x4*)((const float*)(ws + OFF_SSQ) + (size_t)row * 12); f32x4 s0 = {0.f, 0.f, 0.f, 0.f}; if (fq < 3) s0 = sp[fq];
        sc8[ai][m] = (s0[0] + s0[1]) + (s0[2] + s0[3]); }
#pragma unroll
    for (int ai = 0; ai < 2; ++ai)
#pragma unroll
      for (int m = 0; m < 4; ++m) sc8[ai][m] = rsqrtf(fq_sum(sc8[ai][m]) * (1.f / 384.f) + EPS) * QSCALE;
    {
#pragma unroll
    EPI_ROWS {
      const int row = u.pm * 256 + ai * 128 + wr * 64 + m * 16 + fr; const int pos = row % RB - CTXL;
      const float sc = sc8[ai][m];
#pragma unroll
      for (int bj = 0; bj < 2; ++bj) { const int gc = u.pn * 256 + bj * 128 + wc * 32;
        f32x4 v0 = acc[ai][bj][m][0], v1 = acc[ai][bj][m][1];
        if ((gc % 96) == 64) rope8(v0, v1, fq, pos >> 6, pos & 63, rc, rs);
        store8(qm + (size_t)row * 768 + gc + 8 * fq, v0 * sc, v1 * sc); }
    }
    }
  } };

struct EpiKv8 { const Params* p;
  DEVI void operator()(const f32x4 (&acc)[2][2][4][2], const g8::Unit& u, int wr, int wc, int fr, int fq) const {
    char* ws = p->ws; const int b = (u.pm * 256) / RB; float rmx[2] = {0.f, 0.f};
    float sc8[2][4];
#pragma unroll
    for (int ai = 0; ai < 2; ++ai)
#pragma unroll
      for (int m = 0; m < 4; ++m) { const int row = u.pm * 256 + ai * 128 + wr * 64 + m * 16 + fr;
        const f32x4* sp = (const f32x4*)((const float*)(ws + OFF_SSKV) + (size_t)row * 8); f32x4 s0 = {0.f, 0.f, 0.f, 0.f}; if (fq < 2) s0 = sp[fq];
        sc8[ai][m] = (s0[0] + s0[1]) + (s0[2] + s0[3]); }
#pragma unroll
    for (int ai = 0; ai < 2; ++ai)
#pragma unroll
      for (int m = 0; m < 4; ++m) sc8[ai][m] = rsqrtf(fq_sum(sc8[ai][m]) * (1.f / 256.f) + EPS);
#pragma unroll
    EPI_ROWS {
      const int row = u.pm * 256 + ai * 128 + wr * 64 + m * 16 + fr; const float sc = sc8[ai][m];
#pragma unroll
      for (int bj = 0; bj < 2; ++bj) { const int gc = u.pn * 256 + bj * 128 + wc * 32;
        const f32x4 v0 = acc[ai][bj][m][0] * sc, v1 = acc[ai][bj][m][1] * sc;
        store8((bf16_t*)(ws + OFF_KV) + (size_t)row * 1024 + gc + 8 * fq, v0, v1);
        if ((gc & 127) < 64) rmx[bj] = fmaxf(rmx[bj], fq_sum(sumsq8(v0, v1))); }
    }
#pragma unroll
    for (int bj = 0; bj < 2; ++bj) { const int gc = u.pn * 256 + bj * 128 + wc * 32;
      if ((gc & 127) < 64) { const float r = fr_max(rmx[bj]); if ((threadIdx.x & 63) == 0) atomicMax((unsigned*)(ws + OFF_KMAX) + KM_KN + b * 16 + (gc >> 7) * 2 + ((gc >> 5) & 1), __float_as_uint(r)); } }
  } };

struct EpiOut8 { const Params* p;
  DEVI void operator()(const f32x4 (&acc)[2][2][4][2], const g8::Unit& u, int wr, int wc, int fr, int fq) const {
    const float* mod = (const float*)(p->ws + OFF_MOD); const int b = (u.pm * 256) >> 13;
    f32x4 gv[2][2];
#pragma unroll
    for (int bj = 0; bj < 2; ++bj) { const f32x4* gp = (const f32x4*)(mod + b * 6144 + 2048 + u.pn * 256 + bj * 128 + wc * 32 + 8 * fq); gv[bj][0] = gp[0]; gv[bj][1] = gp[1]; }
#pragma unroll
    for (int ai = 0; ai < 2; ++ai)
#pragma unroll
      for (int mh = 0; mh < 2; ++mh) {
        f32x4 xv[2][2][2];
#pragma unroll
        for (int mm = 0; mm < 2; ++mm)
#pragma unroll
          for (int bj = 0; bj < 2; ++bj) { const int m = mh * 2 + mm, tok = u.pm * 256 + ai * 128 + wr * 64 + m * 16 + fr, n = u.pn * 256 + bj * 128 + wc * 32 + 8 * fq;
            const f32x4* xp = (const f32x4*)(p->x + (size_t)tok * 1024 + n); xv[mm][bj][0] = xp[0]; xv[mm][bj][1] = xp[1]; }
#pragma unroll
        for (int mm = 0; mm < 2; ++mm)
#pragma unroll
          for (int bj = 0; bj < 2; ++bj) { const int m = mh * 2 + mm, tok = u.pm * 256 + ai * 128 + wr * 64 + m * 16 + fr, n = u.pn * 256 + bj * 128 + wc * 32 + 8 * fq;
            act_t* op = (act_t*)(p->ws + OFF_X1) + (size_t)tok * 1024 + n;
            const f32x4 r0 = xv[mm][bj][0] + gv[bj][0] * acc[ai][bj][m][0], r1 = xv[mm][bj][1] + gv[bj][1] * acc[ai][bj][m][1];
#if MODE_EXACT
            st4(op, r0[0], r0[1], r0[2], r0[3]); st4(op + 4, r1[0], r1[1], r1[2], r1[3]);
#else
            store8(op, r0, r1);
#endif
          }
      }
  } };

struct EpiGU8 { const Params* p; las_cint* tab;
  DEVI void operator()(const f32x4 (&acc)[2][2][4][2], const g8::Unit& u, int wr, int wc, int fr, int fq) const {
    bf16_t* hid = (bf16_t*)(p->ws + OFF_HID); const int e = u.pn >> 2, tn = u.pn & 3, slot0 = (u.pm - tab[e]) * 256, cnt = tab[17 + e];
    const float* ew = (const float*)(p->ws + OFF_EW) + (size_t)e * TT;
    float cw[2][4];
#pragma unroll
    for (int ai = 0; ai < 2; ++ai)
#pragma unroll
      for (int m = 0; m < 4; ++m) { const int slot = slot0 + ai * 128 + wr * 64 + m * 16 + fr; cw[ai][m] = slot < cnt ? ew[slot] : 0.f; }
#pragma unroll
    EPI_ROWS {
      const int r = ai * 128 + wr * 64 + m * 16 + fr; const bool valid = slot0 + r < cnt; const float c = cw[ai][m];
#pragma unroll
      for (int bj = 0; bj < 2; ++bj) { const int n = tn * 256 + bj * 128 + wc * 32 + 8 * fq;
        const f32x4 g = acc[ai][bj][m][0], up = acc[ai][bj][m][1]; float o[4];
#pragma unroll
        for (int j = 0; j < 4; ++j) o[j] = valid ? silu_fast(g[j]) * up[j] * c : 0.f;
        st4(hid + (size_t)(u.pm * 256 + r) * 512 + (n >> 1), o[0], o[1], o[2], o[3]); }
    }
  } };

struct EpiDown8 { const Params* p; las_cint* tab;
  DEVI void operator()(const f32x4 (&acc)[2][2][4][2], const g8::Unit& u, int wr, int wc, int fr, int fq) const {
    bf16_t* yb = (bf16_t*)(p->ws + OFF_YBUF); const int e = u.pn >> 2, tn = u.pn & 3, slot0 = (u.pm - tab[e]) * 256, cnt = tab[17 + e];
    const int* el = (const int*)(p->ws + OFF_ELIST) + (size_t)e * TT;
    int tk[2][4];
#pragma unroll
    for (int ai = 0; ai < 2; ++ai)
#pragma unroll
      for (int m = 0; m < 4; ++m) { const int slot = slot0 + ai * 128 + wr * 64 + m * 16 + fr; tk[ai][m] = slot < cnt ? el[slot] : -1; }
#pragma unroll
    EPI_ROWS {
      const int t = tk[ai][m];
      if (t >= 0) { bf16_t* rowp = yb + ((size_t)(t & 1) * TT + (t >> 1)) * 1024 + tn * 256 + wc * 32 + 8 * fq;
#pragma unroll
        for (int bj = 0; bj < 2; ++bj) store8(rowp + bj * 128, acc[ai][bj][m][0], acc[ai][bj][m][1]); }
    }
  } };
#undef EPI_ROWS

DEVI void modgemv_item(const Params& p, int item, char* smem) {
  float* sc = (float*)smem; float* red = sc + 3072;
  const int t = threadIdx.x;
  __syncthreads();
  for (int i = t; i < 3072; i += NTHREADS) { const int ci = i >> 10, k = i & 1023; const float v = ci == 0 ? p.c[k] : ci == 1 ? p.c[1024 + k] : p.c_ctx[k]; sc[i] = silu_f(v); }
  __syncthreads();
  const int cc = t & 31, kg = t >> 5, col = item * 32 + cc;
  float a0 = 0.f, a1 = 0.f, a2 = 0.f;
  { const float* wp = p.w_mod + (size_t)kg * 6144 + col;
#pragma unroll 1
    for (int kb = 0; kb < 1024; kb += 512) {
      float wv[32];
#pragma unroll
      for (int u = 0; u < 32; ++u) wv[u] = wp[(size_t)(kb + 16 * u) * 6144];
#pragma unroll
      for (int u = 0; u < 32; ++u) { const int k = kb + 16 * u + kg; a0 = fmaf(sc[k], wv[u], a0); a1 = fmaf(sc[1024 + k], wv[u], a1); a2 = fmaf(sc[2048 + k], wv[u], a2); }
    } }
  red[(kg * 32 + cc) * 3 + 0] = a0; red[(kg * 32 + cc) * 3 + 1] = a1; red[(kg * 32 + cc) * 3 + 2] = a2;
  __syncthreads();
  if (t < 96) { const int c2 = t & 31, ci = t >> 5; float s = 0.f;
#pragma unroll
    for (int g = 0; g < 16; ++g) s += red[(g * 32 + c2) * 3 + ci];
    ((float*)(p.ws + OFF_MOD))[ci * 6144 + item * 32 + c2] = s + p.b_mod[item * 32 + c2]; }
}

DEVI void misc_item(const Params& p) {
  const int t = threadIdx.x;
  if (t < 16) ((int*)(p.ws + OFF_CNT))[t] = 0;
  if (t < KM_BM) ((unsigned*)(p.ws + OFF_KMAX))[t] = 0u;
  { const int h = t >> 6, lane = t & 63; float bm = 0.f;
    for (int i = lane; i < 15 * 31; i += 64) bm = fmaxf(bm, p.rel_bias[h * 465 + i]);
#pragma unroll
    for (int o = 32; o > 0; o >>= 1) bm = fmaxf(bm, __shfl_xor(bm, o));
    if (lane == 0) ((float*)(p.ws + OFF_KMAX))[KM_BM + h] = bm * LOG2E; }
  float* rc = (float*)(p.ws + OFF_ROPE); float* rs = rc + 1024;
  for (int i = t; i < 1024; i += NTHREADS) {
    const int pos = i >> 3, j = i & 7;
    double f = 1.0; for (int q = 0; q < j; ++q) f *= 0.31622776601683794;
    const double a = (double)pos * f; const double n = rint(a * 0.15915494309189535); const double r = a - n * 6.283185307179586477;
    const double r2 = r * r; double sn = r, cs = 1.0, ts = r, tc = 1.0;
    for (int q = 1; q <= 14; ++q) { tc *= -r2 / (double)((2 * q - 1) * (2 * q)); cs += tc; ts *= -r2 / (double)((2 * q) * (2 * q + 1)); sn += ts; }
    rc[i] = (float)cs; rs[i] = (float)sn;
  }
}
DEVI void wrt_item(const Params& p, int j) {
  float* wrt = (float*)(p.ws + OFF_WRT) + j * 1024;
  for (int k = threadIdx.x; k < 1024; k += NTHREADS) wrt[k] = j < 4 ? p.w_rg[k * 4 + j] : p.w_re[k * 16 + j - 4];
}

DEVI void bt_item(const Params& p, int item) {
  unsigned* bt = (unsigned*)(p.ws + OFF_BT) + (size_t)item * 2048;
  for (int i = threadIdx.x; i < 2048; i += NTHREADS) { const int kc = i >> 6, c = i & 63; int cs = c - 8; cs = cs < 0 ? 0 : (cs > 48 ? 48 : cs);
    const float lo = (kc >= cs && kc < cs + 16) ? p.rel_bias[(size_t)item * 31 + (kc - c + 15)] * LOG2E : -1e30f;
    const int k2 = kc + 32; const float hi = (k2 >= cs && k2 < cs + 16) ? p.rel_bias[(size_t)item * 31 + (k2 - c + 15)] * LOG2E : -1e30f;
    bt[i] = pk2(lo, hi); }
}

struct ConvTile { const float* cp; const float* g; bf16_t* dst; int LD, K, n0, k0; float msk; };
DEVI ConvTile conv_desc(const Params& p, int j, int t) {
  constexpr int C_IN = (NPROJ / 64) * 16, C_UQ = 12 * 6, C_UKV = 16 * 4, C_OUT = 256, C_GU = 16 * 16 * 16;
  ConvTile c; c.g = nullptr; c.msk = 1.f; const int nn = t & 63;
  if (j < C_IN) { WInAcc a{p.w_in}; c.n0 = (j >> 4) * 64; c.k0 = (j & 15) * 64; c.cp = a.col(c.n0 + nn, c.msk); c.LD = WInAcc::LD; c.K = 1024; c.dst = (bf16_t*)(p.ws + OFF_WIN); }
  else if ((j -= C_IN) < C_UQ) { c.n0 = (j / 6) * 64; c.k0 = (j % 6) * 64; c.cp = p.w_uq + c.n0 + nn; c.g = p.g_q; c.LD = 768; c.K = 384; c.dst = (bf16_t*)(p.ws + OFF_WUQ); }
  else if ((j -= C_UQ) < C_UKV) { c.n0 = (j >> 2) * 64; c.k0 = (j & 3) * 64; c.cp = p.w_ukv + c.n0 + nn; c.g = p.g_kv; c.LD = 1024; c.K = 256; c.dst = (bf16_t*)(p.ws + OFF_WUKV); }
  else if ((j -= C_UKV) < C_OUT) { c.n0 = (j >> 4) * 64; c.k0 = (j & 15) * 64; c.cp = p.w_out + c.n0 + nn; c.LD = 1024; c.K = 1024; c.dst = (bf16_t*)(p.ws + OFF_WOUT); }
  else if ((j -= C_OUT) < C_GU) { const int e = j >> 8, r = j & 255; c.n0 = (r >> 4) * 64; c.k0 = (r & 15) * 64; WGUAcc a{p.w_gate + (size_t)e * 1024 * 512, p.w_up + (size_t)e * 1024 * 512};
    c.cp = a.col(c.n0 + nn, c.msk); c.LD = 512; c.K = 1024; c.dst = (bf16_t*)(p.ws + OFF_WGU) + (size_t)e * 1024 * 1024; }
  else { j -= C_GU; const int e = j >> 7, r = j & 127; c.n0 = (r >> 3) * 64; c.k0 = (r & 7) * 64; c.cp = p.w_down + (size_t)e * 512 * 1024 + c.n0 + nn; c.LD = 1024; c.K = 512; c.dst = (bf16_t*)(p.ws + OFF_WD) + (size_t)e * 1024 * 512; }
  c.cp += (size_t)(c.k0 + 8 * (t >> 6)) * c.LD;
  return c;
}
DEVI void conv_load(const ConvTile& c, float (&v)[16]) {
#pragma unroll
  for (int i = 0; i < 8; ++i) { v[i] = c.cp[(size_t)i * c.LD]; v[8 + i] = c.cp[(size_t)(64 + i) * c.LD]; }
}
DEVI void conv_finish(const ConvTile& c, const float (&v)[16], int t) {
#pragma unroll
  for (int h = 0; h < 2; ++h) {
    const int kk = c.k0 + 64 * h + 8 * (t >> 6); float x[8];
#pragma unroll
    for (int i = 0; i < 8; ++i) x[i] = v[8 * h + i] * c.msk * (c.g ? c.g[kk + i] : 1.f);
    *(uint4*)(c.dst + (size_t)(c.n0 + (t & 63)) * c.K + kk) = make_uint4(pk2(x[0], x[1]), pk2(x[2], x[3]), pk2(x[4], x[5]), pk2(x[6], x[7])); }
}

constexpr int CONV_C_EXPERTS = 10;
constexpr int NCONV_A = (NPROJ / 64) * 16;
constexpr int NCONV_C = NCONV_A + 12 * 6 + 16 * 4 + 256 + CONV_C_EXPERTS * 256;
constexpr int NCONV_E = NCONV_A + 12 * 6 + 16 * 4 + 256 + 16 * 16 * 16;
constexpr int NCONV = NCONV_E + 16 * 16 * 8;
static_assert(NCONV_A % 4 == 0 && NCONV_C % 4 == 0 && NCONV_E % 4 == 0 && NCONV % 4 == 0, "pairs, two per grab");
DEVI void conv_queue(const Params& p, char* smem, int q, int jbase, int jend) {
  int t = threadIdx.x; asm volatile("" : "+v"(t));
  unsigned* ctr = (unsigned*)(p.ws + OFF_BAR) + 16 * q;
  int* nxt = (int*)(smem + 32768);
  auto grab4 = [&]() -> int { __syncthreads(); if (t == 0) *nxt = jbase + (int)atomicAdd(ctr, 4u); __syncthreads(); return *nxt; };
  int jb = grab4(), jo = 0;
  if (jb < jend) {
    ConvTile c = conv_desc(p, jb, t); float v[16]; conv_load(c, v);
    for (;;) {
      int jn;
      if (jo < 1) { ++jo; jn = jb + 2 * jo; } else { jb = grab4(); jo = 0; jn = jb; }
      const bool more = jn < jend;
      ConvTile cn = c; float vn[16];
      if (more) { cn = conv_desc(p, jn, t); conv_load(cn, vn); }
      conv_finish(c, v, t);
      if (!more) break;
      c = cn;
#pragma unroll
      for (int i = 0; i < 16; ++i) v[i] = vn[i];
    }
  }
}

DEVI void phase_A(const Params& p, int bid, int nb, char* smem) {
  constexpr int N_MOD = 192, N_MISC = 1, N_WRT = 20, N_BT = 120;
  constexpr int I0 = N_MOD + N_MISC + N_WRT + N_BT;
  for (int it = bid; it < I0; it += nb) {
    if (it < N_MOD) modgemv_item(p, it, smem);
    else if (it < N_MOD + N_MISC) misc_item(p);
    else if (it < N_MOD + N_MISC + N_WRT) wrt_item(p, it - N_MOD - N_MISC);
    else bt_item(p, it - N_MOD - N_MISC - N_WRT);
  }
  conv_queue(p, smem, 0, 0, NCONV_A);
}

DEVI void phase_B(const Params& p, int bid, int nb) {
  int tx = threadIdx.x; asm volatile("" : "+v"(tx));
  const int lane = tx & 63, wv = tx >> 6;
  const float* mod = (const float*)(p.ws + OFF_MOD); act_t* hx = (act_t*)(p.ws + OFF_HXALL);
  const int nw = nb * NWAVES;
  for (int r0 = bid * NWAVES + wv; r0 < RR; r0 += 4 * nw) {
    float4 v[4][4]; const float* src[4]; int mrow[4];
#pragma unroll
    for (int q = 0; q < 4; ++q) { int row = r0 + q * nw; row = row < RR ? row : r0; const int b = row / RB, rb = row - b * RB;
      src[q] = rb < CTXL ? p.ctx + (size_t)(b * CTXL + rb) * 1024 : p.x + (size_t)(b * SEQ + rb - CTXL) * 1024; mrow[q] = rb < CTXL ? 2 : b;
#pragma unroll
      for (int i = 0; i < 4; ++i) v[q][i] = *(const float4*)(src[q] + lane * 4 + 256 * i); }
#pragma unroll
    for (int q = 0; q < 4; ++q) { const int row = r0 + q * nw; if (row >= RR) continue;
      float ss = 0.f;
#pragma unroll
      for (int i = 0; i < 4; ++i) ss += v[q][i].x * v[q][i].x + v[q][i].y * v[q][i].y + v[q][i].z * v[q][i].z + v[q][i].w * v[q][i].w;
      ss = wave_sum(ss); const float rstd = rsqrtf(ss * (1.f / 1024.f) + EPS);
      const float* sh = mod + mrow[q] * 6144; const float* sc = sh + 1024;
#pragma unroll
      for (int i = 0; i < 4; ++i) { const int k = lane * 4 + 256 * i; const float4 g = *(const float4*)(p.g_attn + k), s1 = *(const float4*)(sc + k), s0 = *(const float4*)(sh + k);
        st4(hx + (size_t)row * 1024 + k, v[q][i].x * rstd * g.x * (1.f + s1.x) + s0.x, v[q][i].y * rstd * g.y * (1.f + s1.y) + s0.y, v[q][i].z * rstd * g.z * (1.f + s1.z) + s0.z, v[q][i].w * rstd * g.w * (1.f + s1.w) + s0.w); } }
  }
}

DEVI void phase_C(const Params& p, int bid, int nb, char* smem) {
  SchedGrid S{66, 9, 66 * 9, nb, bid, 0}; EpiProj8 E{&p};
  g8::gemm_phase<EpiProj8, SchedGrid, false, 1024>((G8_LAS unsigned char*)smem, (const bf16_t*)(p.ws + OFF_HXALL), (const bf16_t*)(p.ws + OFF_WIN), S, E);
}
DEVI void phase_D(const Params& p, int bid, int nb, char* smem) {
  { SchedGrid S{64, 3, 192, nb, bid, 1}; EpiQm8 E{&p};
    g8::gemm_phase<EpiQm8, SchedGrid, false, 384>((G8_LAS unsigned char*)smem, (const bf16_t*)(p.ws + OFF_QLAT), (const bf16_t*)(p.ws + OFF_WUQ), S, E); }
  { int b2 = bid + 64; b2 = b2 >= nb ? b2 - nb : b2;
    SchedGrid S{66, 4, 264, nb, b2, 0}; EpiKv8 E{&p};
    g8::gemm_phase<EpiKv8, SchedGrid, false, 256>((G8_LAS unsigned char*)smem, (const bf16_t*)(p.ws + OFF_KVLAT), (const bf16_t*)(p.ws + OFF_WUKV), S, E); }
}
DEVI void phase_F(const Params& p, int bid, int nb, char* smem) {
  SchedGrid S{64, 4, 256, nb, bid, 0}; EpiOut8 E{&p};
  g8::gemm_phase<EpiOut8, SchedGrid, false, 1024>((G8_LAS unsigned char*)smem, (const bf16_t*)(p.ws + OFF_ATTN), (const bf16_t*)(p.ws + OFF_WOUT), S, E);
}
DEVI void phase_H(const Params& p, int bid, int nb, char* smem) {
  moe_table(p, smem); las_cint* tab = (las_cint*)(smem + SM_TAB); const int MT = tab[16];
  SchedMoe S{tab, (const int*)(p.ws + OFF_ELIST), MT, MT * 4, nb, bid}; EpiGU8 E{&p, tab};
  g8::gemm_phase<EpiGU8, SchedMoe, true, 1024>((G8_LAS unsigned char*)smem, (const bf16_t*)(p.ws + OFF_HX2), (const bf16_t*)(p.ws + OFF_WGU), S, E);
}
DEVI void phase_I(const Params& p, int bid, int nb, char* smem) {
  moe_table(p, smem); las_cint* tab = (las_cint*)(smem + SM_TAB); const int MT = tab[16];
  SchedMoe S{tab, (const int*)(p.ws + OFF_ELIST), MT, MT * 4, nb, bid}; EpiDown8 E{&p, tab};
  g8::gemm_phase<EpiDown8, SchedMoe, false, 512>((G8_LAS unsigned char*)smem, (const bf16_t*)(p.ws + OFF_HID), (const bf16_t*)(p.ws + OFF_WD), S, E);
}

typedef s16x4 __attribute__((address_space(3))) las_s16x4;
DEVI bf16x8 pack8(const f32x16& s, int base) {
  u32x4 w = {pk2(s[base], s[base + 1]), pk2(s[base + 2], s[base + 3]), pk2(s[base + 4], s[base + 5]), pk2(s[base + 6], s[base + 7])};
  return __builtin_bit_cast(bf16x8, w);
}
DEVI bf16x8 tr_pair(const char* p) {
  const s16x4 lo = __builtin_amdgcn_ds_read_tr16_b64_v4i16((las_s16x4*)(p));
  const s16x4 hh = __builtin_amdgcn_ds_read_tr16_b64_v4i16((las_s16x4*)(p + 8 * 64));
  return (bf16x8){lo[0], lo[1], lo[2], lo[3], hh[0], hh[1], hh[2], hh[3]};
}
template <bool S00, bool S11>
DEVI void pv_block_skip(const char* Vs, int vb, const f32x16& s0, const f32x16& s1, f32x16& o0, f32x16& o1) {
  const char* v0 = Vs + vb; const char* v1 = Vs + 4096 + vb;
  if (!S00) { const bf16x8 p00 = pack8(s0, 0); o0 = __builtin_amdgcn_mfma_f32_32x32x16_bf16(tr_pair(v0), p00, o0, 0, 0, 0); o1 = __builtin_amdgcn_mfma_f32_32x32x16_bf16(tr_pair(v1), p00, o1, 0, 0, 0); }
  { const bf16x8 p01 = pack8(s0, 8); o0 = __builtin_amdgcn_mfma_f32_32x32x16_bf16(tr_pair(v0 + 16 * 64), p01, o0, 0, 0, 0); o1 = __builtin_amdgcn_mfma_f32_32x32x16_bf16(tr_pair(v1 + 16 * 64), p01, o1, 0, 0, 0); }
  { const bf16x8 p10 = pack8(s1, 0); o0 = __builtin_amdgcn_mfma_f32_32x32x16_bf16(tr_pair(v0 + 32 * 64), p10, o0, 0, 0, 0); o1 = __builtin_amdgcn_mfma_f32_32x32x16_bf16(tr_pair(v1 + 32 * 64), p10, o1, 0, 0, 0); }
  if (!S11) { const bf16x8 p11 = pack8(s1, 8); o0 = __builtin_amdgcn_mfma_f32_32x32x16_bf16(tr_pair(v0 + 48 * 64), p11, o0, 0, 0, 0); o1 = __builtin_amdgcn_mfma_f32_32x32x16_bf16(tr_pair(v1 + 48 * 64), p11, o1, 0, 0, 0); }
}
DEVI void pv_block(const char* Vs, int vb, const f32x16& s0, const f32x16& s1, f32x16& o0, f32x16& o1) {
  const bf16x8 p00 = pack8(s0, 0), p01 = pack8(s0, 8), p10 = pack8(s1, 0), p11 = pack8(s1, 8);
  const char* v0 = Vs + vb; const char* v1 = Vs + 4096 + vb;
  o0 = __builtin_amdgcn_mfma_f32_32x32x16_bf16(tr_pair(v0), p00, o0, 0, 0, 0);
  o0 = __builtin_amdgcn_mfma_f32_32x32x16_bf16(tr_pair(v0 + 16 * 64), p01, o0, 0, 0, 0);
  o0 = __builtin_amdgcn_mfma_f32_32x32x16_bf16(tr_pair(v0 + 32 * 64), p10, o0, 0, 0, 0);
  o0 = __builtin_amdgcn_mfma_f32_32x32x16_bf16(tr_pair(v0 + 48 * 64), p11, o0, 0, 0, 0);
  o1 = __builtin_amdgcn_mfma_f32_32x32x16_bf16(tr_pair(v1), p00, o1, 0, 0, 0);
  o1 = __builtin_amdgcn_mfma_f32_32x32x16_bf16(tr_pair(v1 + 16 * 64), p01, o1, 0, 0, 0);
  o1 = __builtin_amdgcn_mfma_f32_32x32x16_bf16(tr_pair(v1 + 32 * 64), p10, o1, 0, 0, 0);
  o1 = __builtin_amdgcn_mfma_f32_32x32x16_bf16(tr_pair(v1 + 48 * 64), p11, o1, 0, 0, 0);
}
template <int DQK, bool BIAS>
DEVI void flash_tile(const char* Ks, const char* Vs, const bf16x8 (&qf)[DQK / 16], f32x16& o0, f32x16& o1, float& m, float& l, const float* bt, int r32, int hi, int vb) {
  constexpr int KROW = DQK * 2 + 16;
  f32x16 s0, s1;
#pragma unroll
  for (int r = 0; r < 16; ++r) { s0[r] = 0.f; s1[r] = 0.f; }
#pragma unroll
  for (int s = 0; s < DQK / 16; ++s) {
    const bf16x8 k0 = *(const bf16x8*)(Ks + r32 * KROW + (16 * s + 8 * hi) * 2);
    const bf16x8 k1 = *(const bf16x8*)(Ks + (32 + r32) * KROW + (16 * s + 8 * hi) * 2);
    s0 = __builtin_amdgcn_mfma_f32_32x32x16_bf16(k0, qf[s], s0, 0, 0, 0);
    s1 = __builtin_amdgcn_mfma_f32_32x32x16_bf16(k1, qf[s], s1, 0, 0, 0);
  }
  if (BIAS) {
#pragma unroll
    for (int r = 0; r < 16; ++r) { s0[r] += bt[crow(r, hi) * 64]; s1[r] += bt[(32 + crow(r, hi)) * 64]; }
  }
  float mx = fmaxf(s0[0], s1[0]);
#pragma unroll
  for (int r = 1; r < 16; ++r) mx = fmaxf(mx, fmaxf(s0[r], s1[r]));
  mx = xhalf_max(mx);
  const float mn = fmaxf(m, mx), alpha = __builtin_amdgcn_exp2f(m - mn); m = mn;
  float ps = 0.f;
#pragma unroll
  for (int r = 0; r < 16; ++r) { s0[r] = __builtin_amdgcn_exp2f(s0[r] - mn); s1[r] = __builtin_amdgcn_exp2f(s1[r] - mn); ps += s0[r] + s1[r]; }
  ps = xhalf_sum(ps); l = l * alpha + ps;
#pragma unroll
  for (int r = 0; r < 16; ++r) { o0[r] *= alpha; o1[r] *= alpha; }
  pv_block(Vs, vb, s0, s1, o0, o1);
}
template <int DQK, bool BIAS, bool NOSHIFT = false, int QB = -1>
DEVI void flash_tile_shift(const char* Ks, const char* Vs, const bf16x8 (&qf)[DQK / 16], f32x16& o0, f32x16& o1, float& l, float negM, const f32x16& bi0, const f32x16& bi1, int r32, int hi, int vb) {
  constexpr int KROW = DQK * 2 + 16;
  f32x16 s0, s1;
#pragma unroll
  for (int r = 0; r < 16; ++r) { if (NOSHIFT) { s0[r] = BIAS ? bi0[r] : 0.f; s1[r] = BIAS ? bi1[r] : 0.f; } else { s0[r] = BIAS ? bi0[r] + negM : negM; s1[r] = BIAS ? bi1[r] + negM : negM; } }
#pragma unroll
  for (int s = 0; s < DQK / 16; ++s) {
    const bf16x8 k0 = *(const bf16x8*)(Ks + r32 * KROW + (16 * s + 8 * hi) * 2);
    const bf16x8 k1 = *(const bf16x8*)(Ks + (32 + r32) * KROW + (16 * s + 8 * hi) * 2);
    s0 = __builtin_amdgcn_mfma_f32_32x32x16_bf16(k0, qf[s], s0, 0, 0, 0);
    s1 = __builtin_amdgcn_mfma_f32_32x32x16_bf16(k1, qf[s], s1, 0, 0, 0);
  }
  float ps = 0.f;
#pragma unroll
  for (int r = 0; r < 16; ++r) {
    if (QB == 1 && r < 12) s0[r] = 0.f; else { s0[r] = __builtin_amdgcn_exp2f(s0[r]); ps += s0[r]; }
    if (QB == 0 && r >= 4) s1[r] = 0.f; else { s1[r] = __builtin_amdgcn_exp2f(s1[r]); ps += s1[r]; } }
  l += ps;
  if (QB == 0) pv_block_skip<false, true>(Vs, vb, s0, s1, o0, o1);
  else if (QB == 1) pv_block_skip<true, false>(Vs, vb, s0, s1, o0, o1);
  else pv_block(Vs, vb, s0, s1, o0, o1);
}
DEVI void flash_store(bf16_t* op, const f32x16& o0, const f32x16& o1, float l, int hi) {
  const float rl = 1.f / l;
#pragma unroll
  for (int g = 0; g < 4; ++g) {
    st4(op + 8 * g + 4 * hi, o0[4 * g] * rl, o0[4 * g + 1] * rl, o0[4 * g + 2] * rl, o0[4 * g + 3] * rl);
    st4(op + 32 + 8 * g + 4 * hi, o1[4 * g] * rl, o1[4 * g + 1] * rl, o1[4 * g + 2] * rl, o1[4 * g + 3] * rl); }
}

#define MLA_SB __builtin_amdgcn_sched_barrier(0)
template <int KN, int VC>
DEVI void mla_step(char* smem, const char* ws, unsigned& gk, unsigned& gv, unsigned& gh, unsigned sk, unsigned sh, int lk, int lv, int lh,
                   const bf16x8 (&qf)[6], f32x16& c0, f32x16& c1, f32x16& n0, f32x16& n1, f32x16& o0, f32x16& o1, float (&l4)[4], const f32x16& negMv, int koff, int vb,
                   u32x4& lrk, u32x4& lrv, uint2& lrh, const u32x4& rk, const u32x4& rv, const uint2& rh) {
  constexpr int KROW = 208, KBYTES = 64 * KROW, VOFF = 2 * KBYTES;
  const char* Kn = smem + KN * KBYTES + koff;
  const char* V0 = smem + VOFF + VC * 8192 + vb; const char* V1 = V0 + 4096;
  lrk = *(const u32x4*)(ws + gk); lrv = *(const u32x4*)(ws + gv); lrh = *(const uint2*)(ws + gh);
  gk += sk; gv += 64u * 1024u * 2u; gh += sh;
  bf16x8 kf[12], pf[4], vf[4], vg[4];
#define MLA_KLD(g) kf[g] = *(const bf16x8*)(Kn + ((g) & 1) * 32 * KROW + ((g) >> 1) * 32)
  MLA_KLD(0); MLA_KLD(1); MLA_KLD(2);
  MLA_SB;
  constexpr int ELO[13] = {0, 3, 6, 9, 10, 13, 16, 17, 20, 23, 24, 28, 32};
#pragma unroll
  for (int g = 0; g < 12; ++g) {
    if (g + 3 < 12) MLA_KLD(g + 3);
    if (g >= 8) vf[g - 8] = tr_pair(V0 + (g - 8) * 16 * 64);
    if ((g & 1) == 0) n0 = __builtin_amdgcn_mfma_f32_32x32x16_bf16(kf[g], qf[g >> 1], g < 2 ? negMv : n0, 0, 0, 0);
    else              n1 = __builtin_amdgcn_mfma_f32_32x32x16_bf16(kf[g], qf[g >> 1], g < 2 ? negMv : n1, 0, 0, 0);
    MLA_SB;
#pragma unroll
    for (int e = ELO[g]; e < ELO[g + 1]; ++e) { if (e < 16) c0[e] = __builtin_amdgcn_exp2f(c0[e]); else c1[e - 16] = __builtin_amdgcn_exp2f(c1[e - 16]); }
    if (g == 3) pf[0] = pack8(c0, 0);
    if (g == 6) pf[1] = pack8(c0, 8);
    if (g == 9) pf[2] = pack8(c1, 0);
    MLA_SB;
  }
#undef MLA_KLD
#pragma unroll
  for (int hh = 0; hh < 8; ++hh) {
    if (hh < 4) vg[hh] = tr_pair(V1 + hh * 16 * 64);
    if (hh < 4) o0 = __builtin_amdgcn_mfma_f32_32x32x16_bf16(vf[hh], pf[hh], o0, 0, 0, 0);
    else        o1 = __builtin_amdgcn_mfma_f32_32x32x16_bf16(vg[hh - 4], pf[hh - 4], o1, 0, 0, 0);
    MLA_SB;
    if (hh == 0) pf[3] = pack8(c1, 8);
#pragma unroll
    for (int e = 4 * hh; e < 4 * hh + 4; ++e) { const float pv_ = e < 16 ? c0[e] : c1[e - 16]; asm volatile("v_add_f32_e32 %0, %1, %0" : "+v"(l4[e & 3]) : "v"(pv_)); }
    if (hh == 5) *(u32x4*)(smem + (1 - KN) * KBYTES + lk) = rk;
    if (hh == 6) *(u32x4*)(smem + (1 - VC) * 8192 + lv) = rv;
    if (hh == 7) *(uint2*)(smem + (1 - KN) * KBYTES + lh) = rh;
    MLA_SB;
  }
  __syncthreads();
}

DEVI void mla_unit(const Params& p, int unit, char* smem) {
  constexpr int KROW = 208, KBYTES = 64 * KROW  , VOFF = 2 * KBYTES;
  const int t = threadIdx.x, lane = t & 63, w = t >> 6, r32 = lane & 31, hi = lane >> 5;
  const int qblk = unit & 31, h = (unit >> 5) & 7, b = unit >> 8;
  const char* ws = p.ws;
  const size_t qrow = (size_t)b * RB + CTXL + qblk * 256 + w * 32 + r32;
  bf16x8 qf[6];
  { const bf16_t* qp = (const bf16_t*)p.out + qrow * 768 + h * 96 + hi * 8;
#pragma unroll
    for (int s = 0; s < 6; ++s) qf[s] = *(const bf16x8*)(qp + 16 * s); }
  unsigned gk, gv, gh, sk, sh; int lk, lv, lh;
  { const int key = t / 12, ch = t - key * 12;
    if (ch < 8) { gk = (unsigned)OFF_KV + (unsigned)(((b * RB + key) * 1024 + h * 128 + ch * 8) * 2); sk = 64u * 1024u * 2u; }
    else { gk = (unsigned)OFF_KROPE + (unsigned)(((b * RB + key) * 32 + (ch - 8) * 8) * 2); sk = 64u * 32u * 2u; }
    lk = key * KROW + ch * 16; }
  { const int c = 512 + (t >> 1), key = c / 12, ch = c - key * 12, hf = t & 1;
    if (ch < 8) { gh = (unsigned)OFF_KV + (unsigned)(((b * RB + key) * 1024 + h * 128 + ch * 8 + hf * 4) * 2); sh = 64u * 1024u * 2u; }
    else { gh = (unsigned)OFF_KROPE + (unsigned)(((b * RB + key) * 32 + (ch - 8) * 8 + hf * 4) * 2); sh = 64u * 32u * 2u; }
    lh = key * KROW + ch * 16 + hf * 8; }
  { const int key = t >> 3, ch = t & 7; gv = (unsigned)OFF_KV + (unsigned)(((b * RB + key) * 1024 + h * 128 + 64 + ch * 8) * 2); lv = VOFF + (ch >> 2) * 4096 + key * 64 + (ch & 3) * 16; }
  const int vb = (((lane & 15) >> 2) + 4 * hi) * 64 + (16 * ((lane >> 4) & 1) + 4 * (lane & 3)) * 2;
  f32x16 o0, o1;
#pragma unroll
  for (int r = 0; r < 16; ++r) { o0[r] = 0.f; o1[r] = 0.f; }
  float q2 = 0.f;
#pragma unroll
  for (int s = 0; s < 6; ++s)
#pragma unroll
    for (int e = 0; e < 8; ++e) { const float x = bf2f((bf16_t)qf[s][e]); q2 = fmaf(x, x, q2); }
  q2 = xhalf_sum(q2);
  const float* kmw = (const float*)(ws + OFF_KMAX);
  const float Mq = 1.01f * sqrtf(q2 * (kmw[KM_KN + b * 16 + h * 2] + kmw[KM_KN + b * 16 + h * 2 + 1] + kmw[KM_KR + b]));
  bool shift_ok;
  { volatile __attribute__((address_space(3))) unsigned* vw = (volatile __attribute__((address_space(3))) unsigned*)(smem + SM_BARW) + 6;
    const bool bad_w = __any(!(Mq < 64.f));
    __syncthreads(); if (t == 0) *vw = 0u; __syncthreads(); if (bad_w && lane == 0) *vw = 1u; __syncthreads();
    shift_ok = __builtin_amdgcn_readfirstlane((int)*vw) == 0; }
  constexpr int NT = RB / 64;
  float l;
  { const u32x4 rk = *(const u32x4*)(ws + gk); const u32x4 rv = *(const u32x4*)(ws + gv); const uint2 rh = *(const uint2*)(ws + gh);
    gk += sk; gv += 64u * 1024u * 2u; gh += sh;
    __syncthreads();
    *(u32x4*)(smem + lk) = rk; *(u32x4*)(smem + lv) = rv; *(uint2*)(smem + lh) = rh; }
  if (shift_ok) {
    { const u32x4 rk = *(const u32x4*)(ws + gk); const uint2 rh = *(const uint2*)(ws + gh); gk += sk; gh += sh;
      *(u32x4*)(smem + KBYTES + lk) = rk; *(uint2*)(smem + KBYTES + lh) = rh; }
    __syncthreads();
    const int koff = r32 * KROW + hi * 16;
    f32x16 negMv;
#pragma unroll
    for (int r = 0; r < 16; ++r) negMv[r] = -Mq;
    f32x16 a0, a1, b0, b1;
    { const char* Kn = smem + koff;
#pragma unroll
      for (int s = 0; s < 6; ++s) {
        a0 = __builtin_amdgcn_mfma_f32_32x32x16_bf16(*(const bf16x8*)(Kn + s * 32), qf[s], s == 0 ? negMv : a0, 0, 0, 0);
        a1 = __builtin_amdgcn_mfma_f32_32x32x16_bf16(*(const bf16x8*)(Kn + 32 * KROW + s * 32), qf[s], s == 0 ? negMv : a1, 0, 0, 0); } }
    float l4[4] = {0.f, 0.f, 0.f, 0.f};
    u32x4 rkA, rvA, rkB, rvB; uint2 rhA, rhB;
    rkB = *(const u32x4*)(ws + gk); rvB = *(const u32x4*)(ws + gv); rhB = *(const uint2*)(ws + gh); gk += sk; gv += 64u * 1024u * 2u; gh += sh;
#pragma unroll 1
    for (int jj = 0; jj < NT / 2; ++jj) {
      mla_step<1, 0>(smem, ws, gk, gv, gh, sk, sh, lk, lv, lh, qf, a0, a1, b0, b1, o0, o1, l4, negMv, koff, vb, rkA, rvA, rhA, rkB, rvB, rhB);
      mla_step<0, 1>(smem, ws, gk, gv, gh, sk, sh, lk, lv, lh, qf, b0, b1, a0, a1, o0, o1, l4, negMv, koff, vb, rkB, rvB, rhB, rkA, rvA, rhA);
    }
    l = xhalf_sum((l4[0] + l4[1]) + (l4[2] + l4[3]));
  } else {
    __syncthreads();
    float m = -1e30f; l = 0.f;
#pragma unroll 1
    for (int j = 0; j < NT; ++j) {
      const u32x4 rk = *(const u32x4*)(ws + gk); const u32x4 rv = *(const u32x4*)(ws + gv); const uint2 rh = *(const uint2*)(ws + gh);
      gk += sk; gv += 64u * 1024u * 2u; gh += sh;
      flash_tile<96, false>(smem + (j & 1) * KBYTES, smem + VOFF + (j & 1) * 8192, qf, o0, o1, m, l, nullptr, r32, hi, vb);
      char* sw = smem + ((j + 1) & 1) * KBYTES; *(u32x4*)(sw + lk) = rk; *(uint2*)(sw + lh) = rh; *(u32x4*)(smem + ((j + 1) & 1) * 8192 + lv) = rv;
      __syncthreads();
    }
  }
  flash_store((bf16_t*)(ws + OFF_ATTN) + ((size_t)b * SEQ + qblk * 256 + w * 32 + r32) * 1024 + h * 64, o0, o1, l, hi);
}

template <bool BIAS>
DEVI void na_tile_max(const char* Ks, const char* Vs, const bf16x8 (&qf)[4], f32x16& o0, f32x16& o1, float& m, float& l, const f32x16& bi0, const f32x16& bi1, int r32, int hi, int vb) {
  constexpr int KROW = 144;
  f32x16 s0, s1;
#pragma unroll
  for (int r = 0; r < 16; ++r) { s0[r] = BIAS ? bi0[r] : 0.f; s1[r] = BIAS ? bi1[r] : 0.f; }
#pragma unroll
  for (int s = 0; s < 4; ++s) {
    const bf16x8 k0 = *(const bf16x8*)(Ks + r32 * KROW + (16 * s + 8 * hi) * 2), k1 = *(const bf16x8*)(Ks + (32 + r32) * KROW + (16 * s + 8 * hi) * 2);
    s0 = __builtin_amdgcn_mfma_f32_32x32x16_bf16(k0, qf[s], s0, 0, 0, 0); s1 = __builtin_amdgcn_mfma_f32_32x32x16_bf16(k1, qf[s], s1, 0, 0, 0);
  }
  float mx = fmaxf(s0[0], s1[0]);
#pragma unroll
  for (int r = 1; r < 16; ++r) mx = fmaxf(mx, fmaxf(s0[r], s1[r]));
  mx = xhalf_max(mx);
  const float mn = fmaxf(m, mx), alpha = __builtin_amdgcn_exp2f(m - mn); m = mn;
  float ps = 0.f;
#pragma unroll
  for (int r = 0; r < 16; ++r) { s0[r] = __builtin_amdgcn_exp2f(s0[r] - mn); s1[r] = __builtin_amdgcn_exp2f(s1[r] - mn); ps += s0[r] + s1[r]; }
  ps = xhalf_sum(ps); l = l * alpha + ps;
#pragma unroll
  for (int r = 0; r < 16; ++r) { o0[r] *= alpha; o1[r] *= alpha; }
  pv_block(Vs, vb, s0, s1, o0, o1);
}

DEVI void na_unit(const Params& p, int unit, char* smem) {
  constexpr int KROW = 144, KBYTES = 64 * KROW  , STAGE = KBYTES + 8192  ;
  const int t = threadIdx.x, lane = t & 63, w = t >> 6, r32 = lane & 31, hi = lane >> 5;
  const int head = unit & 7, rq = (unit >> 3) & 31, b = unit >> 8;
  const int rr = w >> 1, qb = w & 1, grow = rq * 4 + rr, c = qb * 32 + r32;
  int wstart = grow - 4; wstart = wstart < 0 ? 0 : (wstart > 120 ? 120 : wstart);
  int klo = rq * 4 - 4; klo = klo < 0 ? 0 : (klo > 120 ? 120 : klo);
  int khi = rq * 4 - 1; khi = (khi < 0 ? 0 : (khi > 120 ? 120 : khi)) + 8;
  const int ntw = khi - klo, ntt = ntw + 4;
  const char* ws = p.ws;
  const bf16_t* nak = (const bf16_t*)(ws + OFF_NAK) + (size_t)b * RB * 512 + head * 64;
  const bf16_t* nav = (const bf16_t*)(ws + OFF_NAV) + (size_t)b * RB * 512 + head * 64;
  bf16x8 qf[4];
  { const bf16_t* qp = (const bf16_t*)(ws + OFF_NAQ) + ((size_t)b * RB + CTXL + grow * 64 + c) * 512 + head * 64 + hi * 8;
#pragma unroll
    for (int s = 0; s < 4; ++s) qf[s] = *(const bf16x8*)(qp + 16 * s); }
  const int skey = t >> 3, sch = t & 7;
  const int goff0 = skey * 512 + sch * 8, kdst0 = skey * KROW + sch * 16, vdst0 = KBYTES + (sch >> 2) * 4096 + skey * 64 + (sch & 3) * 16;
  const int vb = (((lane & 15) >> 2) + 4 * hi) * 64 + (16 * ((lane >> 4) & 1) + 4 * (lane & 3)) * 2;
  f32x16 o0, o1;
#pragma unroll
  for (int r = 0; r < 16; ++r) { o0[r] = 0.f; o1[r] = 0.f; }
  float m = -1e30f, l = 0.f;
  const unsigned* btb = (const unsigned*)(ws + OFF_BT) + (size_t)(head * 15) * 2048 + c;
  float q2 = 0.f;
#pragma unroll
  for (int s = 0; s < 4; ++s)
#pragma unroll
    for (int e = 0; e < 8; ++e) { const float x = bf2f((bf16_t)qf[s][e]); q2 = fmaf(x, x, q2); }
  q2 = xhalf_sum(q2);
  const float* kmw = (const float*)(ws + OFF_KMAX);
  const float Mq = 1.01f * sqrtf(q2 * (kmw[KM_NA + b * 16 + head * 2] + kmw[KM_NA + b * 16 + head * 2 + 1])) + kmw[KM_BM + head];
  const bool shift_ok = !__any(!(Mq < 64.f));
  u32x4 rk, rv;
  auto rowbase = [&](int j) -> size_t { return j < ntw ? (size_t)CTXL + (size_t)(klo + j) * 64 : (size_t)(j - ntw) * 64; };
#define NA_STAGE_LOAD(J) { const size_t rb1 = rowbase(J) * 512 + goff0; rk = *(const u32x4*)(nak + rb1); rv = *(const u32x4*)(nav + rb1); }
#define NA_STAGE_WRITE(J) { char* sw = smem + ((J) & 1) * STAGE; *(u32x4*)(sw + kdst0) = rk; *(u32x4*)(sw + vdst0) = rv; }
  NA_STAGE_LOAD(0)
  __syncthreads();
  NA_STAGE_WRITE(0)
  __syncthreads();
  unsigned bp[16];
#define NA_BIAS_LOAD(J) { const int kr_ = klo + (J); if ((J) < ntw && kr_ >= wstart && kr_ < wstart + 8) { const unsigned* bt = btb + (size_t)(kr_ - grow + 7) * 2048; \
      _Pragma("unroll") for (int r = 0; r < 16; ++r) bp[r] = bt[crow(r, hi) * 64]; } }
#define NA_TILE_LOOP(WIN_CALL, CTX_CALL)                                                                                                       \
  NA_BIAS_LOAD(0)                                                                                                                                \
  _Pragma("unroll 1") for (int j = 0; j < ntt; ++j) {                                                                                            \
    const char* st = smem + (j & 1) * STAGE;                                                                                                     \
    const int kr = klo + j; const bool win = j < ntw; const bool active = !win || (kr >= wstart && kr < wstart + 8);           \
    f32x16 bc0, bc1;                                                                                                                             \
    if (win && active) { _Pragma("unroll") for (int r = 0; r < 16; ++r) { bc0[r] = __uint_as_float(bp[r] << 16); bc1[r] = __uint_as_float(bp[r] & 0xffff0000u); } } \
    __builtin_amdgcn_sched_barrier(0);                                                                                                           \
    NA_BIAS_LOAD(j + 1)                                                 \
    __builtin_amdgcn_sched_barrier(0);                                                                                                           \
    if (j + 1 < ntt) NA_STAGE_LOAD(j + 1)                                                                                                        \
    __builtin_amdgcn_sched_barrier(0);                                                                                                           \
    if (active) { if (win) { WIN_CALL; } else { CTX_CALL; } }                                                                                    \
    if (j + 1 < ntt) NA_STAGE_WRITE(j + 1)                                                                                                       \
    __syncthreads();                                                                                                                             \
  }
  if (shift_ok) { if (qb == 0) { NA_TILE_LOOP((flash_tile_shift<64, true, true, 0>(st, st + KBYTES, qf, o0, o1, l, 0.f, bc0, bc1, r32, hi, vb)), (flash_tile_shift<64, false, true>(st, st + KBYTES, qf, o0, o1, l, 0.f, bc0, bc1, r32, hi, vb))) }
    else { NA_TILE_LOOP((flash_tile_shift<64, true, true, 1>(st, st + KBYTES, qf, o0, o1, l, 0.f, bc0, bc1, r32, hi, vb)), (flash_tile_shift<64, false, true>(st, st + KBYTES, qf, o0, o1, l, 0.f, bc0, bc1, r32, hi, vb))) } }
  else { NA_TILE_LOOP((na_tile_max<true>(st, st + KBYTES, qf, o0, o1, m, l, bc0, bc1, r32, hi, vb)), (na_tile_max<false>(st, st + KBYTES, qf, o0, o1, m, l, bc0, bc1, r32, hi, vb))) }
#undef NA_TILE_LOOP
#undef NA_BIAS_LOAD
#undef NA_STAGE_LOAD
#undef NA_STAGE_WRITE
  if (shift_ok) l = xhalf_sum(l);
  flash_store((bf16_t*)(ws + OFF_ATTN) + ((size_t)b * SEQ + grow * 64 + c) * 1024 + 512 + head * 64, o0, o1, l, hi);
}

DEVI void phase_E(const Params& p, int bid, int nb, char* smem) {
  constexpr int UM = NBATCH * 8 * 32, UN = NBATCH * 32 * 8;
  { const int iters = xcd_iters(UM, nb);
    for (int it = 0; it < iters; ++it) { const int u = xcd_unit(bid + it * nb, UM); if (u >= 0) mla_unit(p, u, smem); } }
#if TIMING_PROBE
  if (blockIdx.x == 0 && threadIdx.x == 0) ((unsigned long long*)(p.ws + OFF_CNT + 64))[11] = __builtin_amdgcn_s_memrealtime();
#endif
  { const int iters = xcd_iters(UN, nb);
    for (int it = 0; it < iters; ++it) { const int u = xcd_unit(bid + it * nb, UN); if (u >= 0) na_unit(p, u, smem); } }
#if TIMING_PROBE
  if (blockIdx.x == 0 && threadIdx.x == 0) ((unsigned long long*)(p.ws + OFF_CNT + 64))[12] = __builtin_amdgcn_s_memrealtime();
#endif
}

DEVI void wave_reduce40(float (&v)[40], int lane) {
  { const bool b = lane & 32;
#pragma unroll
    for (int i = 0; i < 20; ++i) { const float keep = b ? v[i + 20] : v[i], send = b ? v[i] : v[i + 20]; v[i] = keep + __shfl_xor(send, 32); } }
  { const bool b = lane & 16;
#pragma unroll
    for (int i = 0; i < 10; ++i) { const float keep = b ? v[i + 10] : v[i], send = b ? v[i] : v[i + 10]; v[i] = keep + __shfl_xor(send, 16); } }
  { const bool b = lane & 8;
#pragma unroll
    for (int i = 0; i < 5; ++i) { const float keep = b ? v[i + 5] : v[i], send = b ? v[i] : v[i + 5]; v[i] = keep + __shfl_xor(send, 8); } }
  { const bool b = lane & 4;
#pragma unroll
    for (int i = 0; i < 3; ++i) { const float hi_ = i + 3 < 5 ? v[i + 3] : 0.f; const float keep = b ? hi_ : v[i], send = b ? v[i] : hi_; v[i] = keep + __shfl_xor(send, 4); } }
  { const bool b = lane & 2;
#pragma unroll
    for (int i = 0; i < 2; ++i) { const float hi_ = i + 2 < 3 ? v[i + 2] : 0.f; const float keep = b ? hi_ : v[i], send = b ? v[i] : hi_; v[i] = keep + __shfl_xor(send, 2); } }
  { const bool b = lane & 1;
    const float keep = b ? v[1] : v[0], send = b ? v[0] : v[1]; v[0] = keep + __shfl_xor(send, 1); }
}
template <int IDX> DEVI float reduce40_get(float v0) {
  constexpr int k = IDX % 5, low3 = k < 3 ? k : k + 1;
  constexpr int src = (IDX / 20) * 32 + ((IDX % 20) / 10) * 16 + ((IDX % 10) / 5) * 8 + low3;
  return __builtin_bit_cast(float, __builtin_amdgcn_readlane(__builtin_bit_cast(int, v0), src));
}
DEVI void route_token(const float (&lg)[20], int tl, int lane, int* te, float* tw) {
  int gs = 0; float gm = lg[0];
#pragma unroll
  for (int j = 1; j < 4; ++j) if (lg[j] > gm) { gm = lg[j]; gs = j; }
  float z = 0.f;
#pragma unroll
  for (int j = 0; j < 4; ++j) z += expf(lg[j] - gm);
  const float gw = 1.f / z;
  const float c0 = gs == 0 ? 1.f : 0.f, c1 = gs == 1 ? 1.f : 0.f, c2 = gs == 2 ? 1.f : 0.f, c3 = gs == 3 ? 1.f : 0.f;
  float e4[4];
#pragma unroll
  for (int j = 0; j < 4; ++j) e4[j] = c0 * lg[4 + j] + c1 * lg[8 + j] + c2 * lg[12 + j] + c3 * lg[16 + j];
  int i1 = 0; float m1 = e4[0];
#pragma unroll
  for (int j = 1; j < 4; ++j) if (e4[j] > m1) { m1 = e4[j]; i1 = j; }
  int i2 = -1; float m2 = -3.0e38f;
#pragma unroll
  for (int j = 0; j < 4; ++j) if (j != i1 && e4[j] > m2) { m2 = e4[j]; i2 = j; }
  const float ex = expf(m2 - m1), w1 = 1.f / (1.f + ex), w2 = ex / (1.f + ex);
  if (lane == 0) { te[tl * 2] = gs * 4 + i1; te[tl * 2 + 1] = gs * 4 + i2; tw[tl * 2] = gw * w1; tw[tl * 2 + 1] = gw * w2; }
}
DEVI void phase_G(const Params& p, int bid, int nb, char* smem) {
  int t = threadIdx.x; asm volatile("" : "+v"(t));
  const int lane = t & 63, wv = t >> 6;
  int* te = (int*)smem; float* tw = (float*)(smem + 256);
  const float* mod = (const float*)(p.ws + OFF_MOD); act_t* hx2 = (act_t*)(p.ws + OFF_HX2);
  const float* wrt = (const float*)(smem + 1024);
  { const f32x4* src = (const f32x4*)(p.ws + OFF_WRT); f32x4* dst = (f32x4*)(smem + 1024);
    __syncthreads();
#pragma unroll
    for (int i = 0; i < 10; ++i) dst[t + 512 * i] = src[t + 512 * i];
    __syncthreads(); }
  int* cnt = (int*)(p.ws + OFF_CNT); int* elist = (int*)(p.ws + OFF_ELIST); float* ewt = (float*)(p.ws + OFF_EW);
  for (int ch = bid; ch < TT / 32; ch += nb) {
    __syncthreads();
    const int b = (ch * 32) >> 13; const float* sh = mod + b * 6144 + 3072; const float* sc = sh + 1024;
#pragma unroll 1
    for (int q = 0; q < 4; q += 2) {
      const int tl = wv * 4 + q, tok = ch * 32 + tl;
      const act_t* xa = (const act_t*)(p.ws + OFF_X1) + (size_t)tok * 1024 + lane * 4; const act_t* xb = xa + 1024;
      float sa = 0.f, sb = 0.f;
      { float va[4][4], vb[4][4];
#pragma unroll
        for (int i = 0; i < 4; ++i) { ld4(xa + 256 * i, va[i]); ld4(xb + 256 * i, vb[i]); }
#pragma unroll
        for (int i = 0; i < 4; ++i) { sa += va[i][0] * va[i][0] + va[i][1] * va[i][1] + va[i][2] * va[i][2] + va[i][3] * va[i][3]; sb += vb[i][0] * vb[i][0] + vb[i][1] * vb[i][1] + vb[i][2] * vb[i][2] + vb[i][3] * vb[i][3]; } }
      sa = wave_sum(sa); sb = wave_sum(sb);
      const float ra = rsqrtf(sa * (1.f / 1024.f) + EPS), rb = rsqrtf(sb * (1.f / 1024.f) + EPS);
      float la[20], lb[20];
#pragma unroll
      for (int j = 0; j < 20; ++j) { la[j] = 0.f; lb[j] = 0.f; }
#pragma unroll 1
      for (int i = 0; i < 4; ++i) {
        const int k = lane * 4 + 256 * i;
        float4 va, vb; { float ta[4], tb[4]; ld4(xa + 256 * i, ta); ld4(xb + 256 * i, tb); va = make_float4(ta[0], ta[1], ta[2], ta[3]); vb = make_float4(tb[0], tb[1], tb[2], tb[3]); }
        const float4 g = *(const float4*)(p.g_ffn + k), s1 = *(const float4*)(sc + k), s0 = *(const float4*)(sh + k);
        const float gx = g.x * (1.f + s1.x), gy = g.y * (1.f + s1.y), gz = g.z * (1.f + s1.z), gw = g.w * (1.f + s1.w);
        const float4 ha = make_float4(va.x * ra * gx + s0.x, va.y * ra * gy + s0.y, va.z * ra * gz + s0.z, va.w * ra * gw + s0.w);
        const float4 hb = make_float4(vb.x * rb * gx + s0.x, vb.y * rb * gy + s0.y, vb.z * rb * gz + s0.z, vb.w * rb * gw + s0.w);
        st4(hx2 + (size_t)tok * 1024 + k, ha.x, ha.y, ha.z, ha.w); st4(hx2 + (size_t)(tok + 1) * 1024 + k, hb.x, hb.y, hb.z, hb.w);
        const float* wk = wrt + k;
#pragma unroll
        for (int jg = 0; jg < 20; jg += 10) {
          float4 w[10];
#pragma unroll
          for (int u = 0; u < 10; ++u) w[u] = *(const float4*)(wk + (jg + u) * 1024);
#pragma unroll
          for (int u = 0; u < 10; ++u) {
            la[jg + u] = fmaf(ha.x, w[u].x, fmaf(ha.y, w[u].y, fmaf(ha.z, w[u].z, fmaf(ha.w, w[u].w, la[jg + u]))));
            lb[jg + u] = fmaf(hb.x, w[u].x, fmaf(hb.y, w[u].y, fmaf(hb.z, w[u].z, fmaf(hb.w, w[u].w, lb[jg + u])))); }
        }
      }
      { float v40[40];
#pragma unroll
        for (int j = 0; j < 20; ++j) { v40[j] = la[j]; v40[20 + j] = lb[j]; }
        wave_reduce40(v40, lane);
        const float r0 = v40[0];
#define G_GET(J) la[J] = reduce40_get<J>(r0); lb[J] = reduce40_get<20 + J>(r0);
        G_GET(0) G_GET(1) G_GET(2) G_GET(3) G_GET(4) G_GET(5) G_GET(6) G_GET(7) G_GET(8) G_GET(9) G_GET(10) G_GET(11) G_GET(12) G_GET(13) G_GET(14) G_GET(15) G_GET(16) G_GET(17) G_GET(18) G_GET(19)
#undef G_GET
      }
#pragma unroll
      for (int j = 0; j < 4; ++j) { la[j] += p.b_rg[j]; lb[j] += p.b_rg[j]; }
#pragma unroll
      for (int j = 0; j < 16; ++j) { la[4 + j] += p.b_re[j]; lb[4 + j] += p.b_re[j]; }
      route_token(la, tl, lane, te, tw); route_token(lb, tl + 1, lane, te, tw);
    }
    __syncthreads();
    if (wv == 0) {
      const int my_e = te[lane]; const float my_w = tw[lane];
      unsigned long long me_mask = 0ull; int my_n = 0;
#pragma unroll
      for (int e = 0; e < 16; ++e) { const unsigned long long mk = __ballot(my_e == e); if (my_e == e) me_mask = mk; if (lane == e) my_n = __popcll(mk); }
      int base = 0; if (lane < 16 && my_n) base = atomicAdd(&cnt[lane], my_n);
      const int my_base = __shfl(base, my_e);
      const int rank = __popcll(me_mask & ((1ull << lane) - 1ull));
      const int slot = my_base + rank;
      elist[(size_t)my_e * TT + slot] = (ch * 32 + (lane >> 1)) * 2 + (lane & 1); ewt[(size_t)my_e * TT + slot] = my_w;
    }
  }
}

DEVI void phase_J(const Params& p, int bid, int nb) {
  int tx = threadIdx.x; asm volatile("" : "+v"(tx));
  const int lane = tx & 63, wv = tx >> 6;
  const float* mod = (const float*)(p.ws + OFF_MOD); const act_t* yb = (const act_t*)(p.ws + OFF_YBUF);
  for (int tok0 = (bid * NWAVES + wv) * 4; tok0 < TT; tok0 += nb * NWAVES * 4) {
    const int b = tok0 >> 13; const float* g2 = mod + b * 6144 + 5120;
    float4 xv[4][4]; float y0[4][4][4], y1[4][4][4];
#pragma unroll
    for (int q = 0; q < 4; ++q)
#pragma unroll
      for (int i = 0; i < 4; ++i) { const int k = lane * 4 + 256 * i; { float tx4[4]; ld4((const act_t*)(p.ws + OFF_X1) + (size_t)(tok0 + q) * 1024 + k, tx4); xv[q][i] = make_float4(tx4[0], tx4[1], tx4[2], tx4[3]); }
        ld4(yb + (size_t)(tok0 + q) * 1024 + k, y0[q][i]); ld4(yb + ((size_t)TT + tok0 + q) * 1024 + k, y1[q][i]); }
#pragma unroll
    for (int q = 0; q < 4; ++q) {
      float* xo = p.out + (size_t)(tok0 + q) * 1024; float o[16]; float ss = 0.f;
#pragma unroll
      for (int i = 0; i < 4; ++i) { const int k = lane * 4 + 256 * i; const float4 g = *(const float4*)(g2 + k);
        o[4 * i] = xv[q][i].x + g.x * (y0[q][i][0] + y1[q][i][0]); o[4 * i + 1] = xv[q][i].y + g.y * (y0[q][i][1] + y1[q][i][1]);
        o[4 * i + 2] = xv[q][i].z + g.z * (y0[q][i][2] + y1[q][i][2]); o[4 * i + 3] = xv[q][i].w + g.w * (y0[q][i][3] + y1[q][i][3]);
        ss += o[4 * i] * o[4 * i] + o[4 * i + 1] * o[4 * i + 1] + o[4 * i + 2] * o[4 * i + 2] + o[4 * i + 3] * o[4 * i + 3]; }
      ss = wave_sum(ss); const float rstd = rsqrtf(ss * (1.f / 1024.f) + EPS);
#pragma unroll
      for (int i = 0; i < 4; ++i) { const int k = lane * 4 + 256 * i; const float4 g = *(const float4*)(p.g_final + k);
        *(float4*)(xo + k) = make_float4(o[4 * i] * rstd * g.x, o[4 * i + 1] * rstd * g.y, o[4 * i + 2] * rstd * g.z, o[4 * i + 3] * rstd * g.w); }
    }
  }
}

#if ONE_LAUNCH
#define XB_TMO      128
#define XB_XCNT(j)  (256  + 64 * (j))
#define XB_XSUB(j)  (1280 + 64 * (j))
#define XB_XGEN(j)  (2304 + 64 * (j))
#define XB_TOP      3328
#define XB_TOPGEN   3392
#define XCD_BAR_WORDS 3456
#define XB_SPIN_CAP (1u << 20)
#define LAS __attribute__((address_space(3)))
DEVI unsigned xb_ld(unsigned* p)              { return __hip_atomic_load(p, __ATOMIC_RELAXED, __HIP_MEMORY_SCOPE_AGENT); }
DEVI unsigned xb_add(unsigned* p, unsigned v) { return __hip_atomic_fetch_add(p, v, __ATOMIC_RELAXED, __HIP_MEMORY_SCOPE_AGENT); }
DEVI unsigned xb_xcc_id() { return (unsigned)__builtin_amdgcn_s_getreg((3 << 11) | 20) & 0xFu; }
#define XB_SPIN(cond, bar) do { unsigned _sp = 0; while (cond) { __builtin_amdgcn_s_sleep(1); \
    if ((++_sp & 255u) == 0u) { if (xb_ld(&(bar)[XB_TMO])) break; if (_sp > XB_SPIN_CAP) { atomicAdd(&(bar)[XB_TMO], 1u); break; } } } } while (0)
struct XcdBarrier { unsigned* bar; unsigned x; volatile LAS unsigned* st; };
DEVI XcdBarrier xcd_barrier_post(unsigned* bar, volatile LAS unsigned* st) {
  XcdBarrier b; b.bar = bar; b.x = xb_xcc_id(); b.st = st;
  if (threadIdx.x == 0) st[2] = xb_add(&bar[XB_XCNT(b.x)], 1u);
  return b;
}
DEVI void xcd_barrier_complete(unsigned* bar, unsigned x, unsigned& nloc, unsigned& nx) {
  const unsigned G = gridDim.x * gridDim.y * gridDim.z;
  unsigned sum, cnt, mine, sp = 0u;
  for (;;) {
    sum = 0u; cnt = 0u; mine = 0u;
#pragma unroll
    for (unsigned j = 0; j < 16; ++j) { const unsigned c = xb_ld(&bar[XB_XCNT(j)]); sum += c; cnt += (c > 0u) ? 1u : 0u; mine = (j == x) ? c : mine; }
    if (sum == G) break;
    __builtin_amdgcn_s_sleep(1);
    if ((++sp & 255u) == 0u) { if (xb_ld(&bar[XB_TMO])) break; if (sp > XB_SPIN_CAP) { atomicAdd(&bar[XB_TMO], 1u); break; } }
  }
  nloc = mine > 0u ? mine : 1u; nx = cnt > 0u ? cnt : 1u;
}
DEVI void xcd_barrier(const XcdBarrier& b) {
  asm volatile("s_waitcnt vmcnt(0)" ::: "memory");
  __syncthreads();
  if (threadIdx.x == 0) {
    unsigned* bar = b.bar;
    __builtin_amdgcn_s_waitcnt(0);
    unsigned nloc = b.st[0], nx = b.st[1];
    if (nloc == 0u) { xcd_barrier_complete(bar, b.x, nloc, nx); b.st[0] = nloc; b.st[1] = nx; }
    const unsigned old = xb_add(&bar[XB_XSUB(b.x)], 1u);
    const unsigned gen = old / nloc;
    if (old + 1u == (gen + 1u) * nloc) {
      __builtin_amdgcn_fence(__ATOMIC_RELEASE, "agent");
      asm volatile("s_waitcnt vmcnt(0)" ::: "memory");
      const unsigned og = xb_add(&bar[XB_TOP], 1u);
      const unsigned tg = og / nx;
      if (og + 1u == (tg + 1u) * nx) xb_add(&bar[XB_TOPGEN], 1u);
      else XB_SPIN(xb_ld(&bar[XB_TOPGEN]) == tg, bar);
      __builtin_amdgcn_fence(__ATOMIC_ACQUIRE, "agent");
      xb_add(&bar[XB_XGEN(b.x)], 1u);
      asm volatile("s_waitcnt vmcnt(0)" ::: "memory");
    } else {
      XB_SPIN(xb_ld(&bar[XB_XGEN(b.x)]) == gen, bar);
      __builtin_amdgcn_fence(__ATOMIC_ACQUIRE, "agent");
      asm volatile("s_waitcnt vmcnt(0)" ::: "memory");
    }
  }
  __syncthreads();
}

DEVI const float* lds_ptr(const char* smem, int i) { const unsigned* t = (const unsigned*)(smem + SM_PTR) + 2 * i;
  const unsigned lo = __builtin_amdgcn_readfirstlane(t[0]), hi = __builtin_amdgcn_readfirstlane(t[1]);
  typedef const float __attribute__((address_space(1))) gfloat; return (const float*)(gfloat*)(((unsigned long long)hi << 32) | lo); }
DEVI Params load_params(const char* smem) {
  Params q;
  q.x = lds_ptr(smem, 0); q.c = lds_ptr(smem, 1); q.ctx = lds_ptr(smem, 2); q.c_ctx = lds_ptr(smem, 3); q.w_mod = lds_ptr(smem, 4); q.b_mod = lds_ptr(smem, 5);
  q.g_attn = lds_ptr(smem, 6); q.g_ffn = lds_ptr(smem, 7); q.w_in = lds_ptr(smem, 8); q.g_q = lds_ptr(smem, 9); q.g_kv = lds_ptr(smem, 10); q.w_uq = lds_ptr(smem, 11);
  q.w_ukv = lds_ptr(smem, 12); q.rel_bias = lds_ptr(smem, 13); q.w_out = lds_ptr(smem, 14); q.w_rg = lds_ptr(smem, 15); q.b_rg = lds_ptr(smem, 16); q.w_re = lds_ptr(smem, 17);
  q.b_re = lds_ptr(smem, 18); q.w_gate = lds_ptr(smem, 19); q.w_up = lds_ptr(smem, 20); q.w_down = lds_ptr(smem, 21); q.g_final = lds_ptr(smem, 22);
  q.out = (float*)lds_ptr(smem, 23); q.ws = (char*)lds_ptr(smem, 24);
  return q;
}
DEVI XcdBarrier xb_reload(char* smem) { XcdBarrier b; b.bar = (unsigned*)((char*)lds_ptr(smem, 24) + OFF_BAR); b.st = (volatile LAS unsigned*)(smem + SM_BARW);
  b.x = (unsigned)__builtin_amdgcn_readfirstlane((int)b.st[4]); return b; }
#define GRID_BARRIER() do { const XcdBarrier _xb = xb_reload(smem); xcd_barrier(_xb); } while (0)
#define VBID() __builtin_amdgcn_readfirstlane((int)((volatile LAS unsigned*)(smem + SM_BARW))[3])
#define TS(i) do { if (TIMING_PROBE && blockIdx.x == 0 && threadIdx.x == 0) ((unsigned long long*)(pk.ws + OFF_CNT + 64))[i] = __builtin_amdgcn_s_memrealtime(); } while (0)
#ifndef REPEAT_MASK
#define REPEAT_MASK 0
#endif
#define REP(i) _Pragma("nounroll") for (int _r = 0; _r < ((PHASE_ONLY >= 0 && PHASE_ONLY != (i)) ? 0 : (((REPEAT_MASK >> (i)) & 1) ? 2 : 1)); ++_r)

__global__ void __launch_bounds__(NTHREADS, 2) mega_kernel(Params pk) {
  __shared__ __attribute__((aligned(16))) char smem[LDS_TOTAL];
  const int nb = gridDim.x;
  if (threadIdx.x == 0) { *(uint4*)(smem + SM_BARW) = make_uint4(0u, 0u, 0u, (unsigned)blockIdx.x); *(uint4*)(smem + SM_BARW + 16) = make_uint4(0u, 0u, 0u, 0u); }
  if (threadIdx.x < 25) ((unsigned long long*)(smem + SM_PTR))[threadIdx.x] = ((const unsigned long long*)&pk)[threadIdx.x];
  __syncthreads();
  { const XcdBarrier xb0 = xcd_barrier_post((unsigned*)(pk.ws + OFF_BAR), (volatile LAS unsigned*)(smem + SM_BARW));
    if (threadIdx.x == 0) ((volatile LAS unsigned*)(smem + SM_BARW))[4] = xb0.x; }
  __syncthreads();
  TS(0);
  REP(0) { const Params p = load_params(smem); phase_A(p, (int)blockIdx.x, nb, smem); GRID_BARRIER(); }
  TS(1);
  { volatile LAS unsigned* st = (volatile LAS unsigned*)(smem + SM_BARW);
    if (threadIdx.x == 0) { unsigned* bar = (unsigned*)(pk.ws + OFF_BAR); bool even = (nb % 8) == 0;
      for (unsigned j = 0; j < 16; ++j) { const unsigned c = xb_ld(&bar[XB_XCNT(j)]); even = even && (c == (j < 8 ? (unsigned)nb / 8u : 0u)); }
      st[3] = even ? st[2] * 8u + st[4] : (unsigned)blockIdx.x; }
    __syncthreads(); }
  REP(1) { const Params p = load_params(smem); const int bid = VBID(); phase_B(p, bid, nb); GRID_BARRIER(); }
  TS(2);
  REP(2) { { const Params p = load_params(smem); const int bid = VBID(); phase_C(p, bid, nb, smem); }
    { const Params p = load_params(smem); conv_queue(p, smem, 1, NCONV_A, NCONV_C); }
    GRID_BARRIER(); }
  TS(3);
  REP(3) { const Params p = load_params(smem); const int bid = VBID(); phase_D(p, bid, nb, smem); GRID_BARRIER(); }
  TS(4);
  REP(4) { { const Params p = load_params(smem); const int bid = VBID(); phase_E(p, bid, nb, smem); }
    { const Params p = load_params(smem); conv_queue(p, smem, 3, NCONV_C, NCONV_E); }
    GRID_BARRIER(); }
  TS(5);
  REP(5) { const Params p = load_params(smem); const int bid = VBID(); phase_F(p, bid, nb, smem); GRID_BARRIER(); }
  TS(6);
  REP(6) { const Params p = load_params(smem); const int bid = VBID(); phase_G(p, bid, nb, smem); GRID_BARRIER(); }
  TS(7);
  REP(7) { { const Params p = load_params(smem); const int bid = VBID(); phase_H(p, bid, nb, smem); }
    { const Params p = load_params(smem); conv_queue(p, smem, 2, NCONV_E, NCONV); }
    GRID_BARRIER(); }
  TS(8);
  REP(8) { const Params p = load_params(smem); const int bid = VBID(); phase_I(p, bid, nb, smem); GRID_BARRIER(); }
  TS(9);
  REP(9) { const Params p = load_params(smem); const int bid = VBID(); phase_J(p, bid, nb); }
#if TIMING_PROBE
  GRID_BARRIER(); TS(10);
  if (blockIdx.x == 0 && threadIdx.x < 64) {
    const int lane = threadIdx.x;
    const unsigned long long* ts = (const unsigned long long*)(pk.ws + OFF_CNT + 64); float ta = 0.f, tr = 0.f;
#pragma unroll
    for (int qq = 0; qq < 10; ++qq) { const float d = (float)(unsigned)(ts[qq + 1] - ts[qq]) * 0.01f; if ((PROBE_A_MASK >> qq) & 1) ta += d; if ((PROBE_R_MASK >> qq) & 1) tr += d; }
    if ((PROBE_A_MASK >> 10) & 1) ta += (float)(unsigned)(ts[11] - ts[4]) * 0.01f;
    if ((PROBE_R_MASK >> 11) & 1) tr += (float)(unsigned)(ts[12] - ts[11]) * 0.01f;
    if ((PROBE_A_MASK >> 12) & 1) ta += (float)(unsigned)(ts[5] - ts[12]) * 0.01f;
    if (lane == 0) pk.out[0] += 1.f + ta * 0.01f;
    { float4* o4 = (float4*)(pk.out + 1024 + lane * 16);
#pragma unroll
      for (int i = 0; i < 4; ++i) { float4 v = o4[i]; v.x += tr * PROBE_R_SCALE; v.y += tr * PROBE_R_SCALE; v.z += tr * PROBE_R_SCALE; v.w += tr * PROBE_R_SCALE; o4[i] = v; } }
  }
#endif
}
#endif

extern "C" void kernel_launch(void* const* d_in, const int* in_sizes, int n_in, void* d_out, int out_size, void* d_ws, size_t ws_size, hipStream_t stream) {
  if (n_in != 23 || out_size != TT * 1024 || ws_size < WS_NEED) { fprintf(stderr, "kernel_launch: unexpected shapes n_in %d out %d ws %zu (need %zu)\n", n_in, out_size, ws_size, (size_t)WS_NEED); return; }
  Params p{};
  const float** f = (const float**)&p;
  for (int i = 0; i < 23; ++i) f[i] = (const float*)d_in[i];
  p.out = (float*)d_out; p.ws = (char*)d_ws;
#if ONE_LAUNCH
  static int grid_blocks = 0;
  if (!grid_blocks) {
    int dev = 0, cus = 0, per_cu = 0;
    hipGetDevice(&dev);
    hipDeviceGetAttribute(&cus, hipDeviceAttributeMultiprocessorCount, dev);
    hipOccupancyMaxActiveBlocksPerMultiprocessor(&per_cu, mega_kernel, NTHREADS, 0);
    if (per_cu > 1) per_cu = 1;
    grid_blocks = cus * per_cu;
    if (grid_blocks <= 0) { fprintf(stderr, "kernel_launch: occupancy query failed (cus %d per_cu %d)\n", cus, per_cu); grid_blocks = 0; return; }
  }
  if (hipMemsetAsync((char*)d_ws + OFF_BAR, 0, 16384, stream) != hipSuccess) { fprintf(stderr, "kernel_launch: memset of barrier words failed\n"); return; }
  hipLaunchKernelGGL(mega_kernel, dim3(grid_blocks), dim3(NTHREADS), 0, stream, p);
  const hipError_t e = hipPeekAtLastError();
  if (e != hipSuccess) fprintf(stderr, "kernel_launch: launch failed: %s (grid %d)\n", hipGetErrorString(e), grid_blocks);
#else
  const int G = 1024;
  hipLaunchKernelGGL(phase_kernel<0>, dim3(G), dim3(NTHREADS), 0, stream, p);
  hipLaunchKernelGGL(phase_kernel<1>, dim3(G), dim3(NTHREADS), 0, stream, p);
  hipLaunchKernelGGL(phase_kernel<2>, dim3(G), dim3(NTHREADS), 0, stream, p);
  hipLaunchKernelGGL(phase_kernel<3>, dim3(G), dim3(NTHREADS), 0, stream, p);
  hipLaunchKernelGGL(phase_kernel<4>, dim3(G), dim3(NTHREADS), 0, stream, p);
  hipLaunchKernelGGL(phase_kernel<5>, dim3(G), dim3(NTHREADS), 0, stream, p);
  hipLaunchKernelGGL(phase_kernel<6>, dim3(G), dim3(NTHREADS), 0, stream, p);
  hipLaunchKernelGGL(phase_kernel<7>, dim3(G), dim3(NTHREADS), 0, stream, p);
  hipLaunchKernelGGL(phase_kernel<8>, dim3(G), dim3(NTHREADS), 0, stream, p);
  hipLaunchKernelGGL(phase_kernel<9>, dim3(G), dim3(NTHREADS), 0, stream, p);
#endif
}
```

```cpp
#include <hip/hip_runtime.h>
#include <cstdio>
#include <cstdint>

#ifndef MODE_EXACT
#define MODE_EXACT 0
#endif
#ifndef ONE_LAUNCH
#define ONE_LAUNCH 1
#endif
#ifndef ATTN_EXACT
#define ATTN_EXACT MODE_EXACT
#endif
#ifndef PHASE_ONLY
#define PHASE_ONLY -1
#endif
#ifndef TIMING_PROBE
#define TIMING_PROBE 0
#endif
#ifndef PROBE_A_MASK
#define PROBE_A_MASK 0
#endif
#ifndef PROBE_R_MASK
#define PROBE_R_MASK 0
#endif
#ifndef PROBE_R_SCALE
#define PROBE_R_SCALE 0.002f
#endif
#ifndef GEMM_EXACT
#define GEMM_EXACT MODE_EXACT
#endif

#define DEVI __device__ __forceinline__

typedef unsigned short bf16_t;
typedef short bf16x8 __attribute__((ext_vector_type(8)));
typedef short s16x4 __attribute__((ext_vector_type(4)));
typedef float f32x16 __attribute__((ext_vector_type(16)));
typedef float f32x4 __attribute__((ext_vector_type(4)));
typedef unsigned u32x4 __attribute__((ext_vector_type(4)));

#if MODE_EXACT
typedef float act_t;
#else
typedef bf16_t act_t;
#endif

constexpr int DM = 1024, NBATCH = 2, SEQ = 8192, CTXL = 256, RB = SEQ + CTXL  , RR = NBATCH * RB  , TT = NBATCH * SEQ  ;
constexpr int GW = 64, GROWS = 128;
constexpr int QL = 384, KVL = 256, NPROJ = 2304  , NPROJ_REAL = 2208;
constexpr int NEXP = 16, DEXP = 512;
constexpr float EPS = 1e-6f, LOG2E = 1.4426950408889634f;
constexpr float QSCALE = 0.10206207261596577f * 1.4426950408889634f;
constexpr float NASCALE = 0.125f * 1.4426950408889634f;
constexpr int HIDROWS = 36864;
constexpr int NTHREADS = 512, NWAVES = 8;

constexpr size_t AS = sizeof(act_t);
constexpr size_t OFF_BAR   = 0;
constexpr size_t OFF_CNT   = 16384;
constexpr size_t OFF_MOD   = OFF_CNT + 256;
constexpr size_t OFF_ROPE  = OFF_MOD + 3 * 6144 * 4;
constexpr size_t OFF_SSQ   = OFF_ROPE + 2 * 128 * 8 * 4;
constexpr size_t OFF_SSKV  = OFF_SSQ + (size_t)RR * 12 * 4;
constexpr size_t OFF_BT    = OFF_SSKV + (size_t)RR * 8 * 4;
constexpr size_t OFF_ELIST = OFF_BT + (size_t)8 * 15 * 4096 * 4;
constexpr size_t OFF_EW    = OFF_ELIST + (size_t)NEXP * TT * 4;
constexpr size_t OFF_WRT   = OFF_EW + (size_t)NEXP * TT * 4;
constexpr size_t OFF_KMAX  = OFF_WRT + 20 * 1024 * 4;
constexpr size_t SMALL_END = OFF_KMAX + 512;
static_assert(SMALL_END <= (size_t)8 << 20, "small region");
constexpr size_t OFF_W     = (size_t)8 << 20;
#if MODE_EXACT
constexpr size_t W_BYTES = 0;
#else
constexpr size_t W_BYTES = (size_t)60 << 20;
#endif
constexpr size_t OFF_WIN  = OFF_W;
constexpr size_t OFF_WUQ  = OFF_WIN + (size_t)NPROJ * 1024 * 2;
constexpr size_t OFF_WUKV = OFF_WUQ + (size_t)768 * 384 * 2;
constexpr size_t OFF_WOUT = OFF_WUKV + (size_t)1024 * 256 * 2;
constexpr size_t OFF_WGU  = OFF_WOUT + (size_t)1024 * 1024 * 2;
constexpr size_t OFF_WD   = OFF_WGU + (size_t)16 * 1024 * 1024 * 2;
constexpr size_t W_END    = OFF_WD + (size_t)16 * 1024 * 512 * 2;
static_assert(MODE_EXACT || W_END <= OFF_W + W_BYTES, "weights region");
constexpr size_t G0 = OFF_W + W_BYTES;
constexpr size_t OFF_HXALL = G0;
constexpr size_t OFF_KV    = OFF_HXALL;
constexpr size_t OFF_NAQ   = OFF_HXALL + (size_t)RR * 1024 * AS;
constexpr size_t OFF_NAK   = OFF_NAQ + (size_t)RR * 512 * AS;
constexpr size_t OFF_NAV   = OFF_NAK + (size_t)RR * 512 * AS;
constexpr size_t OFF_KROPE = OFF_NAV + (size_t)RR * 512 * AS;
constexpr size_t OFF_QLAT  = OFF_KROPE + (size_t)RR * 32 * AS;
constexpr size_t OFF_KVLAT = OFF_QLAT + (size_t)RR * 384 * AS;
constexpr size_t OFF_ATTN  = OFF_QLAT;
constexpr size_t ATT_END   = OFF_ATTN + (size_t)TT * 1024 * AS;
constexpr size_t OFF_YBUF  = G0;
constexpr size_t OFF_HX2   = G0;
constexpr size_t OFF_HID   = OFF_YBUF + (size_t)2 * TT * 1024 * AS;
constexpr size_t MOE_END   = OFF_HID + (size_t)HIDROWS * 512 * AS;
constexpr size_t OFF_X1    = ATT_END > MOE_END ? ATT_END : MOE_END;
constexpr size_t WS_NEED   = OFF_X1 + (size_t)TT * 1024 * AS;
static_assert(MODE_EXACT || WS_NEED <= ((size_t)256 << 20), "workspace");

struct Params {
  const float *x, *c, *ctx, *c_ctx, *w_mod, *b_mod, *g_attn, *g_ffn, *w_in, *g_q, *g_kv, *w_uq, *w_ukv, *rel_bias, *w_out,
              *w_rg, *b_rg, *w_re, *b_re, *w_gate, *w_up, *w_down, *g_final;
  float* out; char* ws;
};

DEVI float bf2f(bf16_t v) { return __uint_as_float(((unsigned)v) << 16); }
DEVI bf16_t f2bf(float f) { unsigned u = __float_as_uint(f); u += 0x7fffu + ((u >> 16) & 1u); return (bf16_t)(u >> 16); }
typedef __bf16 bf16x2_t __attribute__((ext_vector_type(2)));
typedef float f32x2_t __attribute__((ext_vector_type(2)));
DEVI unsigned pk2(float lo, float hi) { const f32x2_t v = {lo, hi}; return __builtin_bit_cast(unsigned, __builtin_convertvector(v, bf16x2_t)); }
DEVI float a2f(float v) { return v; }
DEVI float a2f(bf16_t v) { return bf2f(v); }
DEVI void ld4(const float* p, float (&v)[4]) { const float4 t = *(const float4*)p; v[0] = t.x; v[1] = t.y; v[2] = t.z; v[3] = t.w; }
DEVI void ld4(const bf16_t* p, float (&v)[4]) { const uint2 t = *(const uint2*)p; v[0] = __uint_as_float(t.x << 16); v[1] = __uint_as_float(t.x & 0xffff0000u); v[2] = __uint_as_float(t.y << 16); v[3] = __uint_as_float(t.y & 0xffff0000u); }
DEVI void st4(float* p, float a, float b, float c, float d) { *(float4*)p = make_float4(a, b, c, d); }
DEVI void st4(bf16_t* p, float a, float b, float c, float d) { uint2 t; t.x = pk2(a, b); t.y = pk2(c, d); *(uint2*)p = t; }
DEVI void st1(float* p, float a) { *p = a; }
DEVI void st1(bf16_t* p, float a) { *p = f2bf(a); }
DEVI int crow(int r, int hi) { return (r & 3) + 8 * (r >> 2) + 4 * hi; }
DEVI float wave_sum(float v) { v += __shfl_xor(v, 32); v += __shfl_xor(v, 16); v += __shfl_xor(v, 8); v += __shfl_xor(v, 4); v += __shfl_xor(v, 2); v += __shfl_xor(v, 1); return v; }
DEVI float half_sum32(float v) { v += __shfl_xor(v, 16); v += __shfl_xor(v, 8); v += __shfl_xor(v, 4); v += __shfl_xor(v, 2); v += __shfl_xor(v, 1); return v; }
DEVI float xhalf_max(float v) { auto rr = __builtin_amdgcn_permlane32_swap(__float_as_uint(v), __float_as_uint(v), false, false); return fmaxf(__uint_as_float(rr[0]), __uint_as_float(rr[1])); }
DEVI float xhalf_sum(float v) { auto rr = __builtin_amdgcn_permlane32_swap(__float_as_uint(v), __float_as_uint(v), false, false); return __uint_as_float(rr[0]) + __uint_as_float(rr[1]); }
DEVI float silu_f(float v) { return v / (1.f + expf(-v)); }
DEVI float silu_fast(float v) { return v * __builtin_amdgcn_rcpf(1.f + __builtin_amdgcn_exp2f(-v * LOG2E)); }

DEVI int xcd_unit(int v, int U) { const int chunk = (U + 7) >> 3; const int x = v & 7, j = v >> 3; if (j >= chunk) return -1; const int u = x * chunk + j; return u < U ? u : -1; }
DEVI void panel_order(int idx, int nM, int nN, int& tm, int& tn) { const int nig = 8 * nN, gid = idx / nig, fm = gid * 8, gsz = (nM - fm) < 8 ? (nM - fm) : 8, r = idx - gid * nig; tm = fm + r % gsz; tn = r / gsz; }
DEVI int xcd_iters(int U, int nb) { const int chunk = (U + 7) >> 3; return (chunk * 8 + nb - 1) / nb; }

struct WInAcc { const float* w; static constexpr int LD = NPROJ_REAL;
  DEVI const float* col(int n, float& msk) const { const int o = n < 1152 ? n : (n < 2176 ? n + 32 : n - 1024); const bool ok = n < 2208; msk = ok ? 1.f : 0.f; return w + (ok ? o : 0); }
  DEVI float kscale(int) const { return 1.f; }
  DEVI float at(int k, int n) const { int o; if (n < 1152) o = n; else if (n < 2176) o = n + 32; else if (n < 2208) o = n - 1024; else return 0.f; return w[(size_t)k * NPROJ_REAL + o]; } };
struct WUqAcc { const float* w; const float* g; static constexpr int LD = 768;
  DEVI const float* col(int n, float& msk) const { msk = 1.f; return w + n; }
  DEVI float kscale(int k) const { return g[k]; }
  DEVI float at(int k, int n) const { return g[k] * w[(size_t)k * 768 + n]; } };
struct WUkvAcc { const float* w; const float* g; static constexpr int LD = 1024;
  DEVI const float* col(int n, float& msk) const { msk = 1.f; return w + n; }
  DEVI float kscale(int k) const { return g[k]; }
  DEVI float at(int k, int n) const { return g[k] * w[(size_t)k * 1024 + n]; } };
struct WOutAcc { const float* w; static constexpr int LD = 1024;
  DEVI const float* col(int n, float& msk) const { msk = 1.f; return w + n; }
  DEVI float kscale(int) const { return 1.f; }
  DEVI float at(int k, int n) const { return w[(size_t)k * 1024 + n]; } };
struct WGUAcc { const float* wg; const float* wu;
  static constexpr int LD = 512;
  DEVI const float* col(int n, float& msk) const { const int g = n >> 3, j = n & 7; msk = 1.f;
    const unsigned long long a = (unsigned long long)wg, b = (unsigned long long)wu;
    const unsigned lo = j < 4 ? (unsigned)a : (unsigned)b, hi = j < 4 ? (unsigned)(a >> 32) : (unsigned)(b >> 32);
    return (const float*)(((unsigned long long)hi << 32) | lo) + g * 4 + (j & 3); }
  DEVI float kscale(int) const { return 1.f; }
  DEVI float at(int k, int n) const { const int g = n >> 3, j = n & 7; return j < 4 ? wg[(size_t)k * 512 + g * 4 + j] : wu[(size_t)k * 512 + g * 4 + j - 4]; } };
struct WDAcc { const float* w; static constexpr int LD = 1024;
  DEVI const float* col(int n, float& msk) const { msk = 1.f; return w + n; }
  DEVI float kscale(int) const { return 1.f; }
  DEVI float at(int k, int n) const { return w[(size_t)k * 1024 + n]; } };

namespace g8 {
#define G8_LAS __attribute__((address_space(3)))
constexpr int BM = 256, BK = 64, HALF = 128, HTB = HALF * BK * 2  , STAGE_BYTES = 8 * HTB;
DEVI int lds_byte(int r, int c) { const int st = (r >> 4) * 2 + (c >> 5), rr = r & 15, cc = c & 31, ob = rr * 64 + cc * 2; return st * 1024 + (ob ^ (((ob >> 9) & 1) << 5)); }
DEVI void stage_rc(int b, int& R, int& C) { const int st = b / 1024, sb = b % 1024, swz = sb ^ (((sb >> 9) & 1) << 5); R = (st >> 1) * 16 + swz / 64; C = (st & 1) * 32 + (swz % 64) / 2; }
DEVI int perm32(int rho) { const int n = rho >> 4, i = rho & 15; return 8 * (i >> 2) + 4 * n + (i & 3); }
struct Unit { int pm, pn; };
template <class Epi, class Sched, bool GATHER, int K>
DEVI void gemm_phase(G8_LAS unsigned char* lds, const bf16_t* A, const bf16_t* Bt, const Sched& S, const Epi& E) {
  int tid = threadIdx.x; asm volatile("" : "+v"(tid));
  const int wid = __builtin_amdgcn_readfirstlane(tid >> 6), lane = tid & 63, wr = wid >> 2, wc = wid & 3, fr = lane & 15, fq = lane >> 4;
  constexpr int nt = K / BK;
  int sR[2], sC[2]; unsigned voffB[2];
#pragma unroll
  for (int i = 0; i < 2; ++i) { int R, C; stage_rc(tid * 16 + i * 8192, R, C); sR[i] = R; sC[i] = C; const int Rb = (R & ~31) + perm32(R & 31); voffB[i] = (unsigned)(Rb * K + C) * 2u; }
  constexpr size_t kstep = (size_t)(BK * 2);
  constexpr size_t hstep = (size_t)HALF * K * 2;
  constexpr size_t tstep = 2 * hstep;
  const unsigned ldsw = (unsigned)wid * 1024u;
  const int aoff = lds_byte(wr * 64 + fr, fq * 8), boff = lds_byte(wc * 32 + fr, fq * 8);
#define PG8_SA(b, h) (((b) * 2 + (h)) * HTB)
#define PG8_SB(b, h) ((4 + (b) * 2 + (h)) * HTB)
#define PG8_STAGE(bufoff, gbase, voff) do { _Pragma("unroll") for (int _i = 0; _i < 2; ++_i) \
        __builtin_amdgcn_global_load_lds((const unsigned*)((const char*)(gbase) + (voff)[_i]), (G8_LAS unsigned*)(lds + (bufoff) + ldsw + _i * 8192), 16, 0, 0); } while (0)
#define PG8_LDA(dst, b, h) do { _Pragma("unroll") for (int m = 0; m < 4; ++m) _Pragma("unroll") for (int k = 0; k < 2; ++k) dst[m][k] = *(const G8_LAS bf16x8*)(lds + PG8_SA(b, h) + aoff + m * 2048 + k * 1024); } while (0)
#define PG8_LDB(dst, b, h) do { _Pragma("unroll") for (int n = 0; n < 2; ++n) _Pragma("unroll") for (int k = 0; k < 2; ++k) dst[n][k] = *(const G8_LAS bf16x8*)(lds + PG8_SB(b, h) + boff + n * 2048 + k * 1024); } while (0)
#define PG8_MMA(ai, bj, At, Bt_) do { __builtin_amdgcn_s_setprio(1); _Pragma("unroll") for (int m = 0; m < 4; ++m) _Pragma("unroll") for (int n = 0; n < 2; ++n) _Pragma("unroll") for (int k = 0; k < 2; ++k) \
        acc[ai][bj][m][n] = __builtin_amdgcn_mfma_f32_16x16x32_bf16(Bt_[n][k], At[m][k], acc[ai][bj][m][n], 0, 0, 0); __builtin_amdgcn_s_setprio(0); } while (0)
#define PG8_WAIT_V(n) asm volatile("s_waitcnt vmcnt(" #n ")" ::: "memory")
#define PG8_WAIT_L(n) asm volatile("s_waitcnt lgkmcnt(" #n ")" ::: "memory")
#define PG8_BAR __builtin_amdgcn_s_barrier()
#define PG8_SCHED __builtin_amdgcn_sched_barrier(0)
  Unit cur, nxt; int ui = 0;
  if (!S.next(0, cur)) return;
  f32x4 acc[2][2][4][2];
#pragma unroll
  for (int a = 0; a < 2; ++a)
#pragma unroll
    for (int b = 0; b < 2; ++b)
#pragma unroll
      for (int m = 0; m < 4; ++m)
#pragma unroll
        for (int n = 0; n < 2; ++n) acc[a][b][m][n] = (f32x4){0.f, 0.f, 0.f, 0.f};
  bf16x8 At[4][2], B0[2][2], B1[2][2];
  unsigned vA0[2], vA1[2];
#define G8_SETV(U_, V0, V1) do { _Pragma("unroll") for (int _i = 0; _i < 2; ++_i) { \
      V0[_i] = (unsigned)S.arow(U_, sR[_i]) * (unsigned)(K * 2) + (unsigned)(sC[_i] * 2); V1[_i] = (unsigned)S.arow(U_, 128 + sR[_i]) * (unsigned)(K * 2) + (unsigned)(sC[_i] * 2); } } while (0)
  if (GATHER) { G8_SETV(cur, vA0, vA1); }
  else {
#pragma unroll
    for (int i = 0; i < 2; ++i) { vA0[i] = (unsigned)(sR[i] * K + sC[i]) * 2u; vA1[i] = vA0[i]; } }
  constexpr size_t hA = GATHER ? (size_t)0 : hstep;
  const char* cA = GATHER ? (const char*)A : (const char*)A + (size_t)cur.pm * tstep; const char* cB = (const char*)Bt + (size_t)cur.pn * tstep;
  PG8_STAGE(PG8_SB(0, 0), cB, voffB); PG8_STAGE(PG8_SA(0, 0), cA, vA0); PG8_STAGE(PG8_SB(0, 1), cB + hstep, voffB); PG8_STAGE(PG8_SA(0, 1), cA + hA, vA1);
  if (wr == 1) PG8_BAR;
  PG8_WAIT_V(4); PG8_BAR;
  PG8_STAGE(PG8_SB(1, 0), cB + kstep, voffB); PG8_STAGE(PG8_SA(1, 0), cA + kstep, vA0); PG8_STAGE(PG8_SB(1, 1), cB + hstep + kstep, voffB);
  PG8_WAIT_V(6); PG8_BAR;
  for (;;) {
    const bool has_next = S.next(ui + 1, nxt);
    const char* nA = has_next ? (GATHER ? (const char*)A : (const char*)A + (size_t)nxt.pm * tstep) : cA; const char* nB = has_next ? (const char*)Bt + (size_t)nxt.pn * tstep : cB;
#pragma unroll 1
    for (int t = 0; t < nt; t += 2) {
      const bool last = (t == nt - 2);
      const char* a1 = cA + (size_t)(t + 1) * kstep;
      const char* a2 = last ? nA : cA + (size_t)(t + 2) * kstep; const char* b2 = last ? nB : cB + (size_t)(t + 2) * kstep;
      const char* a3 = a2 + kstep; const char* b3 = b2 + kstep;
      PG8_LDB(B0, 0, 0); PG8_SCHED; PG8_LDA(At, 0, 0); PG8_STAGE(PG8_SA(1, 1), a1 + hA, vA1);
      PG8_WAIT_L(8); PG8_BAR; PG8_WAIT_L(0); PG8_MMA(0, 0, At, B0); PG8_BAR; PG8_SCHED;
      if (GATHER) { if (last && has_next) { G8_SETV(nxt, vA0, vA1); } }
      PG8_LDB(B1, 0, 1); PG8_STAGE(PG8_SB(0, 0), b2, voffB);
      PG8_BAR; PG8_WAIT_L(0); PG8_MMA(0, 1, At, B1); PG8_BAR;
      PG8_LDA(At, 0, 1); PG8_STAGE(PG8_SA(0, 0), a2, vA0);
      PG8_BAR; PG8_WAIT_L(0); PG8_MMA(1, 0, At, B0); PG8_BAR; PG8_SCHED;
      PG8_STAGE(PG8_SB(0, 1), b2 + hstep, voffB);
      PG8_WAIT_V(6); PG8_BAR; PG8_MMA(1, 1, At, B1); PG8_BAR;
      PG8_LDB(B0, 1, 0); PG8_SCHED; PG8_LDA(At, 1, 0); PG8_STAGE(PG8_SA(0, 1), a2 + hA, vA1);
      PG8_WAIT_L(8); PG8_BAR; PG8_WAIT_L(0); PG8_MMA(0, 0, At, B0); PG8_BAR; PG8_SCHED;
      PG8_LDB(B1, 1, 1); PG8_STAGE(PG8_SB(1, 0), b3, voffB);
      PG8_BAR; PG8_WAIT_L(0); PG8_MMA(0, 1, At, B1); PG8_BAR;
      PG8_LDA(At, 1, 1); PG8_STAGE(PG8_SA(1, 0), a3, vA0);
      PG8_BAR; PG8_WAIT_L(0); PG8_MMA(1, 0, At, B0); PG8_BAR; PG8_SCHED;
      PG8_STAGE(PG8_SB(1, 1), b3 + hstep, voffB);
      PG8_WAIT_V(6); PG8_BAR; PG8_MMA(1, 1, At, B1); PG8_BAR;
    }
    E(acc, cur, wr, wc, fr, fq);
    if (!has_next) break;
#pragma unroll
    for (int a = 0; a < 2; ++a)
#pragma unroll
      for (int b = 0; b < 2; ++b)
#pragma unroll
        for (int m = 0; m < 4; ++m)
#pragma unroll
          for (int n = 0; n < 2; ++n) acc[a][b][m][n] = (f32x4){0.f, 0.f, 0.f, 0.f};
    cur = nxt; cA = nA; cB = nB; ++ui;
  }
  PG8_WAIT_V(0);
  if (wr == 0) PG8_BAR;
  PG8_BAR;
#undef G8_SETV
#undef PG8_SA
#undef PG8_SB
#undef PG8_STAGE
#undef PG8_LDA
#undef PG8_LDB
#undef PG8_MMA
#undef PG8_WAIT_V
#undef PG8_WAIT_L
#undef PG8_BAR
#undef PG8_SCHED
}
}

constexpr int PH_BYTES = 139264;
constexpr int SM_BARW  = PH_BYTES;
constexpr int SM_TAB   = PH_BYTES + 32;
constexpr int SM_PTR   = PH_BYTES + 32 + 160;
constexpr int LDS_TOTAL = PH_BYTES + 32 + 160 + 208;
constexpr int KM_KN = 0;
constexpr int KM_KR = 32;
constexpr int KM_NA = 40;
constexpr int KM_BM = 80;

DEVI void store8(bf16_t* p, const f32x4& a, const f32x4& b) { u32x4 w = {pk2(a[0], a[1]), pk2(a[2], a[3]), pk2(b[0], b[1]), pk2(b[2], b[3])}; *(u32x4*)p = w; }
DEVI float sumsq8(const f32x4& a, const f32x4& b) { return a[0] * a[0] + a[1] * a[1] + a[2] * a[2] + a[3] * a[3] + b[0] * b[0] + b[1] * b[1] + b[2] * b[2] + b[3] * b[3]; }
DEVI float fq_sum(float v) { v += __shfl_xor(v, 16); v += __shfl_xor(v, 32); return v; }
DEVI float fr_max(float v) { v = fmaxf(v, __shfl_xor(v, 1)); v = fmaxf(v, __shfl_xor(v, 2)); v = fmaxf(v, __shfl_xor(v, 4)); v = fmaxf(v, __shfl_xor(v, 8)); return v; }
DEVI void rope8(f32x4& v0, f32x4& v1, int fq, int gr, int gc, const float* rc, const float* rs) {
  const int pb = ((fq & 1) ? gc : gr) * 8;
  float x[8] = {v0[0], v0[1], v0[2], v0[3], v1[0], v1[1], v1[2], v1[3]};
#pragma unroll
  for (int e = 0; e < 8; ++e) { const float y = __shfl_xor(x[e], 32); const float cs = rc[pb + e], sn = rs[pb + e];
    x[e] = fq < 2 ? x[e] * cs - y * sn : y * sn + x[e] * cs; }
  v0 = (f32x4){x[0], x[1], x[2], x[3]}; v1 = (f32x4){x[4], x[5], x[6], x[7]};
}

struct SchedGrid {
  int nM, nN, U, nb, bid, mskip;
  DEVI bool next(int i, g8::Unit& u) const { const int x = xcd_unit(bid + i * nb, U); if (x < 0) return false; int tm, tn; panel_order(x, nM, nN, tm, tn); u.pm = mskip ? tm + 1 + tm / 32 : tm; u.pn = tn; return true; }
  DEVI unsigned arow(const g8::Unit&, int) const { return 0u; }
};
typedef const int __attribute__((address_space(3))) las_cint;
struct SchedMoe {
  las_cint* tab; const int* elist; int MT, U, nb, bid;
  DEVI bool next(int i, g8::Unit& u) const { const int x = xcd_unit(bid + i * nb, U); if (x < 0) return false; int mt, tn; panel_order(x, MT, 4, mt, tn);
    int e = 0;
#pragma unroll
    for (int q = 1; q < 16; ++q) e += (mt >= tab[q]) ? 1 : 0;
    u.pm = mt; u.pn = e * 4 + tn; return true; }
  DEVI unsigned arow(const g8::Unit& u, int r) const { const int e = u.pn >> 2, slot = (u.pm - tab[e]) * 256 + r; return slot < tab[17 + e] ? (unsigned)(elist[(size_t)e * TT + slot] >> 1) : 0u; }
};
DEVI void moe_table(const Params& p, char* smem) {
  if (threadIdx.x == 0) { int* tab = (int*)(smem + SM_TAB); const int* cnt = (const int*)(p.ws + OFF_CNT); int acc = 0;
    for (int e = 0; e < 16; ++e) { tab[e] = acc; tab[17 + e] = cnt[e]; acc += (cnt[e] + 255) >> 8; } tab[16] = acc; }
  __syncthreads();
}

#define EPI_ROWS for (int ai = 0; ai < 2; ++ai) _Pragma("unroll") for (int m = 0; m < 4; ++m)
struct EpiProj8 { const Params* p;
  DEVI void operator()(const f32x4 (&acc)[2][2][4][2], const g8::Unit& u, int wr, int wc, int fr, int fq) const {
    char* ws = p->ws; const int b = (u.pm * 256) / RB;
    const float* rc = (const float*)(ws + OFF_ROPE); const float* rs = rc + 1024;
#pragma unroll
    for (int bj = 0; bj < 2; ++bj) {
      const int gc = u.pn * 256 + bj * 128 + wc * 32;
      float rmx = 0.f;
#pragma unroll
      EPI_ROWS {
        const int row = u.pm * 256 + ai * 128 + wr * 64 + m * 16 + fr;
        f32x4 v0 = acc[ai][bj][m][0], v1 = acc[ai][bj][m][1];
        if (gc < 384) { store8((bf16_t*)(ws + OFF_QLAT) + (size_t)row * 384 + gc + 8 * fq, v0, v1);
          const float ss = fq_sum(sumsq8(v0, v1)); if (fq == 0) ((float*)(ws + OFF_SSQ))[(size_t)row * 12 + (gc >> 5)] = ss; }
        else if (gc < 896) { store8((bf16_t*)(ws + OFF_NAQ) + (size_t)row * 512 + (gc - 384) + 8 * fq, v0 * NASCALE, v1 * NASCALE); }
        else if (gc < 1152) { store8((bf16_t*)(ws + OFF_KVLAT) + (size_t)row * 256 + (gc - 896) + 8 * fq, v0, v1);
          const float ss = fq_sum(sumsq8(v0, v1)); if (fq == 0) ((float*)(ws + OFF_SSKV))[(size_t)row * 8 + ((gc - 896) >> 5)] = ss; }
        else if (gc < 1664) { store8((bf16_t*)(ws + OFF_NAK) + (size_t)row * 512 + (gc - 1152) + 8 * fq, v0, v1); rmx = fmaxf(rmx, fq_sum(sumsq8(v0, v1))); }
        else if (gc < 2176) { store8((bf16_t*)(ws + OFF_NAV) + (size_t)row * 512 + (gc - 1664) + 8 * fq, v0, v1); }
        else if (gc == 2176) { const int rb = row % RB;
          if (rb >= CTXL) { const int pos = rb - CTXL; rope8(v0, v1, fq, pos >> 6, pos & 63, rc, rs); }
          store8((bf16_t*)(ws + OFF_KROPE) + (size_t)row * 32 + 8 * fq, v0, v1); rmx = fmaxf(rmx, fq_sum(sumsq8(v0, v1))); }
      }
      if (gc >= 1152 && gc < 1664) { rmx = fr_max(rmx); if ((threadIdx.x & 63) == 0) atomicMax((unsigned*)(ws + OFF_KMAX) + KM_NA + b * 16 + ((gc - 1152) >> 5), __float_as_uint(rmx)); }
      if (gc == 2176) { rmx = fr_max(rmx); if ((threadIdx.x & 63) == 0) atomicMax((unsigned*)(ws + OFF_KMAX) + KM_KR + b, __float_as_uint(rmx)); }
    }
  } };

struct EpiQm8 { const Params* p;
  DEVI void operator()(const f32x4 (&acc)[2][2][4][2], const g8::Unit& u, int wr, int wc, int fr, int fq) const {
    char* ws = p->ws; bf16_t* qm = (bf16_t*)p->out;
    const float* rc = (const float*)(ws + OFF_ROPE); const float* rs = rc + 1024;
    float sc8[2][4];
#pragma unroll
    for (int ai = 0; ai < 2; ++ai)
#pragma unroll
      for (int m = 0; m < 4; ++m) { const int row = u.pm * 256 + ai * 128 + wr * 64 + m * 16 + fr;
        const f32x4* sp = (const f32x4*)((const float*)(ws + OFF_SSQ) + (size_t)row * 12); f32x4 s0 = {0.f, 0.f, 0.f, 0.f}; if (fq < 3) s0 = sp[fq];
        sc8[ai][m] = (s0[0] + s0[1]) + (s0[2] + s0[3]); }
#pragma unroll
    for (int ai = 0; ai < 2; ++ai)
#pragma unroll
      for (int m = 0; m < 4; ++m) sc8[ai][m] = rsqrtf(fq_sum(sc8[ai][m]) * (1.f / 384.f) + EPS) * QSCALE;
    {
#pragma unroll
    EPI_ROWS {
      const int row = u.pm * 256 + ai * 128 + wr * 64 + m * 16 + fr; const int pos = row % RB - CTXL;
      const float sc = sc8[ai][m];
#pragma unroll
      for (int bj = 0; bj < 2; ++bj) { const int gc = u.pn * 256 + bj * 128 + wc * 32;
        f32x4 v0 = acc[ai][bj][m][0], v1 = acc[ai][bj][m][1];
        if ((gc % 96) == 64) rope8(v0, v1, fq, pos >> 6, pos & 63, rc, rs);
        store8(qm + (size_t)row * 768 + gc + 8 * fq, v0 * sc, v1 * sc); }
    }
    }
  } };

struct EpiKv8 { const Params* p;
  DEVI void operator()(const f32x4 (&acc)[2][2][4][2], const g8::Unit& u, int wr, int wc, int fr, int fq) const {
    char* ws = p->ws; const int b = (u.pm * 256) / RB; float rmx[2] = {0.f, 0.f};
    float sc8[2][4];
#pragma unroll
    for (int ai = 0; ai < 2; ++ai)
#pragma unroll
      for (int m = 0; m < 4; ++m) { const int row = u.pm * 256 + ai * 128 + wr * 64 + m * 16 + fr;
        const f32x4* sp = (const f32x4*)((const float*)(ws + OFF_SSKV) + (size_t)row * 8); f32x4 s0 = {0.f, 0.f, 0.f, 0.f}; if (fq < 2) s0 = sp[fq];
        sc8[ai][m] = (s0[0] + s0[1]) + (s0[2] + s0[3]); }
#pragma unroll
    for (int ai = 0; ai < 2; ++ai)
#pragma unroll
      for (int m = 0; m < 4; ++m) sc8[ai][m] = rsqrtf(fq_sum(sc8[ai][m]) * (1.f / 256.f) + EPS);
#pragma unroll
    EPI_ROWS {
      const int row = u.pm * 256 + ai * 128 + wr * 64 + m * 16 + fr; const float sc = sc8[ai][m];
#pragma unroll
      for (int bj = 0; bj < 2; ++bj) { const int gc = u.pn * 256 + bj * 128 + wc * 32;
        const f32x4 v0 = acc[ai][bj][m][0] * sc, v1 = acc[ai][bj][m][1] * sc;
        store8((bf16_t*)(ws + OFF_KV) + (size_t)row * 1024 + gc + 8 * fq, v0, v1);
        if ((gc & 127) < 64) rmx[bj] = fmaxf(rmx[bj], fq_sum(sumsq8(v0, v1))); }
    }
#pragma unroll
    for (int bj = 0; bj < 2; ++bj) { const int gc = u.pn * 256 + bj * 128 + wc * 32;
      if ((gc & 127) < 64) { const float r = fr_max(rmx[bj]); if ((threadIdx.x & 63) == 0) atomicMax((unsigned*)(ws + OFF_KMAX) + KM_KN + b * 16 + (gc >> 7) * 2 + ((gc >> 5) & 1), __float_as_uint(r)); } }
  } };

struct EpiOut8 { const Params* p;
  DEVI void operator()(const f32x4 (&acc)[2][2][4][2], const g8::Unit& u, int wr, int wc, int fr, int fq) const {
    const float* mod = (const float*)(p->ws + OFF_MOD); const int b = (u.pm * 256) >> 13;
    f32x4 gv[2][2];
#pragma unroll
    for (int bj = 0; bj < 2; ++bj) { const f32x4* gp = (const f32x4*)(mod + b * 6144 + 2048 + u.pn * 256 + bj * 128 + wc * 32 + 8 * fq); gv[bj][0] = gp[0]; gv[bj][1] = gp[1]; }
#pragma unroll
    for (int ai = 0; ai < 2; ++ai)
#pragma unroll
      for (int mh = 0; mh < 2; ++mh) {
        f32x4 xv[2][2][2];
#pragma unroll
        for (int mm = 0; mm < 2; ++mm)
#pragma unroll
          for (int bj = 0; bj < 2; ++bj) { const int m = mh * 2 + mm, tok = u.pm * 256 + ai * 128 + wr * 64 + m * 16 + fr, n = u.pn * 256 + bj * 128 + wc * 32 + 8 * fq;
            const f32x4* xp = (const f32x4*)(p->x + (size_t)tok * 1024 + n); xv[mm][bj][0] = xp[0]; xv[mm][bj][1] = xp[1]; }
#pragma unroll
        for (int mm = 0; mm < 2; ++mm)
#pragma unroll
          for (int bj = 0; bj < 2; ++bj) { const int m = mh * 2 + mm, tok = u.pm * 256 + ai * 128 + wr * 64 + m * 16 + fr, n = u.pn * 256 + bj * 128 + wc * 32 + 8 * fq;
            act_t* op = (act_t*)(p->ws + OFF_X1) + (size_t)tok * 1024 + n;
            const f32x4 r0 = xv[mm][bj][0] + gv[bj][0] * acc[ai][bj][m][0], r1 = xv[mm][bj][1] + gv[bj][1] * acc[ai][bj][m][1];
#if MODE_EXACT
            st4(op, r0[0], r0[1], r0[2], r0[3]); st4(op + 4, r1[0], r1[1], r1[2], r1[3]);
#else
            store8(op, r0, r1);
#endif
          }
      }
  } };

struct EpiGU8 { const Params* p; las_cint* tab;
  DEVI void operator()(const f32x4 (&acc)[2][2][4][2], const g8::Unit& u, int wr, int wc, int fr, int fq) const {
    bf16_t* hid = (bf16_t*)(p->ws + OFF_HID); const int e = u.pn >> 2, tn = u.pn & 3, slot0 = (u.pm - tab[e]) * 256, cnt = tab[17 + e];
    const float* ew = (const float*)(p->ws + OFF_EW) + (size_t)e * TT;
    float cw[2][4];
#pragma unroll
    for (int ai = 0; ai < 2; ++ai)
#pragma unroll
      for (int m = 0; m < 4; ++m) { const int slot = slot0 + ai * 128 + wr * 64 + m * 16 + fr; cw[ai][m] = slot < cnt ? ew[slot] : 0.f; }
#pragma unroll
    EPI_ROWS {
      const int r = ai * 128 + wr * 64 + m * 16 + fr; const bool valid = slot0 + r < cnt; const float c = cw[ai][m];
#pragma unroll
      for (int bj = 0; bj < 2; ++bj) { const int n = tn * 256 + bj * 128 + wc * 32 + 8 * fq;
        const f32x4 g = acc[ai][bj][m][0], up = acc[ai][bj][m][1]; float o[4];
#pragma unroll
        for (int j = 0; j < 4; ++j) o[j] = valid ? silu_fast(g[j]) * up[j] * c : 0.f;
        st4(hid + (size_t)(u.pm * 256 + r) * 512 + (n >> 1), o[0], o[1], o[2], o[3]); }
    }
  } };

struct EpiDown8 { const Params* p; las_cint* tab;
  DEVI void operator()(const f32x4 (&acc)[2][2][4][2], const g8::Unit& u, int wr, int wc, int fr, int fq) const {
    bf16_t* yb = (bf16_t*)(p->ws + OFF_YBUF); const int e = u.pn >> 2, tn = u.pn & 3, slot0 = (u.pm - tab[e]) * 256, cnt = tab[17 + e];
    const int* el = (const int*)(p->ws + OFF_ELIST) + (size_t)e * TT;
    int tk[2][4];
#pragma unroll
    for (int ai = 0; ai < 2; ++ai)
#pragma unroll
      for (int m = 0; m < 4; ++m) { const int slot = slot0 + ai * 128 + wr * 64 + m * 16 + fr; tk[ai][m] = slot < cnt ? el[slot] : -1; }
#pragma unroll
    EPI_ROWS {
      const int t = tk[ai][m];
      if (t >= 0) { bf16_t* rowp = yb + ((size_t)(t & 1) * TT + (t >> 1)) * 1024 + tn * 256 + wc * 32 + 8 * fq;
#pragma unroll
        for (int bj = 0; bj < 2; ++bj) store8(rowp + bj * 128, acc[ai][bj][m][0], acc[ai][bj][m][1]); }
    }
  } };
#undef EPI_ROWS

DEVI void modgemv_item(const Params& p, int item, char* smem) {
  float* sc = (float*)smem; float* red = sc + 3072;
  const int t = threadIdx.x;
  __syncthreads();
  for (int i = t; i < 3072; i += NTHREADS) { const int ci = i >> 10, k = i & 1023; const float v = ci == 0 ? p.c[k] : ci == 1 ? p.c[1024 + k] : p.c_ctx[k]; sc[i] = silu_f(v); }
  __syncthreads();
  const int cc = t & 31, kg = t >> 5, col = item * 32 + cc;
  float a0 = 0.f, a1 = 0.f, a2 = 0.f;
  { const float* wp = p.w_mod + (size_t)kg * 6144 + col;
#pragma unroll 1
    for (int kb = 0; kb < 1024; kb += 512) {
      float wv[32];
#pragma unroll
      for (int u = 0; u < 32; ++u) wv[u] = wp[(size_t)(kb + 16 * u) * 6144];
#pragma unroll
      for (int u = 0; u < 32; ++u) { const int k = kb + 16 * u + kg; a0 = fmaf(sc[k], wv[u], a0); a1 = fmaf(sc[1024 + k], wv[u], a1); a2 = fmaf(sc[2048 + k], wv[u], a2); }
    } }
  red[(kg * 32 + cc) * 3 + 0] = a0; red[(kg * 32 + cc) * 3 + 1] = a1; red[(kg * 32 + cc) * 3 + 2] = a2;
  __syncthreads();
  if (t < 96) { const int c2 = t & 31, ci = t >> 5; float s = 0.f;
#pragma unroll
    for (int g = 0; g < 16; ++g) s += red[(g * 32 + c2) * 3 + ci];
    ((float*)(p.ws + OFF_MOD))[ci * 6144 + item * 32 + c2] = s + p.b_mod[item * 32 + c2]; }
}

DEVI void misc_item(const Params& p) {
  const int t = threadIdx.x;
  if (t < 16) ((int*)(p.ws + OFF_CNT))[t] = 0;
  if (t < KM_BM) ((unsigned*)(p.ws + OFF_KMAX))[t] = 0u;
  { const int h = t >> 6, lane = t & 63; float bm = 0.f;
    for (int i = lane; i < 15 * 31; i += 64) bm = fmaxf(bm, p.rel_bias[h * 465 + i]);
#pragma unroll
    for (int o = 32; o > 0; o >>= 1) bm = fmaxf(bm, __shfl_xor(bm, o));
    if (lane == 0) ((float*)(p.ws + OFF_KMAX))[KM_BM + h] = bm * LOG2E; }
  float* rc = (float*)(p.ws + OFF_ROPE); float* rs = rc + 1024;
  for (int i = t; i < 1024; i += NTHREADS) {
    const int pos = i >> 3, j = i & 7;
    double f = 1.0; for (int q = 0; q < j; ++q) f *= 0.31622776601683794;
    const double a = (double)pos * f; const double n = rint(a * 0.15915494309189535); const double r = a - n * 6.283185307179586477;
    const double r2 = r * r; double sn = r, cs = 1.0, ts = r, tc = 1.0;
    for (int q = 1; q <= 14; ++q) { tc *= -r2 / (double)((2 * q - 1) * (2 * q)); cs += tc; ts *= -r2 / (double)((2 * q) * (2 * q + 1)); sn += ts; }
    rc[i] = (float)cs; rs[i] = (float)sn;
  }
}
DEVI void wrt_item(const Params& p, int j) {
  float* wrt = (float*)(p.ws + OFF_WRT) + j * 1024;
  for (int k = threadIdx.x; k < 1024; k += NTHREADS) wrt[k] = j < 4 ? p.w_rg[k * 4 + j] : p.w_re[k * 16 + j - 4];
}

DEVI void bt_item(const Params& p, int item) {
  unsigned* bt = (unsigned*)(p.ws + OFF_BT) + (size_t)item * 2048;
  for (int i = threadIdx.x; i < 2048; i += NTHREADS) { const int kc = i >> 6, c = i & 63; int cs = c - 8; cs = cs < 0 ? 0 : (cs > 48 ? 48 : cs);
    const float lo = (kc >= cs && kc < cs + 16) ? p.rel_bias[(size_t)item * 31 + (kc - c + 15)] * LOG2E : -1e30f;
    const int k2 = kc + 32; const float hi = (k2 >= cs && k2 < cs + 16) ? p.rel_bias[(size_t)item * 31 + (k2 - c + 15)] * LOG2E : -1e30f;
    bt[i] = pk2(lo, hi); }
}

struct ConvTile { const float* cp; const float* g; bf16_t* dst; int LD, K, n0, k0; float msk; };
DEVI ConvTile conv_desc(const Params& p, int j, int t) {
  constexpr int C_IN = (NPROJ / 64) * 16, C_UQ = 12 * 6, C_UKV = 16 * 4, C_OUT = 256, C_GU = 16 * 16 * 16;
  ConvTile c; c.g = nullptr; c.msk = 1.f; const int nn = t & 63;
  if (j < C_IN) { WInAcc a{p.w_in}; c.n0 = (j >> 4) * 64; c.k0 = (j & 15) * 64; c.cp = a.col(c.n0 + nn, c.msk); c.LD = WInAcc::LD; c.K = 1024; c.dst = (bf16_t*)(p.ws + OFF_WIN); }
  else if ((j -= C_IN) < C_UQ) { c.n0 = (j / 6) * 64; c.k0 = (j % 6) * 64; c.cp = p.w_uq + c.n0 + nn; c.g = p.g_q; c.LD = 768; c.K = 384; c.dst = (bf16_t*)(p.ws + OFF_WUQ); }
  else if ((j -= C_UQ) < C_UKV) { c.n0 = (j >> 2) * 64; c.k0 = (j & 3) * 64; c.cp = p.w_ukv + c.n0 + nn; c.g = p.g_kv; c.LD = 1024; c.K = 256; c.dst = (bf16_t*)(p.ws + OFF_WUKV); }
  else if ((j -= C_UKV) < C_OUT) { c.n0 = (j >> 4) * 64; c.k0 = (j & 15) * 64; c.cp = p.w_out + c.n0 + nn; c.LD = 1024; c.K = 1024; c.dst = (bf16_t*)(p.ws + OFF_WOUT); }
  else if ((j -= C_OUT) < C_GU) { const int e = j >> 8, r = j & 255; c.n0 = (r >> 4) * 64; c.k0 = (r & 15) * 64; WGUAcc a{p.w_gate + (size_t)e * 1024 * 512, p.w_up + (size_t)e * 1024 * 512};
    c.cp = a.col(c.n0 + nn, c.msk); c.LD = 512; c.K = 1024; c.dst = (bf16_t*)(p.ws + OFF_WGU) + (size_t)e * 1024 * 1024; }
  else { j -= C_GU; const int e = j >> 7, r = j & 127; c.n0 = (r >> 3) * 64; c.k0 = (r & 7) * 64; c.cp = p.w_down + (size_t)e * 512 * 1024 + c.n0 + nn; c.LD = 1024; c.K = 512; c.dst = (bf16_t*)(p.ws + OFF_WD) + (size_t)e * 1024 * 512; }
  c.cp += (size_t)(c.k0 + 8 * (t >> 6)) * c.LD;
  return c;
}
DEVI void conv_load(const ConvTile& c, float (&v)[16]) {
#pragma unroll
  for (int i = 0; i < 8; ++i) { v[i] = c.cp[(size_t)i * c.LD]; v[8 + i] = c.cp[(size_t)(64 + i) * c.LD]; }
}
DEVI void conv_finish(const ConvTile& c, const float (&v)[16], int t) {
#pragma unroll
  for (int h = 0; h < 2; ++h) {
    const int kk = c.k0 + 64 * h + 8 * (t >> 6); float x[8];
#pragma unroll
    for (int i = 0; i < 8; ++i) x[i] = v[8 * h + i] * c.msk * (c.g ? c.g[kk + i] : 1.f);
    *(uint4*)(c.dst + (size_t)(c.n0 + (t & 63)) * c.K + kk) = make_uint4(pk2(x[0], x[1]), pk2(x[2], x[3]), pk2(x[4], x[5]), pk2(x[6], x[7])); }
}

constexpr int CONV_C_EXPERTS = 10;
constexpr int NCONV_A = (NPROJ / 64) * 16;
constexpr int NCONV_C = NCONV_A + 12 * 6 + 16 * 4 + 256 + CONV_C_EXPERTS * 256;
constexpr int NCONV_E = NCONV_A + 12 * 6 + 16 * 4 + 256 + 16 * 16 * 16;
constexpr int NCONV = NCONV_E + 16 * 16 * 8;
static_assert(NCONV_A % 4 == 0 && NCONV_C % 4 == 0 && NCONV_E % 4 == 0 && NCONV % 4 == 0, "pairs, two per grab");
DEVI void conv_queue(const Params& p, char* smem, int q, int jbase, int jend) {
  int t = threadIdx.x; asm volatile("" : "+v"(t));
  unsigned* ctr = (unsigned*)(p.ws + OFF_BAR) + 16 * q;
  int* nxt = (int*)(smem + 32768);
  auto grab4 = [&]() -> int { __syncthreads(); if (t == 0) *nxt = jbase + (int)atomicAdd(ctr, 4u); __syncthreads(); return *nxt; };
  int jb = grab4(), jo = 0;
  if (jb < jend) {
    ConvTile c = conv_desc(p, jb, t); float v[16]; conv_load(c, v);
    for (;;) {
      int jn;
      if (jo < 1) { ++jo; jn = jb + 2 * jo; } else { jb = grab4(); jo = 0; jn = jb; }
      const bool more = jn < jend;
      ConvTile cn = c; float vn[16];
      if (more) { cn = conv_desc(p, jn, t); conv_load(cn, vn); }
      conv_finish(c, v, t);
      if (!more) break;
      c = cn;
#pragma unroll
      for (int i = 0; i < 16; ++i) v[i] = vn[i];
    }
  }
}

DEVI void phase_A(const Params& p, int bid, int nb, char* smem) {
  constexpr int N_MOD = 192, N_MISC = 1, N_WRT = 20, N_BT = 120;
  constexpr int I0 = N_MOD + N_MISC + N_WRT + N_BT;
  for (int it = bid; it < I0; it += nb) {
    if (it < N_MOD) modgemv_item(p, it, smem);
    else if (it < N_MOD + N_MISC) misc_item(p);
    else if (it < N_MOD + N_MISC + N_WRT) wrt_item(p, it - N_MOD - N_MISC);
    else bt_item(p, it - N_MOD - N_MISC - N_WRT);
  }
  conv_queue(p, smem, 0, 0, NCONV_A);
}

DEVI void phase_B(const Params& p, int bid, int nb) {
  int tx = threadIdx.x; asm volatile("" : "+v"(tx));
  const int lane = tx & 63, wv = tx >> 6;
  const float* mod = (const float*)(p.ws + OFF_MOD); act_t* hx = (act_t*)(p.ws + OFF_HXALL);
  const int nw = nb * NWAVES;
  for (int r0 = bid * NWAVES + wv; r0 < RR; r0 += 4 * nw) {
    float4 v[4][4]; const float* src[4]; int mrow[4];
#pragma unroll
    for (int q = 0; q < 4; ++q) { int row = r0 + q * nw; row = row < RR ? row : r0; const int b = row / RB, rb = row - b * RB;
      src[q] = rb < CTXL ? p.ctx + (size_t)(b * CTXL + rb) * 1024 : p.x + (size_t)(b * SEQ + rb - CTXL) * 1024; mrow[q] = rb < CTXL ? 2 : b;
#pragma unroll
      for (int i = 0; i < 4; ++i) v[q][i] = *(const float4*)(src[q] + lane * 4 + 256 * i); }
#pragma unroll
    for (int q = 0; q < 4; ++q) { const int row = r0 + q * nw; if (row >= RR) continue;
      float ss = 0.f;
#pragma unroll
      for (int i = 0; i < 4; ++i) ss += v[q][i].x * v[q][i].x + v[q][i].y * v[q][i].y + v[q][i].z * v[q][i].z + v[q][i].w * v[q][i].w;
      ss = wave_sum(ss); const float rstd = rsqrtf(ss * (1.f / 1024.f) + EPS);
      const float* sh = mod + mrow[q] * 6144; const float* sc = sh + 1024;
#pragma unroll
      for (int i = 0; i < 4; ++i) { const int k = lane * 4 + 256 * i; const float4 g = *(const float4*)(p.g_attn + k), s1 = *(const float4*)(sc + k), s0 = *(const float4*)(sh + k);
        st4(hx + (size_t)row * 1024 + k, v[q][i].x * rstd * g.x * (1.f + s1.x) + s0.x, v[q][i].y * rstd * g.y * (1.f + s1.y) + s0.y, v[q][i].z * rstd * g.z * (1.f + s1.z) + s0.z, v[q][i].w * rstd * g.w * (1.f + s1.w) + s0.w); } }
  }
}

DEVI void phase_C(const Params& p, int bid, int nb, char* smem) {
  SchedGrid S{66, 9, 66 * 9, nb, bid, 0}; EpiProj8 E{&p};
  g8::gemm_phase<EpiProj8, SchedGrid, false, 1024>((G8_LAS unsigned char*)smem, (const bf16_t*)(p.ws + OFF_HXALL), (const bf16_t*)(p.ws + OFF_WIN), S, E);
}
DEVI void phase_D(const Params& p, int bid, int nb, char* smem) {
  { SchedGrid S{64, 3, 192, nb, bid, 1}; EpiQm8 E{&p};
    g8::gemm_phase<EpiQm8, SchedGrid, false, 384>((G8_LAS unsigned char*)smem, (const bf16_t*)(p.ws + OFF_QLAT), (const bf16_t*)(p.ws + OFF_WUQ), S, E); }
  { int b2 = bid + 64; b2 = b2 >= nb ? b2 - nb : b2;
    SchedGrid S{66, 4, 264, nb, b2, 0}; EpiKv8 E{&p};
    g8::gemm_phase<EpiKv8, SchedGrid, false, 256>((G8_LAS unsigned char*)smem, (const bf16_t*)(p.ws + OFF_KVLAT), (const bf16_t*)(p.ws + OFF_WUKV), S, E); }
}
DEVI void phase_F(const Params& p, int bid, int nb, char* smem) {
  SchedGrid S{64, 4, 256, nb, bid, 0}; EpiOut8 E{&p};
  g8::gemm_phase<EpiOut8, SchedGrid, false, 1024>((G8_LAS unsigned char*)smem, (const bf16_t*)(p.ws + OFF_ATTN), (const bf16_t*)(p.ws + OFF_WOUT), S, E);
}
DEVI void phase_H(const Params& p, int bid, int nb, char* smem) {
  moe_table(p, smem); las_cint* tab = (las_cint*)(smem + SM_TAB); const int MT = tab[16];
  SchedMoe S{tab, (const int*)(p.ws + OFF_ELIST), MT, MT * 4, nb, bid}; EpiGU8 E{&p, tab};
  g8::gemm_phase<EpiGU8, SchedMoe, true, 1024>((G8_LAS unsigned char*)smem, (const bf16_t*)(p.ws + OFF_HX2), (const bf16_t*)(p.ws + OFF_WGU), S, E);
}
DEVI void phase_I(const Params& p, int bid, int nb, char* smem) {
  moe_table(p, smem); las_cint* tab = (las_cint*)(smem + SM_TAB); const int MT = tab[16];
  SchedMoe S{tab, (const int*)(p.ws + OFF_ELIST), MT, MT * 4, nb, bid}; EpiDown8 E{&p, tab};
  g8::gemm_phase<EpiDown8, SchedMoe, false, 512>((G8_LAS unsigned char*)smem, (const bf16_t*)(p.ws + OFF_HID), (const bf16_t*)(p.ws + OFF_WD), S, E);
}

typedef s16x4 __attribute__((address_space(3))) las_s16x4;
DEVI bf16x8 pack8(const f32x16& s, int base) {
  u32x4 w = {pk2(s[base], s[base + 1]), pk2(s[base + 2], s[base + 3]), pk2(s[base + 4], s[base + 5]), pk2(s[base + 6], s[base + 7])};
  return __builtin_bit_cast(bf16x8, w);
}
DEVI bf16x8 tr_pair(const char* p) {
  const s16x4 lo = __builtin_amdgcn_ds_read_tr16_b64_v4i16((las_s16x4*)(p));
  const s16x4 hh = __builtin_amdgcn_ds_read_tr16_b64_v4i16((las_s16x4*)(p + 8 * 64));
  return (bf16x8){lo[0], lo[1], lo[2], lo[3], hh[0], hh[1], hh[2], hh[3]};
}
template <bool S00, bool S11>
DEVI void pv_block_skip(const char* Vs, int vb, const f32x16& s0, const f32x16& s1, f32x16& o0, f32x16& o1) {
  const char* v0 = Vs + vb; const char* v1 = Vs + 4096 + vb;
  if (!S00) { const bf16x8 p00 = pack8(s0, 0); o0 = __builtin_amdgcn_mfma_f32_32x32x16_bf16(tr_pair(v0), p00, o0, 0, 0, 0); o1 = __builtin_amdgcn_mfma_f32_32x32x16_bf16(tr_pair(v1), p00, o1, 0, 0, 0); }
  { const bf16x8 p01 = pack8(s0, 8); o0 = __builtin_amdgcn_mfma_f32_32x32x16_bf16(tr_pair(v0 + 16 * 64), p01, o0, 0, 0, 0); o1 = __builtin_amdgcn_mfma_f32_32x32x16_bf16(tr_pair(v1 + 16 * 64), p01, o1, 0, 0, 0); }
  { const bf16x8 p10 = pack8(s1, 0); o0 = __builtin_amdgcn_mfma_f32_32x32x16_bf16(tr_pair(v0 + 32 * 64), p10, o0, 0, 0, 0); o1 = __builtin_amdgcn_mfma_f32_32x32x16_bf16(tr_pair(v1 + 32 * 64), p10, o1, 0, 0, 0); }
  if (!S11) { const bf16x8 p11 = pack8(s1, 8); o0 = __builtin_amdgcn_mfma_f32_32x32x16_bf16(tr_pair(v0 + 48 * 64), p11, o0, 0, 0, 0); o1 = __builtin_amdgcn_mfma_f32_32x32x16_bf16(tr_pair(v1 + 48 * 64), p11, o1, 0, 0, 0); }
}
DEVI void pv_block(const char* Vs, int vb, const f32x16& s0, const f32x16& s1, f32x16& o0, f32x16& o1) {
  const bf16x8 p00 = pack8(s0, 0), p01 = pack8(s0, 8), p10 = pack8(s1, 0), p11 = pack8(s1, 8);
  const char* v0 = Vs + vb; const char* v1 = Vs + 4096 + vb;
  o0 = __builtin_amdgcn_mfma_f32_32x32x16_bf16(tr_pair(v0), p00, o0, 0, 0, 0);
  o0 = __builtin_amdgcn_mfma_f32_32x32x16_bf16(tr_pair(v0 + 16 * 64), p01, o0, 0, 0, 0);
  o0 = __builtin_amdgcn_mfma_f32_32x32x16_bf16(tr_pair(v0 + 32 * 64), p10, o0, 0, 0, 0);
  o0 = __builtin_amdgcn_mfma_f32_32x32x16_bf16(tr_pair(v0 + 48 * 64), p11, o0, 0, 0, 0);
  o1 = __builtin_amdgcn_mfma_f32_32x32x16_bf16(tr_pair(v1), p00, o1, 0, 0, 0);
  o1 = __builtin_amdgcn_mfma_f32_32x32x16_bf16(tr_pair(v1 + 16 * 64), p01, o1, 0, 0, 0);
  o1 = __builtin_amdgcn_mfma_f32_32x32x16_bf16(tr_pair(v1 + 32 * 64), p10, o1, 0, 0, 0);
  o1 = __builtin_amdgcn_mfma_f32_32x32x16_bf16(tr_pair(v1 + 48 * 64), p11, o1, 0, 0, 0);
}
template <int DQK, bool BIAS>
DEVI void flash_tile(const char* Ks, const char* Vs, const bf16x8 (&qf)[DQK / 16], f32x16& o0, f32x16& o1, float& m, float& l, const float* bt, int r32, int hi, int vb) {
  constexpr int KROW = DQK * 2 + 16;
  f32x16 s0, s1;
#pragma unroll
  for (int r = 0; r < 16; ++r) { s0[r] = 0.f; s1[r] = 0.f; }
#pragma unroll
  for (int s = 0; s < DQK / 16; ++s) {
    const bf16x8 k0 = *(const bf16x8*)(Ks + r32 * KROW + (16 * s + 8 * hi) * 2);
    const bf16x8 k1 = *(const bf16x8*)(Ks + (32 + r32) * KROW + (16 * s + 8 * hi) * 2);
    s0 = __builtin_amdgcn_mfma_f32_32x32x16_bf16(k0, qf[s], s0, 0, 0, 0);
    s1 = __builtin_amdgcn_mfma_f32_32x32x16_bf16(k1, qf[s], s1, 0, 0, 0);
  }
  if (BIAS) {
#pragma unroll
    for (int r = 0; r < 16; ++r) { s0[r] += bt[crow(r, hi) * 64]; s1[r] += bt[(32 + crow(r, hi)) * 64]; }
  }
  float mx = fmaxf(s0[0], s1[0]);
#pragma unroll
  for (int r = 1; r < 16; ++r) mx = fmaxf(mx, fmaxf(s0[r], s1[r]));
  mx = xhalf_max(mx);
  const float mn = fmaxf(m, mx), alpha = __builtin_amdgcn_exp2f(m - mn); m = mn;
  float ps = 0.f;
#pragma unroll
  for (int r = 0; r < 16; ++r) { s0[r] = __builtin_amdgcn_exp2f(s0[r] - mn); s1[r] = __builtin_amdgcn_exp2f(s1[r] - mn); ps += s0[r] + s1[r]; }
  ps = xhalf_sum(ps); l = l * alpha + ps;
#pragma unroll
  for (int r = 0; r < 16; ++r) { o0[r] *= alpha; o1[r] *= alpha; }
  pv_block(Vs, vb, s0, s1, o0, o1);
}
template <int DQK, bool BIAS, bool NOSHIFT = false, int QB = -1>
DEVI void flash_tile_shift(const char* Ks, const char* Vs, const bf16x8 (&qf)[DQK / 16], f32x16& o0, f32x16& o1, float& l, float negM, const f32x16& bi0, const f32x16& bi1, int r32, int hi, int vb) {
  constexpr int KROW = DQK * 2 + 16;
  f32x16 s0, s1;
#pragma unroll
  for (int r = 0; r < 16; ++r) { if (NOSHIFT) { s0[r] = BIAS ? bi0[r] : 0.f; s1[r] = BIAS ? bi1[r] : 0.f; } else { s0[r] = BIAS ? bi0[r] + negM : negM; s1[r] = BIAS ? bi1[r] + negM : negM; } }
#pragma unroll
  for (int s = 0; s < DQK / 16; ++s) {
    const bf16x8 k0 = *(const bf16x8*)(Ks + r32 * KROW + (16 * s + 8 * hi) * 2);
    const bf16x8 k1 = *(const bf16x8*)(Ks + (32 + r32) * KROW + (16 * s + 8 * hi) * 2);
    s0 = __builtin_amdgcn_mfma_f32_32x32x16_bf16(k0, qf[s], s0, 0, 0, 0);
    s1 = __builtin_amdgcn_mfma_f32_32x32x16_bf16(k1, qf[s], s1, 0, 0, 0);
  }
  float ps = 0.f;
#pragma unroll
  for (int r = 0; r < 16; ++r) {
    if (QB == 1 && r < 12) s0[r] = 0.f; else { s0[r] = __builtin_amdgcn_exp2f(s0[r]); ps += s0[r]; }
    if (QB == 0 && r >= 4) s1[r] = 0.f; else { s1[r] = __builtin_amdgcn_exp2f(s1[r]); ps += s1[r]; } }
  l += ps;
  if (QB == 0) pv_block_skip<false, true>(Vs, vb, s0, s1, o0, o1);
  else if (QB == 1) pv_block_skip<true, false>(Vs, vb, s0, s1, o0, o1);
  else pv_block(Vs, vb, s0, s1, o0, o1);
}
DEVI void flash_store(bf16_t* op, const f32x16& o0, const f32x16& o1, float l, int hi) {
  const float rl = 1.f / l;
#pragma unroll
  for (int blk = 0; blk < 2; ++blk)
#pragma unroll
    for (int k = 0; k < 2; ++k) {
      const f32x16& o = blk ? o1 : o0;
      const unsigned a0 = pk2(o[8 * k] * rl, o[8 * k + 1] * rl), a1 = pk2(o[8 * k + 2] * rl, o[8 * k + 3] * rl);
      const unsigned b0 = pk2(o[8 * k + 4] * rl, o[8 * k + 5] * rl), b1 = pk2(o[8 * k + 6] * rl, o[8 * k + 7] * rl);
      const auto r0 = __builtin_amdgcn_permlane32_swap(a0, b0, false, false); const auto r1 = __builtin_amdgcn_permlane32_swap(a1, b1, false, false);
      const u32x4 w = {r0[0], r1[0], r0[1], r1[1]};
      *(u32x4*)(op + 32 * blk + 16 * k + 8 * hi) = w; }
}

#define MLA_SB __builtin_amdgcn_sched_barrier(0)
template <int KN, int VC>
DEVI void mla_step(char* smem, const char* ws, unsigned& gk, unsigned& gv, unsigned& gh, unsigned sk, unsigned sh, int lk, int lv, int lh,
                   const bf16x8 (&qf)[6], f32x16& c0, f32x16& c1, f32x16& n0, f32x16& n1, f32x16& o0, f32x16& o1, float (&l4)[4], const f32x16& negMv, int koff, int vb,
                   u32x4& lrk, u32x4& lrv, uint2& lrh, const u32x4& rk, const u32x4& rv, const uint2& rh) {
  constexpr int KROW = 208, KBYTES = 64 * KROW, VOFF = 2 * KBYTES;
  const char* Kn = smem + KN * KBYTES + koff;
  const char* V0 = smem + VOFF + VC * 8192 + vb; const char* V1 = V0 + 4096;
  lrk = *(const u32x4*)(ws + gk); lrv = *(const u32x4*)(ws + gv); lrh = *(const uint2*)(ws + gh);
  gk += sk; gv += 64u * 1024u * 2u; gh += sh;
  bf16x8 kf[12], pf[4], vf[4], vg[4];
#define MLA_KLD(g) kf[g] = *(const bf16x8*)(Kn + ((g) & 1) * 32 * KROW + ((g) >> 1) * 32)
  MLA_KLD(0); MLA_KLD(1); MLA_KLD(2);
  MLA_SB;
  constexpr int ELO[13] = {0, 3, 6, 9, 10, 13, 16, 17, 20, 23, 24, 28, 32};
#pragma unroll
  for (int g = 0; g < 12; ++g) {
    if (g + 3 < 12) MLA_KLD(g + 3);
    if (g >= 8) vf[g - 8] = tr_pair(V0 + (g - 8) * 16 * 64);
    if ((g & 1) == 0) n0 = __builtin_amdgcn_mfma_f32_32x32x16_bf16(kf[g], qf[g >> 1], g < 2 ? negMv : n0, 0, 0, 0);
    else              n1 = __builtin_amdgcn_mfma_f32_32x32x16_bf16(kf[g], qf[g >> 1], g < 2 ? negMv : n1, 0, 0, 0);
    MLA_SB;
#pragma unroll
    for (int e = ELO[g]; e < ELO[g + 1]; ++e) { if (e < 16) c0[e] = __builtin_amdgcn_exp2f(c0[e]); else c1[e - 16] = __builtin_amdgcn_exp2f(c1[e - 16]); }
    if (g == 3) pf[0] = pack8(c0, 0);
    if (g == 6) pf[1] = pack8(c0, 8);
    if (g == 9) pf[2] = pack8(c1, 0);
    MLA_SB;
  }
#undef MLA_KLD
#pragma unroll
  for (int hh = 0; hh < 8; ++hh) {
    if (hh < 4) vg[hh] = tr_pair(V1 + hh * 16 * 64);
    if (hh < 4) o0 = __builtin_amdgcn_mfma_f32_32x32x16_bf16(vf[hh], pf[hh], o0, 0, 0, 0);
    else        o1 = __builtin_amdgcn_mfma_f32_32x32x16_bf16(vg[hh - 4], pf[hh - 4], o1, 0, 0, 0);
    MLA_SB;
    if (hh == 0) pf[3] = pack8(c1, 8);
#pragma unroll
    for (int e = 4 * hh; e < 4 * hh + 4; ++e) { const float pv_ = e < 16 ? c0[e] : c1[e - 16]; asm volatile("v_add_f32_e32 %0, %1, %0" : "+v"(l4[e & 3]) : "v"(pv_)); }
    if (hh == 5) *(u32x4*)(smem + (1 - KN) * KBYTES + lk) = rk;
    if (hh == 6) *(u32x4*)(smem + (1 - VC) * 8192 + lv) = rv;
    if (hh == 7) *(uint2*)(smem + (1 - KN) * KBYTES + lh) = rh;
    MLA_SB;
  }
  __syncthreads();
}

DEVI void mla_unit(const Params& p, int unit, char* smem) {
  constexpr int KROW = 208, KBYTES = 64 * KROW  , VOFF = 2 * KBYTES;
  const int t = threadIdx.x, lane = t & 63, w = t >> 6, r32 = lane & 31, hi = lane >> 5;
  const int qblk = unit & 31, h = (unit >> 5) & 7, b = unit >> 8;
  const char* ws = p.ws;
  const size_t qrow = (size_t)b * RB + CTXL + qblk * 256 + w * 32 + r32;
  bf16x8 qf[6];
  { const bf16_t* qp = (const bf16_t*)p.out + qrow * 768 + h * 96 + hi * 8;
#pragma unroll
    for (int s = 0; s < 6; ++s) qf[s] = *(const bf16x8*)(qp + 16 * s); }
  unsigned gk, gv, gh, sk, sh; int lk, lv, lh;
  { const int key = t / 12, ch = t - key * 12;
    if (ch < 8) { gk = (unsigned)OFF_KV + (unsigned)(((b * RB + key) * 1024 + h * 128 + ch * 8) * 2); sk = 64u * 1024u * 2u; }
    else { gk = (unsigned)OFF_KROPE + (unsigned)(((b * RB + key) * 32 + (ch - 8) * 8) * 2); sk = 64u * 32u * 2u; }
    lk = key * KROW + ch * 16; }
  { const int c = 512 + (t >> 1), key = c / 12, ch = c - key * 12, hf = t & 1;
    if (ch < 8) { gh = (unsigned)OFF_KV + (unsigned)(((b * RB + key) * 1024 + h * 128 + ch * 8 + hf * 4) * 2); sh = 64u * 1024u * 2u; }
    else { gh = (unsigned)OFF_KROPE + (unsigned)(((b * RB + key) * 32 + (ch - 8) * 8 + hf * 4) * 2); sh = 64u * 32u * 2u; }
    lh = key * KROW + ch * 16 + hf * 8; }
  { const int key = t >> 3, ch = t & 7; gv = (unsigned)OFF_KV + (unsigned)(((b * RB + key) * 1024 + h * 128 + 64 + ch * 8) * 2); lv = VOFF + (ch >> 2) * 4096 + key * 64 + (ch & 3) * 16; }
  const int vb = (((lane & 15) >> 2) + 4 * hi) * 64 + (16 * ((lane >> 4) & 1) + 4 * (lane & 3)) * 2;
  f32x16 o0, o1;
#pragma unroll
  for (int r = 0; r < 16; ++r) { o0[r] = 0.f; o1[r] = 0.f; }
  float q2 = 0.f;
#pragma unroll
  for (int s = 0; s < 6; ++s)
#pragma unroll
    for (int e = 0; e < 8; ++e) { const float x = bf2f((bf16_t)qf[s][e]); q2 = fmaf(x, x, q2); }
  q2 = xhalf_sum(q2);
  const float* kmw = (const float*)(ws + OFF_KMAX);
  const float Mq = 1.01f * sqrtf(q2 * (kmw[KM_KN + b * 16 + h * 2] + kmw[KM_KN + b * 16 + h * 2 + 1] + kmw[KM_KR + b]));
  bool shift_ok;
  { volatile __attribute__((address_space(3))) unsigned* vw = (volatile __attribute__((address_space(3))) unsigned*)(smem + SM_BARW) + 6;
    const bool bad_w = __any(!(Mq < 64.f));
    __syncthreads(); if (t == 0) *vw = 0u; __syncthreads(); if (bad_w && lane == 0) *vw = 1u; __syncthreads();
    shift_ok = __builtin_amdgcn_readfirstlane((int)*vw) == 0; }
  constexpr int NT = RB / 64;
  float l;
  { const u32x4 rk = *(const u32x4*)(ws + gk); const u32x4 rv = *(const u32x4*)(ws + gv); const uint2 rh = *(const uint2*)(ws + gh);
    gk += sk; gv += 64u * 1024u * 2u; gh += sh;
    __syncthreads();
    *(u32x4*)(smem + lk) = rk; *(u32x4*)(smem + lv) = rv; *(uint2*)(smem + lh) = rh; }
  if (shift_ok) {
    { const u32x4 rk = *(const u32x4*)(ws + gk); const uint2 rh = *(const uint2*)(ws + gh); gk += sk; gh += sh;
      *(u32x4*)(smem + KBYTES + lk) = rk; *(uint2*)(smem + KBYTES + lh) = rh; }
    __syncthreads();
    const int koff = r32 * KROW + hi * 16;
    f32x16 negMv;
#pragma unroll
    for (int r = 0; r < 16; ++r) negMv[r] = -Mq;
    f32x16 a0, a1, b0, b1;
    { const char* Kn = smem + koff;
#pragma unroll
      for (int s = 0; s < 6; ++s) {
        a0 = __builtin_amdgcn_mfma_f32_32x32x16_bf16(*(const bf16x8*)(Kn + s * 32), qf[s], s == 0 ? negMv : a0, 0, 0, 0);
        a1 = __builtin_amdgcn_mfma_f32_32x32x16_bf16(*(const bf16x8*)(Kn + 32 * KROW + s * 32), qf[s], s == 0 ? negMv : a1, 0, 0, 0); } }
    float l4[4] = {0.f, 0.f, 0.f, 0.f};
    u32x4 rkA, rvA, rkB, rvB; uint2 rhA, rhB;
    rkB = *(const u32x4*)(ws + gk); rvB = *(const u32x4*)(ws + gv); rhB = *(const uint2*)(ws + gh); gk += sk; gv += 64u * 1024u * 2u; gh += sh;
#pragma unroll 1
    for (int jj = 0; jj < NT / 2; ++jj) {
      mla_step<1, 0>(smem, ws, gk, gv, gh, sk, sh, lk, lv, lh, qf, a0, a1, b0, b1, o0, o1, l4, negMv, koff, vb, rkA, rvA, rhA, rkB, rvB, rhB);
      mla_step<0, 1>(smem, ws, gk, gv, gh, sk, sh, lk, lv, lh, qf, b0, b1, a0, a1, o0, o1, l4, negMv, koff, vb, rkB, rvB, rhB, rkA, rvA, rhA);
    }
    l = xhalf_sum((l4[0] + l4[1]) + (l4[2] + l4[3]));
  } else {
    __syncthreads();
    float m = -1e30f; l = 0.f;
#pragma unroll 1
    for (int j = 0; j < NT; ++j) {
      const u32x4 rk = *(const u32x4*)(ws + gk); const u32x4 rv = *(const u32x4*)(ws + gv); const uint2 rh = *(const uint2*)(ws + gh);
      gk += sk; gv += 64u * 1024u * 2u; gh += sh;
      flash_tile<96, false>(smem + (j & 1) * KBYTES, smem + VOFF + (j & 1) * 8192, qf, o0, o1, m, l, nullptr, r32, hi, vb);
      char* sw = smem + ((j + 1) & 1) * KBYTES; *(u32x4*)(sw + lk) = rk; *(uint2*)(sw + lh) = rh; *(u32x4*)(smem + ((j + 1) & 1) * 8192 + lv) = rv;
      __syncthreads();
    }
  }
  flash_store((bf16_t*)(ws + OFF_ATTN) + ((size_t)b * SEQ + qblk * 256 + w * 32 + r32) * 1024 + h * 64, o0, o1, l, hi);
}

template <bool BIAS>
DEVI void na_tile_max(const char* Ks, const char* Vs, const bf16x8 (&qf)[4], f32x16& o0, f32x16& o1, float& m, float& l, const f32x16& bi0, const f32x16& bi1, int r32, int hi, int vb) {
  constexpr int KROW = 144;
  f32x16 s0, s1;
#pragma unroll
  for (int r = 0; r < 16; ++r) { s0[r] = BIAS ? bi0[r] : 0.f; s1[r] = BIAS ? bi1[r] : 0.f; }
#pragma unroll
  for (int s = 0; s < 4; ++s) {
    const bf16x8 k0 = *(const bf16x8*)(Ks + r32 * KROW + (16 * s + 8 * hi) * 2), k1 = *(const bf16x8*)(Ks + (32 + r32) * KROW + (16 * s + 8 * hi) * 2);
    s0 = __builtin_amdgcn_mfma_f32_32x32x16_bf16(k0, qf[s], s0, 0, 0, 0); s1 = __builtin_amdgcn_mfma_f32_32x32x16_bf16(k1, qf[s], s1, 0, 0, 0);
  }
  float mx = fmaxf(s0[0], s1[0]);
#pragma unroll
  for (int r = 1; r < 16; ++r) mx = fmaxf(mx, fmaxf(s0[r], s1[r]));
  mx = xhalf_max(mx);
  const float mn = fmaxf(m, mx), alpha = __builtin_amdgcn_exp2f(m - mn); m = mn;
  float ps = 0.f;
#pragma unroll
  for (int r = 0; r < 16; ++r) { s0[r] = __builtin_amdgcn_exp2f(s0[r] - mn); s1[r] = __builtin_amdgcn_exp2f(s1[r] - mn); ps += s0[r] + s1[r]; }
  ps = xhalf_sum(ps); l = l * alpha + ps;
#pragma unroll
  for (int r = 0; r < 16; ++r) { o0[r] *= alpha; o1[r] *= alpha; }
  pv_block(Vs, vb, s0, s1, o0, o1);
}

DEVI void na_unit(const Params& p, int unit, char* smem) {
  constexpr int KROW = 144, KBYTES = 64 * KROW  , STAGE = KBYTES + 8192  ;
  const int t = threadIdx.x, lane = t & 63, w = t >> 6, r32 = lane & 31, hi = lane >> 5;
  const int head = unit & 7, rq = (unit >> 3) & 31, b = unit >> 8;
  const int rr = w >> 1, qb = w & 1, grow = rq * 4 + rr, c = qb * 32 + r32;
  int wstart = grow - 4; wstart = wstart < 0 ? 0 : (wstart > 120 ? 120 : wstart);
  int klo = rq * 4 - 4; klo = klo < 0 ? 0 : (klo > 120 ? 120 : klo);
  int khi = rq * 4 - 1; khi = (khi < 0 ? 0 : (khi > 120 ? 120 : khi)) + 8;
  const int ntw = khi - klo, ntt = ntw + 4;
  const char* ws = p.ws;
  const bf16_t* nak = (const bf16_t*)(ws + OFF_NAK) + (size_t)b * RB * 512 + head * 64;
  const bf16_t* nav = (const bf16_t*)(ws + OFF_NAV) + (size_t)b * RB * 512 + head * 64;
  bf16x8 qf[4];
  { const bf16_t* qp = (const bf16_t*)(ws + OFF_NAQ) + ((size_t)b * RB + CTXL + grow * 64 + c) * 512 + head * 64 + hi * 8;
#pragma unroll
    for (int s = 0; s < 4; ++s) qf[s] = *(const bf16x8*)(qp + 16 * s); }
  const int skey = t >> 3, sch = t & 7;
  const int goff0 = skey * 512 + sch * 8, kdst0 = skey * KROW + sch * 16, vdst0 = KBYTES + (sch >> 2) * 4096 + skey * 64 + (sch & 3) * 16;
  const int vb = (((lane & 15) >> 2) + 4 * hi) * 64 + (16 * ((lane >> 4) & 1) + 4 * (lane & 3)) * 2;
  f32x16 o0, o1;
#pragma unroll
  for (int r = 0; r < 16; ++r) { o0[r] = 0.f; o1[r] = 0.f; }
  float m = -1e30f, l = 0.f;
  const unsigned* btb = (const unsigned*)(ws + OFF_BT) + (size_t)(head * 15) * 2048 + c;
  float q2 = 0.f;
#pragma unroll
  for (int s = 0; s < 4; ++s)
#pragma unroll
    for (int e = 0; e < 8; ++e) { const float x = bf2f((bf16_t)qf[s][e]); q2 = fmaf(x, x, q2); }
  q2 = xhalf_sum(q2);
  const float* kmw = (const float*)(ws + OFF_KMAX);
  const float Mq = 1.01f * sqrtf(q2 * (kmw[KM_NA + b * 16 + head * 2] + kmw[KM_NA + b * 16 + head * 2 + 1])) + kmw[KM_BM + head];
  const bool shift_ok = !__any(!(Mq < 64.f));
  u32x4 rk, rv;
  auto rowbase = [&](int j) -> size_t { return j < ntw ? (size_t)CTXL + (size_t)(klo + j) * 64 : (size_t)(j - ntw) * 64; };
#define NA_STAGE_LOAD(J) { const size_t rb1 = rowbase(J) * 512 + goff0; rk = *(const u32x4*)(nak + rb1); rv = *(const u32x4*)(nav + rb1); }
#define NA_STAGE_WRITE(J) { char* sw = smem + ((J) & 1) * STAGE; *(u32x4*)(sw + kdst0) = rk; *(u32x4*)(sw + vdst0) = rv; }
  NA_STAGE_LOAD(0)
  __syncthreads();
  NA_STAGE_WRITE(0)
  __syncthreads();
  unsigned bp[16];
#define NA_BIAS_LOAD(J) { const int kr_ = klo + (J); if ((J) < ntw && kr_ >= wstart && kr_ < wstart + 8) { const unsigned* bt = btb + (size_t)(kr_ - grow + 7) * 2048; \
      _Pragma("unroll") for (int r = 0; r < 16; ++r) bp[r] = bt[crow(r, hi) * 64]; } }
#define NA_TILE_LOOP(WIN_CALL, CTX_CALL)                                                                                                       \
  NA_BIAS_LOAD(0)                                                                                                                                \
  _Pragma("unroll 1") for (int j = 0; j < ntt; ++j) {                                                                                            \
    const char* st = smem + (j & 1) * STAGE;                                                                                                     \
    const int kr = klo + j; const bool win = j < ntw; const bool active = !win || (kr >= wstart && kr < wstart + 8);           \
    f32x16 bc0, bc1;                                                                                                                             \
    if (win && active) { _Pragma("unroll") for (int r = 0; r < 16; ++r) { bc0[r] = __uint_as_float(bp[r] << 16); bc1[r] = __uint_as_float(bp[r] & 0xffff0000u); } } \
    __builtin_amdgcn_sched_barrier(0);                                                                                                           \
    NA_BIAS_LOAD(j + 1)                                                 \
    __builtin_amdgcn_sched_barrier(0);                                                                                                           \
    if (j + 1 < ntt) NA_STAGE_LOAD(j + 1)                                                                                                        \
    __builtin_amdgcn_sched_barrier(0);                                                                                                           \
    if (active) { if (win) { WIN_CALL; } else { CTX_CALL; } }                                                                                    \
    if (j + 1 < ntt) NA_STAGE_WRITE(j + 1)                                                                                                       \
    __syncthreads();                                                                                                                             \
  }
  if (shift_ok) { if (qb == 0) { NA_TILE_LOOP((flash_tile_shift<64, true, true, 0>(st, st + KBYTES, qf, o0, o1, l, 0.f, bc0, bc1, r32, hi, vb)), (flash_tile_shift<64, false, true>(st, st + KBYTES, qf, o0, o1, l, 0.f, bc0, bc1, r32, hi, vb))) }
    else { NA_TILE_LOOP((flash_tile_shift<64, true, true, 1>(st, st + KBYTES, qf, o0, o1, l, 0.f, bc0, bc1, r32, hi, vb)), (flash_tile_shift<64, false, true>(st, st + KBYTES, qf, o0, o1, l, 0.f, bc0, bc1, r32, hi, vb))) } }
  else { NA_TILE_LOOP((na_tile_max<true>(st, st + KBYTES, qf, o0, o1, m, l, bc0, bc1, r32, hi, vb)), (na_tile_max<false>(st, st + KBYTES, qf, o0, o1, m, l, bc0, bc1, r32, hi, vb))) }
#undef NA_TILE_LOOP
#undef NA_BIAS_LOAD
#undef NA_STAGE_LOAD
#undef NA_STAGE_WRITE
  if (shift_ok) l = xhalf_sum(l);
  flash_store((bf16_t*)(ws + OFF_ATTN) + ((size_t)b * SEQ + grow * 64 + c) * 1024 + 512 + head * 64, o0, o1, l, hi);
}

DEVI void phase_E(const Params& p, int bid, int nb, char* smem) {
  constexpr int UM = NBATCH * 8 * 32, UN = NBATCH * 32 * 8;
  { const int iters = xcd_iters(UM, nb);
    for (int it = 0; it < iters; ++it) { const int u = xcd_unit(bid + it * nb, UM); if (u >= 0) mla_unit(p, u, smem); } }
#if TIMING_PROBE
  if (blockIdx.x == 0 && threadIdx.x == 0) ((unsigned long long*)(p.ws + OFF_CNT + 64))[11] = __builtin_amdgcn_s_memrealtime();
#endif
  { const int iters = xcd_iters(UN, nb);
    for (int it = 0; it < iters; ++it) { const int u = xcd_unit(bid + it * nb, UN); if (u >= 0) na_unit(p, u, smem); } }
#if TIMING_PROBE
  if (blockIdx.x == 0 && threadIdx.x == 0) ((unsigned long long*)(p.ws + OFF_CNT + 64))[12] = __builtin_amdgcn_s_memrealtime();
#endif
}

DEVI void wave_reduce40(float (&v)[40], int lane) {
  { const bool b = lane & 32;
#pragma unroll
    for (int i = 0; i < 20; ++i) { const float keep = b ? v[i + 20] : v[i], send = b ? v[i] : v[i + 20]; v[i] = keep + __shfl_xor(send, 32); } }
  { const bool b = lane & 16;
#pragma unroll
    for (int i = 0; i < 10; ++i) { const float keep = b ? v[i + 10] : v[i], send = b ? v[i] : v[i + 10]; v[i] = keep + __shfl_xor(send, 16); } }
  { const bool b = lane & 8;
#pragma unroll
    for (int i = 0; i < 5; ++i) { const float keep = b ? v[i + 5] : v[i], send = b ? v[i] : v[i + 5]; v[i] = keep + __shfl_xor(send, 8); } }
  { const bool b = lane & 4;
#pragma unroll
    for (int i = 0; i < 3; ++i) { const float hi_ = i + 3 < 5 ? v[i + 3] : 0.f; const float keep = b ? hi_ : v[i], send = b ? v[i] : hi_; v[i] = keep + __shfl_xor(send, 4); } }
  { const bool b = lane & 2;
#pragma unroll
    for (int i = 0; i < 2; ++i) { const float hi_ = i + 2 < 3 ? v[i + 2] : 0.f; const float keep = b ? hi_ : v[i], send = b ? v[i] : hi_; v[i] = keep + __shfl_xor(send, 2); } }
  { const bool b = lane & 1;
    const float keep = b ? v[1] : v[0], send = b ? v[0] : v[1]; v[0] = keep + __shfl_xor(send, 1); }
}
template <int IDX> DEVI float reduce40_get(float v0) {
  constexpr int k = IDX % 5, low3 = k < 3 ? k : k + 1;
  constexpr int src = (IDX / 20) * 32 + ((IDX % 20) / 10) * 16 + ((IDX % 10) / 5) * 8 + low3;
  return __builtin_bit_cast(float, __builtin_amdgcn_readlane(__builtin_bit_cast(int, v0), src));
}
DEVI void route_token(const float (&lg)[20], int tl, int lane, int* te, float* tw) {
  int gs = 0; float gm = lg[0];
#pragma unroll
  for (int j = 1; j < 4; ++j) if (lg[j] > gm) { gm = lg[j]; gs = j; }
  float z = 0.f;
#pragma unroll
  for (int j = 0; j < 4; ++j) z += expf(lg[j] - gm);
  const float gw = 1.f / z;
  const float c0 = gs == 0 ? 1.f : 0.f, c1 = gs == 1 ? 1.f : 0.f, c2 = gs == 2 ? 1.f : 0.f, c3 = gs == 3 ? 1.f : 0.f;
  float e4[4];
#pragma unroll
  for (int j = 0; j < 4; ++j) e4[j] = c0 * lg[4 + j] + c1 * lg[8 + j] + c2 * lg[12 + j] + c3 * lg[16 + j];
  int i1 = 0; float m1 = e4[0];
#pragma unroll
  for (int j = 1; j < 4; ++j) if (e4[j] > m1) { m1 = e4[j]; i1 = j; }
  int i2 = -1; float m2 = -3.0e38f;
#pragma unroll
  for (int j = 0; j < 4; ++j) if (j != i1 && e4[j] > m2) { m2 = e4[j]; i2 = j; }
  const float ex = expf(m2 - m1), w1 = 1.f / (1.f + ex), w2 = ex / (1.f + ex);
  if (lane == 0) { te[tl * 2] = gs * 4 + i1; te[tl * 2 + 1] = gs * 4 + i2; tw[tl * 2] = gw * w1; tw[tl * 2 + 1] = gw * w2; }
}
DEVI void phase_G(const Params& p, int bid, int nb, char* smem) {
  int t = threadIdx.x; asm volatile("" : "+v"(t));
  const int lane = t & 63, wv = t >> 6;
  int* te = (int*)smem; float* tw = (float*)(smem + 256);
  const float* mod = (const float*)(p.ws + OFF_MOD); act_t* hx2 = (act_t*)(p.ws + OFF_HX2);
  const float* wrt = (const float*)(smem + 1024);
  { const f32x4* src = (const f32x4*)(p.ws + OFF_WRT); f32x4* dst = (f32x4*)(smem + 1024);
    __syncthreads();
#pragma unroll
    for (int i = 0; i < 10; ++i) dst[t + 512 * i] = src[t + 512 * i];
    __syncthreads(); }
  int* cnt = (int*)(p.ws + OFF_CNT); int* elist = (int*)(p.ws + OFF_ELIST); float* ewt = (float*)(p.ws + OFF_EW);
  for (int ch = bid; ch < TT / 32; ch += nb) {
    __syncthreads();
    const int b = (ch * 32) >> 13; const float* sh = mod + b * 6144 + 3072; const float* sc = sh + 1024;
#pragma unroll 1
    for (int q = 0; q < 4; q += 2) {
      const int tl = wv * 4 + q, tok = ch * 32 + tl;
      const act_t* xa = (const act_t*)(p.ws + OFF_X1) + (size_t)tok * 1024 + lane * 4; const act_t* xb = xa + 1024;
      float sa = 0.f, sb = 0.f;
      { float va[4][4], vb[4][4];
#pragma unroll
        for (int i = 0; i < 4; ++i) { ld4(xa + 256 * i, va[i]); ld4(xb + 256 * i, vb[i]); }
#pragma unroll
        for (int i = 0; i < 4; ++i) { sa += va[i][0] * va[i][0] + va[i][1] * va[i][1] + va[i][2] * va[i][2] + va[i][3] * va[i][3]; sb += vb[i][0] * vb[i][0] + vb[i][1] * vb[i][1] + vb[i][2] * vb[i][2] + vb[i][3] * vb[i][3]; } }
      sa = wave_sum(sa); sb = wave_sum(sb);
      const float ra = rsqrtf(sa * (1.f / 1024.f) + EPS), rb = rsqrtf(sb * (1.f / 1024.f) + EPS);
      float la[20], lb[20];
#pragma unroll
      for (int j = 0; j < 20; ++j) { la[j] = 0.f; lb[j] = 0.f; }
#pragma unroll 1
      for (int i = 0; i < 4; ++i) {
        const int k = lane * 4 + 256 * i;
        float4 va, vb; { float ta[4], tb[4]; ld4(xa + 256 * i, ta); ld4(xb + 256 * i, tb); va = make_float4(ta[0], ta[1], ta[2], ta[3]); vb = make_float4(tb[0], tb[1], tb[2], tb[3]); }
        const float4 g = *(const float4*)(p.g_ffn + k), s1 = *(const float4*)(sc + k), s0 = *(const float4*)(sh + k);
        const float gx = g.x * (1.f + s1.x), gy = g.y * (1.f + s1.y), gz = g.z * (1.f + s1.z), gw = g.w * (1.f + s1.w);
        const float4 ha = make_float4(va.x * ra * gx + s0.x, va.y * ra * gy + s0.y, va.z * ra * gz + s0.z, va.w * ra * gw + s0.w);
        const float4 hb = make_float4(vb.x * rb * gx + s0.x, vb.y * rb * gy + s0.y, vb.z * rb * gz + s0.z, vb.w * rb * gw + s0.w);
        st4(hx2 + (size_t)tok * 1024 + k, ha.x, ha.y, ha.z, ha.w); st4(hx2 + (size_t)(tok + 1) * 1024 + k, hb.x, hb.y, hb.z, hb.w);
        const float* wk = wrt + k;
#pragma unroll
        for (int jg = 0; jg < 20; jg += 10) {
          float4 w[10];
#pragma unroll
          for (int u = 0; u < 10; ++u) w[u] = *(const float4*)(wk + (jg + u) * 1024);
#pragma unroll
          for (int u = 0; u < 10; ++u) {
            la[jg + u] = fmaf(ha.x, w[u].x, fmaf(ha.y, w[u].y, fmaf(ha.z, w[u].z, fmaf(ha.w, w[u].w, la[jg + u]))));
            lb[jg + u] = fmaf(hb.x, w[u].x, fmaf(hb.y, w[u].y, fmaf(hb.z, w[u].z, fmaf(hb.w, w[u].w, lb[jg + u])))); }
        }
      }
      { float v40[40];
#pragma unroll
        for (int j = 0; j < 20; ++j) { v40[j] = la[j]; v40[20 + j] = lb[j]; }
        wave_reduce40(v40, lane);
        const float r0 = v40[0];
#define G_GET(J) la[J] = reduce40_get<J>(r0); lb[J] = reduce40_get<20 + J>(r0);
        G_GET(0) G_GET(1) G_GET(2) G_GET(3) G_GET(4) G_GET(5) G_GET(6) G_GET(7) G_GET(8) G_GET(9) G_GET(10) G_GET(11) G_GET(12) G_GET(13) G_GET(14) G_GET(15) G_GET(16) G_GET(17) G_GET(18) G_GET(19)
#undef G_GET
      }
#pragma unroll
      for (int j = 0; j < 4; ++j) { la[j] += p.b_rg[j]; lb[j] += p.b_rg[j]; }
#pragma unroll
      for (int j = 0; j < 16; ++j) { la[4 + j] += p.b_re[j]; lb[4 + j] += p.b_re[j]; }
      route_token(la, tl, lane, te, tw); route_token(lb, tl + 1, lane, te, tw);
    }
    __syncthreads();
    if (wv == 0) {
      const int my_e = te[lane]; const float my_w = tw[lane];
      unsigned long long me_mask = 0ull; int my_n = 0;
#pragma unroll
      for (int e = 0; e < 16; ++e) { const unsigned long long mk = __ballot(my_e == e); if (my_e == e) me_mask = mk; if (lane == e) my_n = __popcll(mk); }
      int base = 0; if (lane < 16 && my_n) base = atomicAdd(&cnt[lane], my_n);
      const int my_base = __shfl(base, my_e);
      const int rank = __popcll(me_mask & ((1ull << lane) - 1ull));
      const int slot = my_base + rank;
      elist[(size_t)my_e * TT + slot] = (ch * 32 + (lane >> 1)) * 2 + (lane & 1); ewt[(size_t)my_e * TT + slot] = my_w;
    }
  }
}

DEVI void phase_J(const Params& p, int bid, int nb) {
  int tx = threadIdx.x; asm volatile("" : "+v"(tx));
  const int lane = tx & 63, wv = tx >> 6;
  const float* mod = (const float*)(p.ws + OFF_MOD); const act_t* yb = (const act_t*)(p.ws + OFF_YBUF);
  for (int tok0 = (bid * NWAVES + wv) * 4; tok0 < TT; tok0 += nb * NWAVES * 4) {
    const int b = tok0 >> 13; const float* g2 = mod + b * 6144 + 5120;
    float4 xv[4][4]; float y0[4][4][4], y1[4][4][4];
#pragma unroll
    for (int q = 0; q < 4; ++q)
#pragma unroll
      for (int i = 0; i < 4; ++i) { const int k = lane * 4 + 256 * i; { float tx4[4]; ld4((const act_t*)(p.ws + OFF_X1) + (size_t)(tok0 + q) * 1024 + k, tx4); xv[q][i] = make_float4(tx4[0], tx4[1], tx4[2], tx4[3]); }
        ld4(yb + (size_t)(tok0 + q) * 1024 + k, y0[q][i]); ld4(yb + ((size_t)TT + tok0 + q) * 1024 + k, y1[q][i]); }
#pragma unroll
    for (int q = 0; q < 4; ++q) {
      float* xo = p.out + (size_t)(tok0 + q) * 1024; float o[16]; float ss = 0.f;
#pragma unroll
      for (int i = 0; i < 4; ++i) { const int k = lane * 4 + 256 * i; const float4 g = *(const float4*)(g2 + k);
        o[4 * i] = xv[q][i].x + g.x * (y0[q][i][0] + y1[q][i][0]); o[4 * i + 1] = xv[q][i].y + g.y * (y0[q][i][1] + y1[q][i][1]);
        o[4 * i + 2] = xv[q][i].z + g.z * (y0[q][i][2] + y1[q][i][2]); o[4 * i + 3] = xv[q][i].w + g.w * (y0[q][i][3] + y1[q][i][3]);
        ss += o[4 * i] * o[4 * i] + o[4 * i + 1] * o[4 * i + 1] + o[4 * i + 2] * o[4 * i + 2] + o[4 * i + 3] * o[4 * i + 3]; }
      ss = wave_sum(ss); const float rstd = rsqrtf(ss * (1.f / 1024.f) + EPS);
#pragma unroll
      for (int i = 0; i < 4; ++i) { const int k = lane * 4 + 256 * i; const float4 g = *(const float4*)(p.g_final + k);
        *(float4*)(xo + k) = make_float4(o[4 * i] * rstd * g.x, o[4 * i + 1] * rstd * g.y, o[4 * i + 2] * rstd * g.z, o[4 * i + 3] * rstd * g.w); }
    }
  }
}

#if ONE_LAUNCH
#define XB_TMO      128
#define XB_XCNT(j)  (256  + 64 * (j))
#define XB_XSUB(j)  (1280 + 64 * (j))
#define XB_XGEN(j)  (2304 + 64 * (j))
#define XB_TOP      3328
#define XB_TOPGEN   3392
#define XCD_BAR_WORDS 3456
#define XB_SPIN_CAP (1u << 20)
#define LAS __attribute__((address_space(3)))
DEVI unsigned xb_ld(unsigned* p)              { return __hip_atomic_load(p, __ATOMIC_RELAXED, __HIP_MEMORY_SCOPE_AGENT); }
DEVI unsigned xb_add(unsigned* p, unsigned v) { return __hip_atomic_fetch_add(p, v, __ATOMIC_RELAXED, __HIP_MEMORY_SCOPE_AGENT); }
DEVI unsigned xb_xcc_id() { return (unsigned)__builtin_amdgcn_s_getreg((3 << 11) | 20) & 0xFu; }
#define XB_SPIN(cond, bar) do { unsigned _sp = 0; while (cond) { __builtin_amdgcn_s_sleep(1); \
    if ((++_sp & 255u) == 0u) { if (xb_ld(&(bar)[XB_TMO])) break; if (_sp > XB_SPIN_CAP) { atomicAdd(&(bar)[XB_TMO], 1u); break; } } } } while (0)
struct XcdBarrier { unsigned* bar; unsigned x; volatile LAS unsigned* st; };
DEVI XcdBarrier xcd_barrier_post(unsigned* bar, volatile LAS unsigned* st) {
  XcdBarrier b; b.bar = bar; b.x = xb_xcc_id(); b.st = st;
  if (threadIdx.x == 0) st[2] = xb_add(&bar[XB_XCNT(b.x)], 1u);
  return b;
}
DEVI void xcd_barrier_complete(unsigned* bar, unsigned x, unsigned& nloc, unsigned& nx) {
  const unsigned G = gridDim.x * gridDim.y * gridDim.z;
  unsigned sum, cnt, mine, sp = 0u;
  for (;;) {
    sum = 0u; cnt = 0u; mine = 0u;
#pragma unroll
    for (unsigned j = 0; j < 16; ++j) { const unsigned c = xb_ld(&bar[XB_XCNT(j)]); sum += c; cnt += (c > 0u) ? 1u : 0u; mine = (j == x) ? c : mine; }
    if (sum == G) break;
    __builtin_amdgcn_s_sleep(1);
    if ((++sp & 255u) == 0u) { if (xb_ld(&bar[XB_TMO])) break; if (sp > XB_SPIN_CAP) { atomicAdd(&bar[XB_TMO], 1u); break; } }
  }
  nloc = mine > 0u ? mine : 1u; nx = cnt > 0u ? cnt : 1u;
}
DEVI void xcd_barrier(const XcdBarrier& b) {
  asm volatile("s_waitcnt vmcnt(0)" ::: "memory");
  __syncthreads();
  if (threadIdx.x == 0) {
    unsigned* bar = b.bar;
    __builtin_amdgcn_s_waitcnt(0);
    unsigned nloc = b.st[0], nx = b.st[1];
    if (nloc == 0u) { xcd_barrier_complete(bar, b.x, nloc, nx); b.st[0] = nloc; b.st[1] = nx; }
    const unsigned old = xb_add(&bar[XB_XSUB(b.x)], 1u);
    const unsigned gen = old / nloc;
    if (old + 1u == (gen + 1u) * nloc) {
      __builtin_amdgcn_fence(__ATOMIC_RELEASE, "agent");
      asm volatile("s_waitcnt vmcnt(0)" ::: "memory");
      const unsigned og = xb_add(&bar[XB_TOP], 1u);
      const unsigned tg = og / nx;
      if (og + 1u == (tg + 1u) * nx) xb_add(&bar[XB_TOPGEN], 1u);
      else XB_SPIN(xb_ld(&bar[XB_TOPGEN]) == tg, bar);
      __builtin_amdgcn_fence(__ATOMIC_ACQUIRE, "agent");
      xb_add(&bar[XB_XGEN(b.x)], 1u);
      asm volatile("s_waitcnt vmcnt(0)" ::: "memory");
    } else {
      XB_SPIN(xb_ld(&bar[XB_XGEN(b.x)]) == gen, bar);
      __builtin_amdgcn_fence(__ATOMIC_ACQUIRE, "agent");
      asm volatile("s_waitcnt vmcnt(0)" ::: "memory");
    }
  }
  __syncthreads();
}

DEVI const float* lds_ptr(const char* smem, int i) { const unsigned* t = (const unsigned*)(smem + SM_PTR) + 2 * i;
  const unsigned lo = __builtin_amdgcn_readfirstlane(t[0]), hi = __builtin_amdgcn_readfirstlane(t[1]);
  typedef const float __attribute__((address_space(1))) gfloat; return (const float*)(gfloat*)(((unsigned long long)hi << 32) | lo); }
DEVI Params load_params(const char* smem) {
  Params q;
  q.x = lds_ptr(smem, 0); q.c = lds_ptr(smem, 1); q.ctx = lds_ptr(smem, 2); q.c_ctx = lds_ptr(smem, 3); q.w_mod = lds_ptr(smem, 4); q.b_mod = lds_ptr(smem, 5);
  q.g_attn = lds_ptr(smem, 6); q.g_ffn = lds_ptr(smem, 7); q.w_in = lds_ptr(smem, 8); q.g_q = lds_ptr(smem, 9); q.g_kv = lds_ptr(smem, 10); q.w_uq = lds_ptr(smem, 11);
  q.w_ukv = lds_ptr(smem, 12); q.rel_bias = lds_ptr(smem, 13); q.w_out = lds_ptr(smem, 14); q.w_rg = lds_ptr(smem, 15); q.b_rg = lds_ptr(smem, 16); q.w_re = lds_ptr(smem, 17);
  q.b_re = lds_ptr(smem, 18); q.w_gate = lds_ptr(smem, 19); q.w_up = lds_ptr(smem, 20); q.w_down = lds_ptr(smem, 21); q.g_final = lds_ptr(smem, 22);
  q.out = (float*)lds_ptr(smem, 23); q.ws = (char*)lds_ptr(smem, 24);
  return q;
}
DEVI XcdBarrier xb_reload(char* smem) { XcdBarrier b; b.bar = (unsigned*)((char*)lds_ptr(smem, 24) + OFF_BAR); b.st = (volatile LAS unsigned*)(smem + SM_BARW);
  b.x = (unsigned)__builtin_amdgcn_readfirstlane((int)b.st[4]); return b; }
#define GRID_BARRIER() do { const XcdBarrier _xb = xb_reload(smem); xcd_barrier(_xb); } while (0)
#define VBID() __builtin_amdgcn_readfirstlane((int)((volatile LAS unsigned*)(smem + SM_BARW))[3])
#define TS(i) do { if (TIMING_PROBE && blockIdx.x == 0 && threadIdx.x == 0) ((unsigned long long*)(pk.ws + OFF_CNT + 64))[i] = __builtin_amdgcn_s_memrealtime(); } while (0)
#ifndef REPEAT_MASK
#define REPEAT_MASK 0
#endif
#define REP(i) _Pragma("nounroll") for (int _r = 0; _r < ((PHASE_ONLY >= 0 && PHASE_ONLY != (i)) ? 0 : (((REPEAT_MASK >> (i)) & 1) ? 2 : 1)); ++_r)

__global__ void __launch_bounds__(NTHREADS, 2) mega_kernel(Params pk) {
  __shared__ __attribute__((aligned(16))) char smem[LDS_TOTAL];
  const int nb = gridDim.x;
  if (threadIdx.x == 0) { *(uint4*)(smem + SM_BARW) = make_uint4(0u, 0u, 0u, (unsigned)blockIdx.x); *(uint4*)(smem + SM_BARW + 16) = make_uint4(0u, 0u, 0u, 0u); }
  if (threadIdx.x < 25) ((unsigned long long*)(smem + SM_PTR))[threadIdx.x] = ((const unsigned long long*)&pk)[threadIdx.x];
  __syncthreads();
  { const XcdBarrier xb0 = xcd_barrier_post((unsigned*)(pk.ws + OFF_BAR), (volatile LAS unsigned*)(smem + SM_BARW));
    if (threadIdx.x == 0) ((volatile LAS unsigned*)(smem + SM_BARW))[4] = xb0.x; }
  __syncthreads();
  TS(0);
  REP(0) { const Params p = load_params(smem); phase_A(p, (int)blockIdx.x, nb, smem); GRID_BARRIER(); }
  TS(1);
  { volatile LAS unsigned* st = (volatile LAS unsigned*)(smem + SM_BARW);
    if (threadIdx.x == 0) { unsigned* bar = (unsigned*)(pk.ws + OFF_BAR); bool even = (nb % 8) == 0;
      for (unsigned j = 0; j < 16; ++j) { const unsigned c = xb_ld(&bar[XB_XCNT(j)]); even = even && (c == (j < 8 ? (unsigned)nb / 8u : 0u)); }
      st[3] = even ? st[2] * 8u + st[4] : (unsigned)blockIdx.x; }
    __syncthreads(); }
  REP(1) { const Params p = load_params(smem); const int bid = VBID(); phase_B(p, bid, nb); GRID_BARRIER(); }
  TS(2);
  REP(2) { { const Params p = load_params(smem); const int bid = VBID(); phase_C(p, bid, nb, smem); }
    { const Params p = load_params(smem); conv_queue(p, smem, 1, NCONV_A, NCONV_C); }
    GRID_BARRIER(); }
  TS(3);
  REP(3) { const Params p = load_params(smem); const int bid = VBID(); phase_D(p, bid, nb, smem); GRID_BARRIER(); }
  TS(4);
  REP(4) { { const Params p = load_params(smem); const int bid = VBID(); phase_E(p, bid, nb, smem); }
    { const Params p = load_params(smem); conv_queue(p, smem, 3, NCONV_C, NCONV_E); }
    GRID_BARRIER(); }
  TS(5);
  REP(5) { const Params p = load_params(smem); const int bid = VBID(); phase_F(p, bid, nb, smem); GRID_BARRIER(); }
  TS(6);
  REP(6) { const Params p = load_params(smem); const int bid = VBID(); phase_G(p, bid, nb, smem); GRID_BARRIER(); }
  TS(7);
  REP(7) { { const Params p = load_params(smem); const int bid = VBID(); phase_H(p, bid, nb, smem); }
    { const Params p = load_params(smem); conv_queue(p, smem, 2, NCONV_E, NCONV); }
    GRID_BARRIER(); }
  TS(8);
  REP(8) { const Params p = load_params(smem); const int bid = VBID(); phase_I(p, bid, nb, smem); GRID_BARRIER(); }
  TS(9);
  REP(9) { const Params p = load_params(smem); const int bid = VBID(); phase_J(p, bid, nb); }
#if TIMING_PROBE
  GRID_BARRIER(); TS(10);
  if (blockIdx.x == 0 && threadIdx.x < 64) {
    const int lane = threadIdx.x;
    const unsigned long long* ts = (const unsigned long long*)(pk.ws + OFF_CNT + 64); float ta = 0.f, tr = 0.f;
#pragma unroll
    for (int qq = 0; qq < 10; ++qq) { const float d = (float)(unsigned)(ts[qq + 1] - ts[qq]) * 0.01f; if ((PROBE_A_MASK >> qq) & 1) ta += d; if ((PROBE_R_MASK >> qq) & 1) tr += d; }
    if ((PROBE_A_MASK >> 10) & 1) ta += (float)(unsigned)(ts[11] - ts[4]) * 0.01f;
    if ((PROBE_R_MASK >> 11) & 1) tr += (float)(unsigned)(ts[12] - ts[11]) * 0.01f;
    if ((PROBE_A_MASK >> 12) & 1) ta += (float)(unsigned)(ts[5] - ts[12]) * 0.01f;
    if (lane == 0) pk.out[0] += 1.f + ta * 0.01f;
    { float4* o4 = (float4*)(pk.out + 1024 + lane * 16);
#pragma unroll
      for (int i = 0; i < 4; ++i) { float4 v = o4[i]; v.x += tr * PROBE_R_SCALE; v.y += tr * PROBE_R_SCALE; v.z += tr * PROBE_R_SCALE; v.w += tr * PROBE_R_SCALE; o4[i] = v; } }
  }
#endif
}
#endif

extern "C" void kernel_launch(void* const* d_in, const int* in_sizes, int n_in, void* d_out, int out_size, void* d_ws, size_t ws_size, hipStream_t stream) {
  if (n_in != 23 || out_size != TT * 1024 || ws_size < WS_NEED) { fprintf(stderr, "kernel_launch: unexpected shapes n_in %d out %d ws %zu (need %zu)\n", n_in, out_size, ws_size, (size_t)WS_NEED); return; }
  Params p{};
  const float** f = (const float**)&p;
  for (int i = 0; i < 23; ++i) f[i] = (const float*)d_in[i];
  p.out = (float*)d_out; p.ws = (char*)d_ws;
#if ONE_LAUNCH
  static int grid_blocks = 0;
  if (!grid_blocks) {
    int dev = 0, cus = 0, per_cu = 0;
    hipGetDevice(&dev);
    hipDeviceGetAttribute(&cus, hipDeviceAttributeMultiprocessorCount, dev);
    hipOccupancyMaxActiveBlocksPerMultiprocessor(&per_cu, mega_kernel, NTHREADS, 0);
    if (per_cu > 1) per_cu = 1;
    grid_blocks = cus * per_cu;
    if (grid_blocks <= 0) { fprintf(stderr, "kernel_launch: occupancy query failed (cus %d per_cu %d)\n", cus, per_cu); grid_blocks = 0; return; }
  }
  if (hipMemsetAsync((char*)d_ws + OFF_BAR, 0, 16384, stream) != hipSuccess) { fprintf(stderr, "kernel_launch: memset of barrier words failed\n"); return; }
  hipLaunchKernelGGL(mega_kernel, dim3(grid_blocks), dim3(NTHREADS), 0, stream, p);
  const hipError_t e = hipPeekAtLastError();
  if (e != hipSuccess) fprintf(stderr, "kernel_launch: launch failed: %s (grid %d)\n", hipGetErrorString(e), grid_blocks);
#else
  const int G = 1024;
  hipLaunchKernelGGL(phase_kernel<0>, dim3(G), dim3(NTHREADS), 0, stream, p);
  hipLaunchKernelGGL(phase_kernel<1>, dim3(G), dim3(NTHREADS), 0, stream, p);
  hipLaunchKernelGGL(phase_kernel<2>, dim3(G), dim3(NTHREADS), 0, stream, p);
  hipLaunchKernelGGL(phase_kernel<3>, dim3(G), dim3(NTHREADS), 0, stream, p);
  hipLaunchKernelGGL(phase_kernel<4>, dim3(G), dim3(NTHREADS), 0, stream, p);
  hipLaunchKernelGGL(phase_kernel<5>, dim3(G), dim3(NTHREADS), 0, stream, p);
  hipLaunchKernelGGL(phase_kernel<6>, dim3(G), dim3(NTHREADS), 0, stream, p);
  hipLaunchKernelGGL(phase_kernel<7>, dim3(G), dim3(NTHREADS), 0, stream, p);
  hipLaunchKernelGGL(phase_kernel<8>, dim3(G), dim3(NTHREADS), 0, stream, p);
  hipLaunchKernelGGL(phase_kernel<9>, dim3(G), dim3(NTHREADS), 0, stream, p);
#endif
}
```

```cpp
#include <hip/hip_runtime.h>
#include <cstdio>
#include <cstdint>

#ifndef MODE_EXACT
#define MODE_EXACT 0
#endif
#ifndef ONE_LAUNCH
#define ONE_LAUNCH 1
#endif
#ifndef ATTN_EXACT
#define ATTN_EXACT MODE_EXACT
#endif
#ifndef PHASE_ONLY
#define PHASE_ONLY -1
#endif
#ifndef TIMING_PROBE
#define TIMING_PROBE 0
#endif
#ifndef PROBE_A_MASK
#define PROBE_A_MASK 0
#endif
#ifndef PROBE_R_MASK
#define PROBE_R_MASK 0
#endif
#ifndef PROBE_R_SCALE
#define PROBE_R_SCALE 0.002f
#endif
#ifndef GEMM_EXACT
#define GEMM_EXACT MODE_EXACT
#endif

#define DEVI __device__ __forceinline__

typedef unsigned short bf16_t;
typedef short bf16x8 __attribute__((ext_vector_type(8)));
typedef short s16x4 __attribute__((ext_vector_type(4)));
typedef float f32x16 __attribute__((ext_vector_type(16)));
typedef float f32x4 __attribute__((ext_vector_type(4)));
typedef unsigned u32x4 __attribute__((ext_vector_type(4)));

#if MODE_EXACT
typedef float act_t;
#else
typedef bf16_t act_t;
#endif

constexpr int DM = 1024, NBATCH = 2, SEQ = 8192, CTXL = 256, RB = SEQ + CTXL  , RR = NBATCH * RB  , TT = NBATCH * SEQ  ;
constexpr int GW = 64, GROWS = 128;
constexpr int QL = 384, KVL = 256, NPROJ = 2304  , NPROJ_REAL = 2208;
constexpr int NEXP = 16, DEXP = 512;
constexpr float EPS = 1e-6f, LOG2E = 1.4426950408889634f;
constexpr float QSCALE = 0.10206207261596577f * 1.4426950408889634f;
constexpr float NASCALE = 0.125f * 1.4426950408889634f;
constexpr int HIDROWS = 36864;
constexpr int NTHREADS = 512, NWAVES = 8;

constexpr size_t AS = sizeof(act_t);
constexpr size_t OFF_BAR   = 0;
constexpr size_t OFF_CNT   = 16384;
constexpr size_t OFF_MOD   = OFF_CNT + 256;
constexpr size_t OFF_ROPE  = OFF_MOD + 3 * 6144 * 4;
constexpr size_t OFF_SSQ   = OFF_ROPE + 2 * 128 * 8 * 4;
constexpr size_t OFF_SSKV  = OFF_SSQ + (size_t)RR * 12 * 4;
constexpr size_t OFF_BT    = OFF_SSKV + (size_t)RR * 8 * 4;
constexpr size_t OFF_ELIST = OFF_BT + (size_t)8 * 15 * 4096 * 4;
constexpr size_t OFF_EW    = OFF_ELIST + (size_t)NEXP * TT * 4;
constexpr size_t OFF_WRT   = OFF_EW + (size_t)NEXP * TT * 4;
constexpr size_t OFF_KMAX  = OFF_WRT + 20 * 1024 * 4;
constexpr size_t SMALL_END = OFF_KMAX + 512;
static_assert(SMALL_END <= (size_t)8 << 20, "small region");
constexpr size_t OFF_W     = (size_t)8 << 20;
#if MODE_EXACT
constexpr size_t W_BYTES = 0;
#else
constexpr size_t W_BYTES = (size_t)60 << 20;
#endif
constexpr size_t OFF_WIN  = OFF_W;
constexpr size_t OFF_WUQ  = OFF_WIN + (size_t)NPROJ * 1024 * 2;
constexpr size_t OFF_WUKV = OFF_WUQ + (size_t)768 * 384 * 2;
constexpr size_t OFF_WOUT = OFF_WUKV + (size_t)1024 * 256 * 2;
constexpr size_t OFF_WGU  = OFF_WOUT + (size_t)1024 * 1024 * 2;
constexpr size_t OFF_WD   = OFF_WGU + (size_t)16 * 1024 * 1024 * 2;
constexpr size_t W_END    = OFF_WD + (size_t)16 * 1024 * 512 * 2;
static_assert(MODE_EXACT || W_END <= OFF_W + W_BYTES, "weights region");
constexpr size_t G0 = OFF_W + W_BYTES;
constexpr size_t OFF_HXALL = G0;
constexpr size_t OFF_KV    = OFF_HXALL;
constexpr size_t OFF_NAQ   = OFF_HXALL + (size_t)RR * 1024 * AS;
constexpr size_t OFF_NAK   = OFF_NAQ + (size_t)RR * 512 * AS;
constexpr size_t OFF_NAV   = OFF_NAK + (size_t)RR * 512 * AS;
constexpr size_t OFF_KROPE = OFF_NAV + (size_t)RR * 512 * AS;
constexpr size_t OFF_QLAT  = OFF_KROPE + (size_t)RR * 32 * AS;
constexpr size_t OFF_KVLAT = OFF_QLAT + (size_t)RR * 384 * AS;
constexpr size_t OFF_ATTN  = OFF_QLAT;
constexpr size_t ATT_END   = OFF_ATTN + (size_t)TT * 1024 * AS;
constexpr size_t OFF_YBUF  = G0;
constexpr size_t OFF_HX2   = G0;
constexpr size_t OFF_HID   = OFF_YBUF + (size_t)2 * TT * 1024 * AS;
constexpr size_t MOE_END   = OFF_HID + (size_t)HIDROWS * 512 * AS;
constexpr size_t OFF_X1    = ATT_END > MOE_END ? ATT_END : MOE_END;
constexpr size_t WS_NEED   = OFF_X1 + (size_t)TT * 1024 * AS;
static_assert(MODE_EXACT || WS_NEED <= ((size_t)256 << 20), "workspace");

struct Params {
  const float *x, *c, *ctx, *c_ctx, *w_mod, *b_mod, *g_attn, *g_ffn, *w_in, *g_q, *g_kv, *w_uq, *w_ukv, *rel_bias, *w_out,
              *w_rg, *b_rg, *w_re, *b_re, *w_gate, *w_up, *w_down, *g_final;
  float* out; char* ws;
};

DEVI float bf2f(bf16_t v) { return __uint_as_float(((unsigned)v) << 16); }
DEVI bf16_t f2bf(float f) { unsigned u = __float_as_uint(f); u += 0x7fffu + ((u >> 16) & 1u); return (bf16_t)(u >> 16); }
typedef __bf16 bf16x2_t __attribute__((ext_vector_type(2)));
typedef float f32x2_t __attribute__((ext_vector_type(2)));
DEVI unsigned pk2(float lo, float hi) { const f32x2_t v = {lo, hi}; return __builtin_bit_cast(unsigned, __builtin_convertvector(v, bf16x2_t)); }
DEVI float a2f(float v) { return v; }
DEVI float a2f(bf16_t v) { return bf2f(v); }
DEVI void ld4(const float* p, float (&v)[4]) { const float4 t = *(const float4*)p; v[0] = t.x; v[1] = t.y; v[2] = t.z; v[3] = t.w; }
DEVI void ld4(const bf16_t* p, float (&v)[4]) { const uint2 t = *(const uint2*)p; v[0] = __uint_as_float(t.x << 16); v[1] = __uint_as_float(t.x & 0xffff0000u); v[2] = __uint_as_float(t.y << 16); v[3] = __uint_as_float(t.y & 0xffff0000u); }
DEVI void st4(float* p, float a, float b, float c, float d) { *(float4*)p = make_float4(a, b, c, d); }
DEVI void st4(bf16_t* p, float a, float b, float c, float d) { uint2 t; t.x = pk2(a, b); t.y = pk2(c, d); *(uint2*)p = t; }
DEVI void st1(float* p, float a) { *p = a; }
DEVI void st1(bf16_t* p, float a) { *p = f2bf(a); }
DEVI int crow(int r, int hi) { return (r & 3) + 8 * (r >> 2) + 4 * hi; }
DEVI float wave_sum(float v) { v += __shfl_xor(v, 32); v += __shfl_xor(v, 16); v += __shfl_xor(v, 8); v += __shfl_xor(v, 4); v += __shfl_xor(v, 2); v += __shfl_xor(v, 1); return v; }
DEVI float half_sum32(float v) { v += __shfl_xor(v, 16); v += __shfl_xor(v, 8); v += __shfl_xor(v, 4); v += __shfl_xor(v, 2); v += __shfl_xor(v, 1); return v; }
DEVI float xhalf_max(float v) { auto rr = __builtin_amdgcn_permlane32_swap(__float_as_uint(v), __float_as_uint(v), false, false); return fmaxf(__uint_as_float(rr[0]), __uint_as_float(rr[1])); }
DEVI float xhalf_sum(float v) { auto rr = __builtin_amdgcn_permlane32_swap(__float_as_uint(v), __float_as_uint(v), false, false); return __uint_as_float(rr[0]) + __uint_as_float(rr[1]); }
DEVI float silu_f(float v) { return v / (1.f + expf(-v)); }
DEVI float silu_fast(float v) { return v * __builtin_amdgcn_rcpf(1.f + __builtin_amdgcn_exp2f(-v * LOG2E)); }

DEVI int xcd_unit(int v, int U) { const int chunk = (U + 7) >> 3; const int x = v & 7, j = v >> 3; if (j >= chunk) return -1; const int u = x * chunk + j; return u < U ? u : -1; }
DEVI void panel_order(int idx, int nM, int nN, int& tm, int& tn) { const int nig = 8 * nN, gid = idx / nig, fm = gid * 8, gsz = (nM - fm) < 8 ? (nM - fm) : 8, r = idx - gid * nig; tm = fm + r % gsz; tn = r / gsz; }
DEVI int xcd_iters(int U, int nb) { const int chunk = (U + 7) >> 3; return (chunk * 8 + nb - 1) / nb; }

struct WInAcc { const float* w; static constexpr int LD = NPROJ_REAL;
  DEVI const float* col(int n, float& msk) const { const int o = n < 1152 ? n : (n < 2176 ? n + 32 : n - 1024); const bool ok = n < 2208; msk = ok ? 1.f : 0.f; return w + (ok ? o : 0); }
  DEVI float kscale(int) const { return 1.f; }
  DEVI float at(int k, int n) const { int o; if (n < 1152) o = n; else if (n < 2176) o = n + 32; else if (n < 2208) o = n - 1024; else return 0.f; return w[(size_t)k * NPROJ_REAL + o]; } };
struct WUqAcc { const float* w; const float* g; static constexpr int LD = 768;
  DEVI const float* col(int n, float& msk) const { msk = 1.f; return w + n; }
  DEVI float kscale(int k) const { return g[k]; }
  DEVI float at(int k, int n) const { return g[k] * w[(size_t)k * 768 + n]; } };
struct WUkvAcc { const float* w; const float* g; static constexpr int LD = 1024;
  DEVI const float* col(int n, float& msk) const { msk = 1.f; return w + n; }
  DEVI float kscale(int k) const { return g[k]; }
  DEVI float at(int k, int n) const { return g[k] * w[(size_t)k * 1024 + n]; } };
struct WOutAcc { const float* w; static constexpr int LD = 1024;
  DEVI const float* col(int n, float& msk) const { msk = 1.f; return w + n; }
  DEVI float kscale(int) const { return 1.f; }
  DEVI float at(int k, int n) const { return w[(size_t)k * 1024 + n]; } };
struct WGUAcc { const float* wg; const float* wu;
  static constexpr int LD = 512;
  DEVI const float* col(int n, float& msk) const { const int g = n >> 3, j = n & 7; msk = 1.f;
    const unsigned long long a = (unsigned long long)wg, b = (unsigned long long)wu;
    const unsigned lo = j < 4 ? (unsigned)a : (unsigned)b, hi = j < 4 ? (unsigned)(a >> 32) : (unsigned)(b >> 32);
    return (const float*)(((unsigned long long)hi << 32) | lo) + g * 4 + (j & 3); }
  DEVI float kscale(int) const { return 1.f; }
  DEVI float at(int k, int n) const { const int g = n >> 3, j = n & 7; return j < 4 ? wg[(size_t)k * 512 + g * 4 + j] : wu[(size_t)k * 512 + g * 4 + j - 4]; } };
struct WDAcc { const float* w; static constexpr int LD = 1024;
  DEVI const float* col(int n, float& msk) const { msk = 1.f; return w + n; }
  DEVI float kscale(int) const { return 1.f; }
  DEVI float at(int k, int n) const { return w[(size_t)k * 1024 + n]; } };

namespace g8 {
#define G8_LAS __attribute__((address_space(3)))
constexpr int BM = 256, BK = 64, HALF = 128, HTB = HALF * BK * 2  , STAGE_BYTES = 8 * HTB;
DEVI int lds_byte(int r, int c) { const int st = (r >> 4) * 2 + (c >> 5), rr = r & 15, cc = c & 31, ob = rr * 64 + cc * 2; return st * 1024 + (ob ^ (((ob >> 9) & 1) << 5)); }
DEVI void stage_rc(int b, int& R, int& C) { const int st = b / 1024, sb = b % 1024, swz = sb ^ (((sb >> 9) & 1) << 5); R = (st >> 1) * 16 + swz / 64; C = (st & 1) * 32 + (swz % 64) / 2; }
DEVI int perm32(int rho) { const int n = rho >> 4, i = rho & 15; return 8 * (i >> 2) + 4 * n + (i & 3); }
struct Unit { int pm, pn; };
template <class Epi, class Sched, bool GATHER, int K>
DEVI void gemm_phase(G8_LAS unsigned char* lds, const bf16_t* A, const bf16_t* Bt, const Sched& S, const Epi& E) {
  int tid = threadIdx.x; asm volatile("" : "+v"(tid));
  const int wid = __builtin_amdgcn_readfirstlane(tid >> 6), lane = tid & 63, wr = wid >> 2, wc = wid & 3, fr = lane & 15, fq = lane >> 4;
  constexpr int nt = K / BK;
  int sR[2], sC[2]; unsigned voffB[2];
#pragma unroll
  for (int i = 0; i < 2; ++i) { int R, C; stage_rc(tid * 16 + i * 8192, R, C); sR[i] = R; sC[i] = C; const int Rb = (R & ~31) + perm32(R & 31); voffB[i] = (unsigned)(Rb * K + C) * 2u; }
  constexpr size_t kstep = (size_t)(BK * 2);
  constexpr size_t hstep = (size_t)HALF * K * 2;
  constexpr size_t tstep = 2 * hstep;
  const unsigned ldsw = (unsigned)wid * 1024u;
  const int aoff = lds_byte(wr * 64 + fr, fq * 8), boff = lds_byte(wc * 32 + fr, fq * 8);
#define PG8_SA(b, h) (((b) * 2 + (h)) * HTB)
#define PG8_SB(b, h) ((4 + (b) * 2 + (h)) * HTB)
#define PG8_STAGE(bufoff, gbase, voff) do { _Pragma("unroll") for (int _i = 0; _i < 2; ++_i) \
        __builtin_amdgcn_global_load_lds((const unsigned*)((const char*)(gbase) + (voff)[_i]), (G8_LAS unsigned*)(lds + (bufoff) + ldsw + _i * 8192), 16, 0, 0); } while (0)
#define PG8_LDA(dst, b, h) do { _Pragma("unroll") for (int m = 0; m < 4; ++m) _Pragma("unroll") for (int k = 0; k < 2; ++k) dst[m][k] = *(const G8_LAS bf16x8*)(lds + PG8_SA(b, h) + aoff + m * 2048 + k * 1024); } while (0)
#define PG8_LDB(dst, b, h) do { _Pragma("unroll") for (int n = 0; n < 2; ++n) _Pragma("unroll") for (int k = 0; k < 2; ++k) dst[n][k] = *(const G8_LAS bf16x8*)(lds + PG8_SB(b, h) + boff + n * 2048 + k * 1024); } while (0)
#define PG8_MMA(ai, bj, At, Bt_) do { __builtin_amdgcn_s_setprio(1); _Pragma("unroll") for (int m = 0; m < 4; ++m) _Pragma("unroll") for (int n = 0; n < 2; ++n) _Pragma("unroll") for (int k = 0; k < 2; ++k) \
        acc[ai][bj][m][n] = __builtin_amdgcn_mfma_f32_16x16x32_bf16(Bt_[n][k], At[m][k], acc[ai][bj][m][n], 0, 0, 0); __builtin_amdgcn_s_setprio(0); } while (0)
#define PG8_WAIT_V(n) asm volatile("s_waitcnt vmcnt(" #n ")" ::: "memory")
#define PG8_WAIT_L(n) asm volatile("s_waitcnt lgkmcnt(" #n ")" ::: "memory")
#define PG8_BAR __builtin_amdgcn_s_barrier()
#define PG8_SCHED __builtin_amdgcn_sched_barrier(0)
  Unit cur, nxt; int ui = 0;
  if (!S.next(0, cur)) return;
  f32x4 acc[2][2][4][2];
#pragma unroll
  for (int a = 0; a < 2; ++a)
#pragma unroll
    for (int b = 0; b < 2; ++b)
#pragma unroll
      for (int m = 0; m < 4; ++m)
#pragma unroll
        for (int n = 0; n < 2; ++n) acc[a][b][m][n] = (f32x4){0.f, 0.f, 0.f, 0.f};
  bf16x8 At[4][2], B0[2][2], B1[2][2];
  unsigned vA0[2], vA1[2];
#define G8_SETV(U_, V0, V1) do { _Pragma("unroll") for (int _i = 0; _i < 2; ++_i) { \
      V0[_i] = (unsigned)S.arow(U_, sR[_i]) * (unsigned)(K * 2) + (unsigned)(sC[_i] * 2); V1[_i] = (unsigned)S.arow(U_, 128 + sR[_i]) * (unsigned)(K * 2) + (unsigned)(sC[_i] * 2); } } while (0)
  if (GATHER) { G8_SETV(cur, vA0, vA1); }
  else {
#pragma unroll
    for (int i = 0; i < 2; ++i) { vA0[i] = (unsigned)(sR[i] * K + sC[i]) * 2u; vA1[i] = vA0[i]; } }
  constexpr size_t hA = GATHER ? (size_t)0 : hstep;
  const char* cA = GATHER ? (const char*)A : (const char*)A + (size_t)cur.pm * tstep; const char* cB = (const char*)Bt + (size_t)cur.pn * tstep;
  PG8_STAGE(PG8_SB(0, 0), cB, voffB); PG8_STAGE(PG8_SA(0, 0), cA, vA0); PG8_STAGE(PG8_SB(0, 1), cB + hstep, voffB); PG8_STAGE(PG8_SA(0, 1), cA + hA, vA1);
  if (wr == 1) PG8_BAR;
  PG8_WAIT_V(4); PG8_BAR;
  PG8_STAGE(PG8_SB(1, 0), cB + kstep, voffB); PG8_STAGE(PG8_SA(1, 0), cA + kstep, vA0); PG8_STAGE(PG8_SB(1, 1), cB + hstep + kstep, voffB);
  PG8_WAIT_V(6); PG8_BAR;
  for (;;) {
    const bool has_next = S.next(ui + 1, nxt);
    const char* nA = has_next ? (GATHER ? (const char*)A : (const char*)A + (size_t)nxt.pm * tstep) : cA; const char* nB = has_next ? (const char*)Bt + (size_t)nxt.pn * tstep : cB;
#pragma unroll 1
    for (int t = 0; t < nt; t += 2) {
      const bool last = (t == nt - 2);
      const char* a1 = cA + (size_t)(t + 1) * kstep;
      const char* a2 = last ? nA : cA + (size_t)(t + 2) * kstep; const char* b2 = last ? nB : cB + (size_t)(t + 2) * kstep;
      const char* a3 = a2 + kstep; const char* b3 = b2 + kstep;
      PG8_LDB(B0, 0, 0); PG8_SCHED; PG8_LDA(At, 0, 0); PG8_STAGE(PG8_SA(1, 1), a1 + hA, vA1);
      PG8_WAIT_L(8); PG8_BAR; PG8_WAIT_L(0); PG8_MMA(0, 0, At, B0); PG8_BAR; PG8_SCHED;
      if (GATHER) { if (last && has_next) { G8_SETV(nxt, vA0, vA1); } }
      PG8_LDB(B1, 0, 1); PG8_STAGE(PG8_SB(0, 0), b2, voffB);
      PG8_BAR; PG8_WAIT_L(0); PG8_MMA(0, 1, At, B1); PG8_BAR;
      PG8_LDA(At, 0, 1); PG8_STAGE(PG8_SA(0, 0), a2, vA0);
      PG8_BAR; PG8_WAIT_L(0); PG8_MMA(1, 0, At, B0); PG8_BAR; PG8_SCHED;
      PG8_STAGE(PG8_SB(0, 1), b2 + hstep, voffB);
      PG8_WAIT_V(6); PG8_BAR; PG8_MMA(1, 1, At, B1); PG8_BAR;
      PG8_LDB(B0, 1, 0); PG8_SCHED; PG8_LDA(At, 1, 0); PG8_STAGE(PG8_SA(0, 1), a2 + hA, vA1);
      PG8_WAIT_L(8); PG8_BAR; PG8_WAIT_L(0); PG8_MMA(0, 0, At, B0); PG8_BAR; PG8_SCHED;
      PG8_LDB(B1, 1, 1); PG8_STAGE(PG8_SB(1, 0), b3, voffB);
      PG8_BAR; PG8_WAIT_L(0); PG8_MMA(0, 1, At, B1); PG8_BAR;
      PG8_LDA(At, 1, 1); PG8_STAGE(PG8_SA(1, 0), a3, vA0);
      PG8_BAR; PG8_WAIT_L(0); PG8_MMA(1, 0, At, B0); PG8_BAR; PG8_SCHED;
      PG8_STAGE(PG8_SB(1, 1), b3 + hstep, voffB);
      PG8_WAIT_V(6); PG8_BAR; PG8_MMA(1, 1, At, B1); PG8_BAR;
    }
    E(acc, cur, wr, wc, fr, fq);
    if (!has_next) break;
#pragma unroll
    for (int a = 0; a < 2; ++a)
#pragma unroll
      for (int b = 0; b < 2; ++b)
#pragma unroll
        for (int m = 0; m < 4; ++m)
#pragma unroll
          for (int n = 0; n < 2; ++n) acc[a][b][m][n] = (f32x4){0.f, 0.f, 0.f, 0.f};
    cur = nxt; cA = nA; cB = nB; ++ui;
  }
  PG8_WAIT_V(0);
  if (wr == 0) PG8_BAR;
  PG8_BAR;
#undef G8_SETV
#undef PG8_SA
#undef PG8_SB
#undef PG8_STAGE
#undef PG8_LDA
#undef PG8_LDB
#undef PG8_MMA
#undef PG8_WAIT_V
#undef PG8_WAIT_L
#undef PG8_BAR
#undef PG8_SCHED
}
}

constexpr int PH_BYTES = 139264;
constexpr int SM_BARW  = PH_BYTES;
constexpr int SM_TAB   = PH_BYTES + 32;
constexpr int SM_PTR   = PH_BYTES + 32 + 160;
constexpr int LDS_TOTAL = PH_BYTES + 32 + 160 + 208;
constexpr int KM_KN = 0;
constexpr int KM_KR = 32;
constexpr int KM_NA = 40;
constexpr int KM_BM = 80;

DEVI void store8(bf16_t* p, const f32x4& a, const f32x4& b) { u32x4 w = {pk2(a[0], a[1]), pk2(a[2], a[3]), pk2(b[0], b[1]), pk2(b[2], b[3])}; *(u32x4*)p = w; }
DEVI float sumsq8(const f32x4& a, const f32x4& b) { return a[0] * a[0] + a[1] * a[1] + a[2] * a[2] + a[3] * a[3] + b[0] * b[0] + b[1] * b[1] + b[2] * b[2] + b[3] * b[3]; }
DEVI float fq_sum(float v) { v += __shfl_xor(v, 16); v += __shfl_xor(v, 32); return v; }
DEVI float fr_max(float v) { v = fmaxf(v, __shfl_xor(v, 1)); v = fmaxf(v, __shfl_xor(v, 2)); v = fmaxf(v, __shfl_xor(v, 4)); v = fmaxf(v, __shfl_xor(v, 8)); return v; }
DEVI void rope8(f32x4& v0, f32x4& v1, int fq, int gr, int gc, const float* rc, const float* rs) {
  const int pb = ((fq & 1) ? gc : gr) * 8;
  float x[8] = {v0[0], v0[1], v0[2], v0[3], v1[0], v1[1], v1[2], v1[3]};
#pragma unroll
  for (int e = 0; e < 8; ++e) { const float y = __shfl_xor(x[e], 32); const float cs = rc[pb + e], sn = rs[pb + e];
    x[e] = fq < 2 ? x[e] * cs - y * sn : y * sn + x[e] * cs; }
  v0 = (f32x4){x[0], x[1], x[2], x[3]}; v1 = (f32x4){x[4], x[5], x[6], x[7]};
}

struct SchedGrid {
  int nM, nN, U, nb, bid, mskip;
  DEVI bool next(int i, g8::Unit& u) const { const int x = xcd_unit(bid + i * nb, U); if (x < 0) return false; int tm, tn; panel_order(x, nM, nN, tm, tn); u.pm = mskip ? tm + 1 + tm / 32 : tm; u.pn = tn; return true; }
  DEVI unsigned arow(const g8::Unit&, int) const { return 0u; }
};
typedef const int __attribute__((address_space(3))) las_cint;
struct SchedMoe {
  las_cint* tab; const int* elist; int MT, U, nb, bid;
  DEVI bool next(int i, g8::Unit& u) const { const int x = xcd_unit(bid + i * nb, U); if (x < 0) return false; int mt, tn; panel_order(x, MT, 4, mt, tn);
    int e = 0;
#pragma unroll
    for (int q = 1; q < 16; ++q) e += (mt >= tab[q]) ? 1 : 0;
    u.pm = mt; u.pn = e * 4 + tn; return true; }
  DEVI unsigned arow(const g8::Unit& u, int r) const { const int e = u.pn >> 2, slot = (u.pm - tab[e]) * 256 + r; return slot < tab[17 + e] ? (unsigned)(elist[(size_t)e * TT + slot] >> 1) : 0u; }
};
DEVI void moe_table(const Params& p, char* smem) {
  if (threadIdx.x == 0) { int* tab = (int*)(smem + SM_TAB); const int* cnt = (const int*)(p.ws + OFF_CNT); int acc = 0;
    for (int e = 0; e < 16; ++e) { tab[e] = acc; tab[17 + e] = cnt[e]; acc += (cnt[e] + 255) >> 8; } tab[16] = acc; }
  __syncthreads();
}

#define EPI_ROWS for (int ai = 0; ai < 2; ++ai) _Pragma("unroll") for (int m = 0; m < 4; ++m)
struct EpiProj8 { const Params* p;
  DEVI void operator()(const f32x4 (&acc)[2][2][4][2], const g8::Unit& u, int wr, int wc, int fr, int fq) const {
    char* ws = p->ws; const int b = (u.pm * 256) / RB;
    const float* rc = (const float*)(ws + OFF_ROPE); const float* rs = rc + 1024;
#pragma unroll
    for (int bj = 0; bj < 2; ++bj) {
      const int gc = u.pn * 256 + bj * 128 + wc * 32;
      float rmx = 0.f;
#pragma unroll
      EPI_ROWS {
        const int row = u.pm * 256 + ai * 128 + wr * 64 + m * 16 + fr;
        f32x4 v0 = acc[ai][bj][m][0], v1 = acc[ai][bj][m][1];
        if (gc < 384) { store8((bf16_t*)(ws + OFF_QLAT) + (size_t)row * 384 + gc + 8 * fq, v0, v1);
          const float ss = fq_sum(sumsq8(v0, v1)); if (fq == 0) ((float*)(ws + OFF_SSQ))[(size_t)row * 12 + (gc >> 5)] = ss; }
        else if (gc < 896) { store8((bf16_t*)(ws + OFF_NAQ) + (size_t)row * 512 + (gc - 384) + 8 * fq, v0 * NASCALE, v1 * NASCALE); }
        else if (gc < 1152) { store8((bf16_t*)(ws + OFF_KVLAT) + (size_t)row * 256 + (gc - 896) + 8 * fq, v0, v1);
          const float ss = fq_sum(sumsq8(v0, v1)); if (fq == 0) ((float*)(ws + OFF_SSKV))[(size_t)row * 8 + ((gc - 896) >> 5)] = ss; }
        else if (gc < 1664) { store8((bf16_t*)(ws + OFF_NAK) + (size_t)row * 512 + (gc - 1152) + 8 * fq, v0, v1); rmx = fmaxf(rmx, fq_sum(sumsq8(v0, v1))); }
        else if (gc < 2176) { store8((bf16_t*)(ws + OFF_NAV) + (size_t)row * 512 + (gc - 1664) + 8 * fq, v0, v1); }
        else if (gc == 2176) { const int rb = row % RB;
          if (rb >= CTXL) { const int pos = rb - CTXL; rope8(v0, v1, fq, pos >> 6, pos & 63, rc, rs); }
          store8((bf16_t*)(ws + OFF_KROPE) + (size_t)row * 32 + 8 * fq, v0, v1); rmx = fmaxf(rmx, fq_sum(sumsq8(v0, v1))); }
      }
      if (gc >= 1152 && gc < 1664) { rmx = fr_max(rmx); if ((threadIdx.x & 63) == 0) atomicMax((unsigned*)(ws + OFF_KMAX) + KM_NA + b * 16 + ((gc - 1152) >> 5), __float_as_uint(rmx)); }
      if (gc == 2176) { rmx = fr_max(rmx); if ((threadIdx.x & 63) == 0) atomicMax((unsigned*)(ws + OFF_KMAX) + KM_KR + b, __float_as_uint(rmx)); }
    }
  } };

struct EpiQm8 { const Params* p;
  DEVI void operator()(const f32x4 (&acc)[2][2][4][2], const g8::Unit& u, int wr, int wc, int fr, int fq) const {
    char* ws = p->ws; bf16_t* qm = (bf16_t*)p->out;
    const float* rc = (const float*)(ws + OFF_ROPE); const float* rs = rc + 1024;
    float sc8[2][4];
#pragma unroll
    for (int ai = 0; ai < 2; ++ai)
#pragma unroll
      for (int m = 0; m < 4; ++m) { const int row = u.pm * 256 + ai * 128 + wr * 64 + m * 16 + fr;
        const f32x4* sp = (const f32x4*)((const float*)(ws + OFF_SSQ) + (size_t)row * 12); f32x4 s0 = {0.f, 0.f, 0.f, 0.f}; if (fq < 3) s0 = sp[fq];
        sc8[ai][m] = (s0[0] + s0[1]) + (s0[2] + s0[3]); }
#pragma unroll
    for (int ai = 0; ai < 2; ++ai)
#pragma unroll
      for (int m = 0; m < 4; ++m) sc8[ai][m] = rsqrtf(fq_sum(sc8[ai][m]) * (1.f / 384.f) + EPS) * QSCALE;
    {
#pragma unroll
    EPI_ROWS {
      const int row = u.pm * 256 + ai * 128 + wr * 64 + m * 16 + fr; const int pos = row % RB - CTXL;
      const float sc = sc8[ai][m];
#pragma unroll
      for (int bj = 0; bj < 2; ++bj) { const int gc = u.pn * 256 + bj * 128 + wc * 32;
        f32x4 v0 = acc[ai][bj][m][0], v1 = acc[ai][bj][m][1];
        if ((gc % 96) == 64) rope8(v0, v1, fq, pos >> 6, pos & 63, rc, rs);
        store8(qm + (size_t)row * 768 + gc + 8 * fq, v0 * sc, v1 * sc); }
    }
    }
  } };

struct EpiKv8 { const Params* p;
  DEVI void operator()(const f32x4 (&acc)[2][2][4][2], const g8::Unit& u, int wr, int wc, int fr, int fq) const {
    char* ws = p->ws; const int b = (u.pm * 256) / RB; float rmx[2] = {0.f, 0.f};
    float sc8[2][4];
#pragma unroll
    for (int ai = 0; ai < 2; ++ai)
#pragma unroll
      for (int m = 0; m < 4; ++m) { const int row = u.pm * 256 + ai * 128 + wr * 64 + m * 16 + fr;
        const f32x4* sp = (const f32x4*)((const float*)(ws + OFF_SSKV) + (size_t)row * 8); f32x4 s0 = {0.f, 0.f, 0.f, 0.f}; if (fq < 2) s0 = sp[fq];
        sc8[ai][m] = (s0[0] + s0[1]) + (s0[2] + s0[3]); }
#pragma unroll
    for (int ai = 0; ai < 2; ++ai)
#pragma unroll
      for (int m = 0; m < 4; ++m) sc8[ai][m] = rsqrtf(fq_sum(sc8[ai][m]) * (1.f / 256.f) + EPS);
#pragma unroll
    EPI_ROWS {
      const int row = u.pm * 256 + ai * 128 + wr * 64 + m * 16 + fr; const float sc = sc8[ai][m];
#pragma unroll
      for (int bj = 0; bj < 2; ++bj) { const int gc = u.pn * 256 + bj * 128 + wc * 32;
        const f32x4 v0 = acc[ai][bj][m][0] * sc, v1 = acc[ai][bj][m][1] * sc;
        store8((bf16_t*)(ws + OFF_KV) + (size_t)row * 1024 + gc + 8 * fq, v0, v1);
        if ((gc & 127) < 64) rmx[bj] = fmaxf(rmx[bj], fq_sum(sumsq8(v0, v1))); }
    }
#pragma unroll
    for (int bj = 0; bj < 2; ++bj) { const int gc = u.pn * 256 + bj * 128 + wc * 32;
      if ((gc & 127) < 64) { const float r = fr_max(rmx[bj]); if ((threadIdx.x & 63) == 0) atomicMax((unsigned*)(ws + OFF_KMAX) + KM_KN + b * 16 + (gc >> 7) * 2 + ((gc >> 5) & 1), __float_as_uint(r)); } }
  } };

struct EpiOut8 { const Params* p;
  DEVI void operator()(const f32x4 (&acc)[2][2][4][2], const g8::Unit& u, int wr, int wc, int fr, int fq) const {
    const float* mod = (const float*)(p->ws + OFF_MOD); const int b = (u.pm * 256) >> 13;
    f32x4 gv[2][2];
#pragma unroll
    for (int bj = 0; bj < 2; ++bj) { const f32x4* gp = (const f32x4*)(mod + b * 6144 + 2048 + u.pn * 256 + bj * 128 + wc * 32 + 8 * fq); gv[bj][0] = gp[0]; gv[bj][1] = gp[1]; }
#pragma unroll
    for (int ai = 0; ai < 2; ++ai)
#pragma unroll
      for (int mh = 0; mh < 2; ++mh) {
        f32x4 xv[2][2][2];
#pragma unroll
        for (int mm = 0; mm < 2; ++mm)
#pragma unroll
          for (int bj = 0; bj < 2; ++bj) { const int m = mh * 2 + mm, tok = u.pm * 256 + ai * 128 + wr * 64 + m * 16 + fr, n = u.pn * 256 + bj * 128 + wc * 32 + 8 * fq;
            const f32x4* xp = (const f32x4*)(p->x + (size_t)tok * 1024 + n); xv[mm][bj][0] = xp[0]; xv[mm][bj][1] = xp[1]; }
#pragma unroll
        for (int mm = 0; mm < 2; ++mm)
#pragma unroll
          for (int bj = 0; bj < 2; ++bj) { const int m = mh * 2 + mm, tok = u.pm * 256 + ai * 128 + wr * 64 + m * 16 + fr, n = u.pn * 256 + bj * 128 + wc * 32 + 8 * fq;
            act_t* op = (act_t*)(p->ws + OFF_X1) + (size_t)tok * 1024 + n;
            const f32x4 r0 = xv[mm][bj][0] + gv[bj][0] * acc[ai][bj][m][0], r1 = xv[mm][bj][1] + gv[bj][1] * acc[ai][bj][m][1];
#if MODE_EXACT
            st4(op, r0[0], r0[1], r0[2], r0[3]); st4(op + 4, r1[0], r1[1], r1[2], r1[3]);
#else
            store8(op, r0, r1);
#endif
          }
      }
  } };

struct EpiGU8 { const Params* p; las_cint* tab;
  DEVI void operator()(const f32x4 (&acc)[2][2][4][2], const g8::Unit& u, int wr, int wc, int fr, int fq) const {
    bf16_t* hid = (bf16_t*)(p->ws + OFF_HID); const int e = u.pn >> 2, tn = u.pn & 3, slot0 = (u.pm - tab[e]) * 256, cnt = tab[17 + e];
    const float* ew = (const float*)(p->ws + OFF_EW) + (size_t)e * TT;
    float cw[2][4];
#pragma unroll
    for (int ai = 0; ai < 2; ++ai)
#pragma unroll
      for (int m = 0; m < 4; ++m) { const int slot = slot0 + ai * 128 + wr * 64 + m * 16 + fr; cw[ai][m] = slot < cnt ? ew[slot] : 0.f; }
#pragma unroll
    EPI_ROWS {
      const int r = ai * 128 + wr * 64 + m * 16 + fr; const bool valid = slot0 + r < cnt; const float c = cw[ai][m];
#pragma unroll
      for (int bj = 0; bj < 2; ++bj) { const int n = tn * 256 + bj * 128 + wc * 32 + 8 * fq;
        const f32x4 g = acc[ai][bj][m][0], up = acc[ai][bj][m][1]; float o[4];
#pragma unroll
        for (int j = 0; j < 4; ++j) o[j] = valid ? silu_fast(g[j]) * up[j] * c : 0.f;
        st4(hid + (size_t)(u.pm * 256 + r) * 512 + (n >> 1), o[0], o[1], o[2], o[3]); }
    }
  } };

struct EpiDown8 { const Params* p; las_cint* tab;
  DEVI void operator()(const f32x4 (&acc)[2][2][4][2], const g8::Unit& u, int wr, int wc, int fr, int fq) const {
    bf16_t* yb = (bf16_t*)(p->ws + OFF_YBUF); const int e = u.pn >> 2, tn = u.pn & 3, slot0 = (u.pm - tab[e]) * 256, cnt = tab[17 + e];
    const int* el = (const int*)(p->ws + OFF_ELIST) + (size_t)e * TT;
    int tk[2][4];
#pragma unroll
    for (int ai = 0; ai < 2; ++ai)
#pragma unroll
      for (int m = 0; m < 4; ++m) { const int slot = slot0 + ai * 128 + wr * 64 + m * 16 + fr; tk[ai][m] = slot < cnt ? el[slot] : -1; }
#pragma unroll
    EPI_ROWS {
      const int t = tk[ai][m];
      if (t >= 0) { bf16_t* rowp = yb + ((size_t)(t & 1) * TT + (t >> 1)) * 1024 + tn * 256 + wc * 32 + 8 * fq;
#pragma unroll
        for (int bj = 0; bj < 2; ++bj) store8(rowp + bj * 128, acc[ai][bj][m][0], acc[ai][bj][m][1]); }
    }
  } };
#undef EPI_ROWS

DEVI void modgemv_item(const Params& p, int item, char* smem) {
  float* sc = (float*)smem; float* red = sc + 3072;
  const int t = threadIdx.x;
  __syncthreads();
  for (int i = t; i < 3072; i += NTHREADS) { const int ci = i >> 10, k = i & 1023; const float v = ci == 0 ? p.c[k] : ci == 1 ? p.c[1024 + k] : p.c_ctx[k]; sc[i] = silu_f(v); }
  __syncthreads();
  const int cc = t & 31, kg = t >> 5, col = item * 32 + cc;
  float a0 = 0.f, a1 = 0.f, a2 = 0.f;
  { const float* wp = p.w_mod + (size_t)kg * 6144 + col;
#pragma unroll 1
    for (int kb = 0; kb < 1024; kb += 512) {
      float wv[32];
#pragma unroll
      for (int u = 0; u < 32; ++u) wv[u] = wp[(size_t)(kb + 16 * u) * 6144];
#pragma unroll
      for (int u = 0; u < 32; ++u) { const int k = kb + 16 * u + kg; a0 = fmaf(sc[k], wv[u], a0); a1 = fmaf(sc[1024 + k], wv[u], a1); a2 = fmaf(sc[2048 + k], wv[u], a2); }
    } }
  red[(kg * 32 + cc) * 3 + 0] = a0; red[(kg * 32 + cc) * 3 + 1] = a1; red[(kg * 32 + cc) * 3 + 2] = a2;
  __syncthreads();
  if (t < 96) { const int c2 = t & 31, ci = t >> 5; float s = 0.f;
#pragma unroll
    for (int g = 0; g < 16; ++g) s += red[(g * 32 + c2) * 3 + ci];
    ((float*)(p.ws + OFF_MOD))[ci * 6144 + item * 32 + c2] = s + p.b_mod[item * 32 + c2]; }
}

DEVI void misc_item(const Params& p) {
  const int t = threadIdx.x;
  if (t < 16) ((int*)(p.ws + OFF_CNT))[t] = 0;
  if (t < KM_BM) ((unsigned*)(p.ws + OFF_KMAX))[t] = 0u;
  { const int h = t >> 6, lane = t & 63; float bm = 0.f;
    for (int i = lane; i < 15 * 31; i += 64) bm = fmaxf(bm, p.rel_bias[h * 465 + i]);
#pragma unroll
    for (int o = 32; o > 0; o >>= 1) bm = fmaxf(bm, __shfl_xor(bm, o));
    if (lane == 0) ((float*)(p.ws + OFF_KMAX))[KM_BM + h] = bm * LOG2E; }
  float* rc = (float*)(p.ws + OFF_ROPE); float* rs = rc + 1024;
  for (int i = t; i < 1024; i += NTHREADS) {
    const int pos = i >> 3, j = i & 7;
    double f = 1.0; for (int q = 0; q < j; ++q) f *= 0.31622776601683794;
    const double a = (double)pos * f; const double n = rint(a * 0.15915494309189535); const double r = a - n * 6.283185307179586477;
    const double r2 = r * r; double sn = r, cs = 1.0, ts = r, tc = 1.0;
    for (int q = 1; q <= 14; ++q) { tc *= -r2 / (double)((2 * q - 1) * (2 * q)); cs += tc; ts *= -r2 / (double)((2 * q) * (2 * q + 1)); sn += ts; }
    rc[i] = (float)cs; rs[i] = (float)sn;
  }
}
DEVI void wrt_item(const Params& p, int j) {
  float* wrt = (float*)(p.ws + OFF_WRT) + j * 1024;
  for (int k = threadIdx.x; k < 1024; k += NTHREADS) wrt[k] = j < 4 ? p.w_rg[k * 4 + j] : p.w_re[k * 16 + j - 4];
}

DEVI void bt_item(const Params& p, int item) {
  unsigned* bt = (unsigned*)(p.ws + OFF_BT) + (size_t)item * 2048;
  for (int i = threadIdx.x; i < 2048; i += NTHREADS) { const int kc = i >> 6, c = i & 63; int cs = c - 8; cs = cs < 0 ? 0 : (cs > 48 ? 48 : cs);
    const float lo = (kc >= cs && kc < cs + 16) ? p.rel_bias[(size_t)item * 31 + (kc - c + 15)] * LOG2E : -1e30f;
    const int k2 = kc + 32; const float hi = (k2 >= cs && k2 < cs + 16) ? p.rel_bias[(size_t)item * 31 + (k2 - c + 15)] * LOG2E : -1e30f;
    bt[i] = pk2(lo, hi); }
}

struct ConvTile { const float* cp; const float* g; bf16_t* dst; int LD, K, n0, k0; float msk; };
DEVI ConvTile conv_desc(const Params& p, int j, int t) {
  constexpr int C_IN = (NPROJ / 64) * 16, C_UQ = 12 * 6, C_UKV = 16 * 4, C_OUT = 256, C_GU = 16 * 16 * 16;
  ConvTile c; c.g = nullptr; c.msk = 1.f; const int nn = t & 63;
  if (j < C_IN) { WInAcc a{p.w_in}; c.n0 = (j >> 4) * 64; c.k0 = (j & 15) * 64; c.cp = a.col(c.n0 + nn, c.msk); c.LD = WInAcc::LD; c.K = 1024; c.dst = (bf16_t*)(p.ws + OFF_WIN); }
  else if ((j -= C_IN) < C_UQ) { c.n0 = (j / 6) * 64; c.k0 = (j % 6) * 64; c.cp = p.w_uq + c.n0 + nn; c.g = p.g_q; c.LD = 768; c.K = 384; c.dst = (bf16_t*)(p.ws + OFF_WUQ); }
  else if ((j -= C_UQ) < C_UKV) { c.n0 = (j >> 2) * 64; c.k0 = (j & 3) * 64; c.cp = p.w_ukv + c.n0 + nn; c.g = p.g_kv; c.LD = 1024; c.K = 256; c.dst = (bf16_t*)(p.ws + OFF_WUKV); }
  else if ((j -= C_UKV) < C_OUT) { c.n0 = (j >> 4) * 64; c.k0 = (j & 15) * 64; c.cp = p.w_out + c.n0 + nn; c.LD = 1024; c.K = 1024; c.dst = (bf16_t*)(p.ws + OFF_WOUT); }
  else if ((j -= C_OUT) < C_GU) { const int e = j >> 8, r = j & 255; c.n0 = (r >> 4) * 64; c.k0 = (r & 15) * 64; WGUAcc a{p.w_gate + (size_t)e * 1024 * 512, p.w_up + (size_t)e * 1024 * 512};
    c.cp = a.col(c.n0 + nn, c.msk); c.LD = 512; c.K = 1024; c.dst = (bf16_t*)(p.ws + OFF_WGU) + (size_t)e * 1024 * 1024; }
  else { j -= C_GU; const int e = j >> 7, r = j & 127; c.n0 = (r >> 3) * 64; c.k0 = (r & 7) * 64; c.cp = p.w_down + (size_t)e * 512 * 1024 + c.n0 + nn; c.LD = 1024; c.K = 512; c.dst = (bf16_t*)(p.ws + OFF_WD) + (size_t)e * 1024 * 512; }
  c.cp += (size_t)(c.k0 + 8 * (t >> 6)) * c.LD;
  return c;
}
DEVI void conv_load(const ConvTile& c, float (&v)[16]) {
#pragma unroll
  for (int i = 0; i < 8; ++i) { v[i] = c.cp[(size_t)i * c.LD]; v[8 + i] = c.cp[(size_t)(64 + i) * c.LD]; }
}
DEVI void conv_finish(const ConvTile& c, const float (&v)[16], int t) {
#pragma unroll
  for (int h = 0; h < 2; ++h) {
    const int kk = c.k0 + 64 * h + 8 * (t >> 6); float x[8];
#pragma unroll
    for (int i = 0; i < 8; ++i) x[i] = v[8 * h + i] * c.msk * (c.g ? c.g[kk + i] : 1.f);
    *(uint4*)(c.dst + (size_t)(c.n0 + (t & 63)) * c.K + kk) = make_uint4(pk2(x[0], x[1]), pk2(x[2], x[3]), pk2(x[4], x[5]), pk2(x[6], x[7])); }
}

constexpr int CONV_C_EXPERTS = 10;
constexpr int NCONV_A = (NPROJ / 64) * 16;
constexpr int NCONV_C = NCONV_A + 12 * 6 + 16 * 4 + 256 + CONV_C_EXPERTS * 256;
constexpr int NCONV_E = NCONV_A + 12 * 6 + 16 * 4 + 256 + 16 * 16 * 16;
constexpr int NCONV = NCONV_E + 16 * 16 * 8;
static_assert(NCONV_A % 4 == 0 && NCONV_C % 4 == 0 && NCONV_E % 4 == 0 && NCONV % 4 == 0, "pairs, two per grab");
DEVI void conv_queue(const Params& p, char* smem, int q, int jbase, int jend) {
  int t = threadIdx.x; asm volatile("" : "+v"(t));
  unsigned* ctr = (unsigned*)(p.ws + OFF_BAR) + 16 * q;
  int* nxt = (int*)(smem + 32768);
  auto grab4 = [&]() -> int { __syncthreads(); if (t == 0) *nxt = jbase + (int)atomicAdd(ctr, 4u); __syncthreads(); return *nxt; };
  int jb = grab4(), jo = 0;
  if (jb < jend) {
    ConvTile c = conv_desc(p, jb, t); float v[16]; conv_load(c, v);
    for (;;) {
      int jn;
      if (jo < 1) { ++jo; jn = jb + 2 * jo; } else { jb = grab4(); jo = 0; jn = jb; }
      const bool more = jn < jend;
      ConvTile cn = c; float vn[16];
      if (more) { cn = conv_desc(p, jn, t); conv_load(cn, vn); }
      conv_finish(c, v, t);
      if (!more) break;
      c = cn;
#pragma unroll
      for (int i = 0; i < 16; ++i) v[i] = vn[i];
    }
  }
}

DEVI void phase_A(const Params& p, int bid, int nb, char* smem) {
  constexpr int N_MOD = 192, N_MISC = 1, N_WRT = 20, N_BT = 120;
  constexpr int I0 = N_MOD + N_MISC + N_WRT + N_BT;
  for (int it = bid; it < I0; it += nb) {
    if (it < N_MOD) modgemv_item(p, it, smem);
    else if (it < N_MOD + N_MISC) misc_item(p);
    else if (it < N_MOD + N_MISC + N_WRT) wrt_item(p, it - N_MOD - N_MISC);
    else bt_item(p, it - N_MOD - N_MISC - N_WRT);
  }
  conv_queue(p, smem, 0, 0, NCONV_A);
}

DEVI void phase_B(const Params& p, int bid, int nb) {
  int tx = threadIdx.x; asm volatile("" : "+v"(tx));
  const int lane = tx & 63, wv = tx >> 6;
  const float* mod = (const float*)(p.ws + OFF_MOD); act_t* hx = (act_t*)(p.ws + OFF_HXALL);
  const int nw = nb * NWAVES;
  for (int r0 = bid * NWAVES + wv; r0 < RR; r0 += 4 * nw) {
    float4 v[4][4]; const float* src[4]; int mrow[4];
#pragma unroll
    for (int q = 0; q < 4; ++q) { int row = r0 + q * nw; row = row < RR ? row : r0; const int b = row / RB, rb = row - b * RB;
      src[q] = rb < CTXL ? p.ctx + (size_t)(b * CTXL + rb) * 1024 : p.x + (size_t)(b * SEQ + rb - CTXL) * 1024; mrow[q] = rb < CTXL ? 2 : b;
#pragma unroll
      for (int i = 0; i < 4; ++i) v[q][i] = *(const float4*)(src[q] + lane * 4 + 256 * i); }
#pragma unroll
    for (int q = 0; q < 4; ++q) { const int row = r0 + q * nw; if (row >= RR) continue;
      float ss = 0.f;
#pragma unroll
      for (int i = 0; i < 4; ++i) ss += v[q][i].x * v[q][i].x + v[q][i].y * v[q][i].y + v[q][i].z * v[q][i].z + v[q][i].w * v[q][i].w;
      ss = wave_sum(ss); const float rstd = rsqrtf(ss * (1.f / 1024.f) + EPS);
      const float* sh = mod + mrow[q] * 6144; const float* sc = sh + 1024;
#pragma unroll
      for (int i = 0; i < 4; ++i) { const int k = lane * 4 + 256 * i; const float4 g = *(const float4*)(p.g_attn + k), s1 = *(const float4*)(sc + k), s0 = *(const float4*)(sh + k);
        st4(hx + (size_t)row * 1024 + k, v[q][i].x * rstd * g.x * (1.f + s1.x) + s0.x, v[q][i].y * rstd * g.y * (1.f + s1.y) + s0.y, v[q][i].z * rstd * g.z * (1.f + s1.z) + s0.z, v[q][i].w * rstd * g.w * (1.f + s1.w) + s0.w); } }
  }
}

DEVI void phase_C(const Params& p, int bid, int nb, char* smem) {
  SchedGrid S{66, 9, 66 * 9, nb, bid, 0}; EpiProj8 E{&p};
  g8::gemm_phase<EpiProj8, SchedGrid, false, 1024>((G8_LAS unsigned char*)smem, (const bf16_t*)(p.ws + OFF_HXALL), (const bf16_t*)(p.ws + OFF_WIN), S, E);
}
DEVI void phase_D(const Params& p, int bid, int nb, char* smem) {
  { SchedGrid S{64, 3, 192, nb, bid, 1}; EpiQm8 E{&p};
    g8::gemm_phase<EpiQm8, SchedGrid, false, 384>((G8_LAS unsigned char*)smem, (const bf16_t*)(p.ws + OFF_QLAT), (const bf16_t*)(p.ws + OFF_WUQ), S, E); }
  { int b2 = bid + 64; b2 = b2 >= nb ? b2 - nb : b2;
    SchedGrid S{66, 4, 264, nb, b2, 0}; EpiKv8 E{&p};
    g8::gemm_phase<EpiKv8, SchedGrid, false, 256>((G8_LAS unsigned char*)smem, (const bf16_t*)(p.ws + OFF_KVLAT), (const bf16_t*)(p.ws + OFF_WUKV), S, E); }
}
DEVI void phase_F(const Params& p, int bid, int nb, char* smem) {
  SchedGrid S{64, 4, 256, nb, bid, 0}; EpiOut8 E{&p};
  g8::gemm_phase<EpiOut8, SchedGrid, false, 1024>((G8_LAS unsigned char*)smem, (const bf16_t*)(p.ws + OFF_ATTN), (const bf16_t*)(p.ws + OFF_WOUT), S, E);
}
DEVI void phase_H(const Params& p, int bid, int nb, char* smem) {
  moe_table(p, smem); las_cint* tab = (las_cint*)(smem + SM_TAB); const int MT = tab[16];
  SchedMoe S{tab, (const int*)(p.ws + OFF_ELIST), MT, MT * 4, nb, bid}; EpiGU8 E{&p, tab};
  g8::gemm_phase<EpiGU8, SchedMoe, true, 1024>((G8_LAS unsigned char*)smem, (const bf16_t*)(p.ws + OFF_HX2), (const bf16_t*)(p.ws + OFF_WGU), S, E);
}
DEVI void phase_I(const Params& p, int bid, int nb, char* smem) {
  moe_table(p, smem); las_cint* tab = (las_cint*)(smem + SM_TAB); const int MT = tab[16];
  SchedMoe S{tab, (const int*)(p.ws + OFF_ELIST), MT, MT * 4, nb, bid}; EpiDown8 E{&p, tab};
  g8::gemm_phase<EpiDown8, SchedMoe, false, 512>((G8_LAS unsigned char*)smem, (const bf16_t*)(p.ws + OFF_HID), (const bf16_t*)(p.ws + OFF_WD), S, E);
}

typedef s16x4 __attribute__((address_space(3))) las_s16x4;
DEVI bf16x8 pack8(const f32x16& s, int base) {
  u32x4 w = {pk2(s[base], s[base + 1]), pk2(s[base + 2], s[base + 3]), pk2(s[base + 4], s[base + 5]), pk2(s[base + 6], s[base + 7])};
  return __builtin_bit_cast(bf16x8, w);
}
DEVI bf16x8 tr_pair(const char* p) {
  const s16x4 lo = __builtin_amdgcn_ds_read_tr16_b64_v4i16((las_s16x4*)(p));
  const s16x4 hh = __builtin_amdgcn_ds_read_tr16_b64_v4i16((las_s16x4*)(p + 8 * 64));
  return (bf16x8){lo[0], lo[1], lo[2], lo[3], hh[0], hh[1], hh[2], hh[3]};
}
template <bool S00, bool S11>
DEVI void pv_block_skip(const char* Vs, int vb, const f32x16& s0, const f32x16& s1, f32x16& o0, f32x16& o1) {
  const char* v0 = Vs + vb; const char* v1 = Vs + 4096 + vb;
  if (!S00) { const bf16x8 p00 = pack8(s0, 0); o0 = __builtin_amdgcn_mfma_f32_32x32x16_bf16(tr_pair(v0), p00, o0, 0, 0, 0); o1 = __builtin_amdgcn_mfma_f32_32x32x16_bf16(tr_pair(v1), p00, o1, 0, 0, 0); }
  { const bf16x8 p01 = pack8(s0, 8); o0 = __builtin_amdgcn_mfma_f32_32x32x16_bf16(tr_pair(v0 + 16 * 64), p01, o0, 0, 0, 0); o1 = __builtin_amdgcn_mfma_f32_32x32x16_bf16(tr_pair(v1 + 16 * 64), p01, o1, 0, 0, 0); }
  { const bf16x8 p10 = pack8(s1, 0); o0 = __builtin_amdgcn_mfma_f32_32x32x16_bf16(tr_pair(v0 + 32 * 64), p10, o0, 0, 0, 0); o1 = __builtin_amdgcn_mfma_f32_32x32x16_bf16(tr_pair(v1 + 32 * 64), p10, o1, 0, 0, 0); }
  if (!S11) { const bf16x8 p11 = pack8(s1, 8); o0 = __builtin_amdgcn_mfma_f32_32x32x16_bf16(tr_pair(v0 + 48 * 64), p11, o0, 0, 0, 0); o1 = __builtin_amdgcn_mfma_f32_32x32x16_bf16(tr_pair(v1 + 48 * 64), p11, o1, 0, 0, 0); }
}
DEVI void pv_block(const char* Vs, int vb, const f32x16& s0, const f32x16& s1, f32x16& o0, f32x16& o1) {
  const bf16x8 p00 = pack8(s0, 0), p01 = pack8(s0, 8), p10 = pack8(s1, 0), p11 = pack8(s1, 8);
  const char* v0 = Vs + vb; const char* v1 = Vs + 4096 + vb;
  o0 = __builtin_amdgcn_mfma_f32_32x32x16_bf16(tr_pair(v0), p00, o0, 0, 0, 0);
  o0 = __builtin_amdgcn_mfma_f32_32x32x16_bf16(tr_pair(v0 + 16 * 64), p01, o0, 0, 0, 0);
  o0 = __builtin_amdgcn_mfma_f32_32x32x16_bf16(tr_pair(v0 + 32 * 64), p10, o0, 0, 0, 0);
  o0 = __builtin_amdgcn_mfma_f32_32x32x16_bf16(tr_pair(v0 + 48 * 64), p11, o0, 0, 0, 0);
  o1 = __builtin_amdgcn_mfma_f32_32x32x16_bf16(tr_pair(v1), p00, o1, 0, 0, 0);
  o1 = __builtin_amdgcn_mfma_f32_32x32x16_bf16(tr_pair(v1 + 16 * 64), p01, o1, 0, 0, 0);
  o1 = __builtin_amdgcn_mfma_f32_32x32x16_bf16(tr_pair(v1 + 32 * 64), p10, o1, 0, 0, 0);
  o1 = __builtin_amdgcn_mfma_f32_32x32x16_bf16(tr_pair(v1 + 48 * 64), p11, o1, 0, 0, 0);
}
template <int DQK, bool BIAS>
DEVI void flash_tile(const char* Ks, const char* Vs, const bf16x8 (&qf)[DQK / 16], f32x16& o0, f32x16& o1, float& m, float& l, const float* bt, int r32, int hi, int vb) {
  constexpr int KROW = DQK * 2 + 16;
  f32x16 s0, s1;
#pragma unroll
  for (int r = 0; r < 16; ++r) { s0[r] = 0.f; s1[r] = 0.f; }
#pragma unroll
  for (int s = 0; s < DQK / 16; ++s) {
    const bf16x8 k0 = *(const bf16x8*)(Ks + r32 * KROW + (16 * s + 8 * hi) * 2);
    const bf16x8 k1 = *(const bf16x8*)(Ks + (32 + r32) * KROW + (16 * s + 8 * hi) * 2);
    s0 = __builtin_amdgcn_mfma_f32_32x32x16_bf16(k0, qf[s], s0, 0, 0, 0);
    s1 = __builtin_amdgcn_mfma_f32_32x32x16_bf16(k1, qf[s], s1, 0, 0, 0);
  }
  if (BIAS) {
#pragma unroll
    for (int r = 0; r < 16; ++r) { s0[r] += bt[crow(r, hi) * 64]; s1[r] += bt[(32 + crow(r, hi)) * 64]; }
  }
  float mx = fmaxf(s0[0], s1[0]);
#pragma unroll
  for (int r = 1; r < 16; ++r) mx = fmaxf(mx, fmaxf(s0[r], s1[r]));
  mx = xhalf_max(mx);
  const float mn = fmaxf(m, mx), alpha = __builtin_amdgcn_exp2f(m - mn); m = mn;
  float ps = 0.f;
#pragma unroll
  for (int r = 0; r < 16; ++r) { s0[r] = __builtin_amdgcn_exp2f(s0[r] - mn); s1[r] = __builtin_amdgcn_exp2f(s1[r] - mn); ps += s0[r] + s1[r]; }
  ps = xhalf_sum(ps); l = l * alpha + ps;
#pragma unroll
  for (int r = 0; r < 16; ++r) { o0[r] *= alpha; o1[r] *= alpha; }
  pv_block(Vs, vb, s0, s1, o0, o1);
}
template <int DQK, bool BIAS, bool NOSHIFT = false, int QB = -1>
DEVI void flash_tile_shift(const char* Ks, const char* Vs, const bf16x8 (&qf)[DQK / 16], f32x16& o0, f32x16& o1, float& l, float negM, const f32x16& bi0, const f32x16& bi1, int r32, int hi, int vb) {
  constexpr int KROW = DQK * 2 + 16;
  f32x16 s0, s1;
#pragma unroll
  for (int r = 0; r < 16; ++r) { if (NOSHIFT) { s0[r] = BIAS ? bi0[r] : 0.f; s1[r] = BIAS ? bi1[r] : 0.f; } else { s0[r] = BIAS ? bi0[r] + negM : negM; s1[r] = BIAS ? bi1[r] + negM : negM; } }
#pragma unroll
  for (int s = 0; s < DQK / 16; ++s) {
    const bf16x8 k0 = *(const bf16x8*)(Ks + r32 * KROW + (16 * s + 8 * hi) * 2);
    const bf16x8 k1 = *(const bf16x8*)(Ks + (32 + r32) * KROW + (16 * s + 8 * hi) * 2);
    s0 = __builtin_amdgcn_mfma_f32_32x32x16_bf16(k0, qf[s], s0, 0, 0, 0);
    s1 = __builtin_amdgcn_mfma_f32_32x32x16_bf16(k1, qf[s], s1, 0, 0, 0);
  }
  float ps = 0.f;
#pragma unroll
  for (int r = 0; r < 16; ++r) {
    if (QB == 1 && r < 12) s0[r] = 0.f; else { s0[r] = __builtin_amdgcn_exp2f(s0[r]); ps += s0[r]; }
    if (QB == 0 && r >= 4) s1[r] = 0.f; else { s1[r] = __builtin_amdgcn_exp2f(s1[r]); ps += s1[r]; } }
  l += ps;
  if (QB == 0) pv_block_skip<false, true>(Vs, vb, s0, s1, o0, o1);
  else if (QB == 1) pv_block_skip<true, false>(Vs, vb, s0, s1, o0, o1);
  else pv_block(Vs, vb, s0, s1, o0, o1);
}
DEVI void flash_store(bf16_t* op, const f32x16& o0, const f32x16& o1, float l, int hi) {
  const float rl = 1.f / l;
#pragma unroll
  for (int blk = 0; blk < 2; ++blk)
#pragma unroll
    for (int k = 0; k < 2; ++k) {
      const f32x16& o = blk ? o1 : o0;
      const unsigned a0 = pk2(o[8 * k] * rl, o[8 * k + 1] * rl), a1 = pk2(o[8 * k + 2] * rl, o[8 * k + 3] * rl);
      const unsigned b0 = pk2(o[8 * k + 4] * rl, o[8 * k + 5] * rl), b1 = pk2(o[8 * k + 6] * rl, o[8 * k + 7] * rl);
      const auto r0 = __builtin_amdgcn_permlane32_swap(a0, b0, false, false); const auto r1 = __builtin_amdgcn_permlane32_swap(a1, b1, false, false);
      const u32x4 w = {r0[0], r1[0], r0[1], r1[1]};
      *(u32x4*)(op + 32 * blk + 16 * k + 8 * hi) = w; }
}

#define MLA_SB __builtin_amdgcn_sched_barrier(0)
template <int KN, int VC>
DEVI void mla_step(char* smem, const char* ws, unsigned& gk, unsigned& gv, unsigned& gh, unsigned sk, unsigned sh, int lk, int lv, int lh,
                   const bf16x8 (&qf)[6], f32x16& c0, f32x16& c1, f32x16& n0, f32x16& n1, f32x16& o0, f32x16& o1, float (&l4)[4], const f32x16& negMv, int koff, int vb,
                   u32x4& lrk, u32x4& lrv, uint2& lrh, const u32x4& rk, const u32x4& rv, const uint2& rh) {
  constexpr int KROW = 208, KBYTES = 64 * KROW, VOFF = 2 * KBYTES;
  const char* Kn = smem + KN * KBYTES + koff;
  const char* V0 = smem + VOFF + VC * 8192 + vb; const char* V1 = V0 + 4096;
  lrk = *(const u32x4*)(ws + gk); lrv = *(const u32x4*)(ws + gv); lrh = *(const uint2*)(ws + gh);
  gk += sk; gv += 64u * 1024u * 2u; gh += sh;
  bf16x8 kf[12], pf[4], vf[4], vg[4];
#define MLA_KLD(g) kf[g] = *(const bf16x8*)(Kn + ((g) & 1) * 32 * KROW + ((g) >> 1) * 32)
  MLA_KLD(0); MLA_KLD(1); MLA_KLD(2);
  MLA_SB;
  constexpr int ELO[13] = {0, 3, 6, 9, 10, 13, 16, 17, 20, 23, 24, 28, 32};
#pragma unroll
  for (int g = 0; g < 12; ++g) {
    if (g + 3 < 12) MLA_KLD(g + 3);
    if (g >= 8) vf[g - 8] = tr_pair(V0 + (g - 8) * 16 * 64);
    if ((g & 1) == 0) n0 = __builtin_amdgcn_mfma_f32_32x32x16_bf16(kf[g], qf[g >> 1], g < 2 ? negMv : n0, 0, 0, 0);
    else              n1 = __builtin_amdgcn_mfma_f32_32x32x16_bf16(kf[g], qf[g >> 1], g < 2 ? negMv : n1, 0, 0, 0);
    MLA_SB;
#pragma unroll
    for (int e = ELO[g]; e < ELO[g + 1]; ++e) { if (e < 16) c0[e] = __builtin_amdgcn_exp2f(c0[e]); else c1[e - 16] = __builtin_amdgcn_exp2f(c1[e - 16]); }
    if (g == 3) pf[0] = pack8(c0, 0);
    if (g == 6) pf[1] = pack8(c0, 8);
    if (g == 9) pf[2] = pack8(c1, 0);
    MLA_SB;
  }
#undef MLA_KLD
#pragma unroll
  for (int hh = 0; hh < 8; ++hh) {
    if (hh < 4) vg[hh] = tr_pair(V1 + hh * 16 * 64);
    if (hh < 4) o0 = __builtin_amdgcn_mfma_f32_32x32x16_bf16(vf[hh], pf[hh], o0, 0, 0, 0);
    else        o1 = __builtin_amdgcn_mfma_f32_32x32x16_bf16(vg[hh - 4], pf[hh - 4], o1, 0, 0, 0);
    MLA_SB;
    if (hh == 0) pf[3] = pack8(c1, 8);
#pragma unroll
    for (int e = 4 * hh; e < 4 * hh + 4; ++e) { const float pv_ = e < 16 ? c0[e] : c1[e - 16]; asm volatile("v_add_f32_e32 %0, %1, %0" : "+v"(l4[e & 3]) : "v"(pv_)); }
    if (hh == 5) *(u32x4*)(smem + (1 - KN) * KBYTES + lk) = rk;
    if (hh == 6) *(u32x4*)(smem + (1 - VC) * 8192 + lv) = rv;
    if (hh == 7) *(uint2*)(smem + (1 - KN) * KBYTES + lh) = rh;
    MLA_SB;
  }
  __syncthreads();
}

DEVI void mla_unit(const Params& p, int unit, char* smem) {
  constexpr int KROW = 208, KBYTES = 64 * KROW  , VOFF = 2 * KBYTES;
  const int t = threadIdx.x, lane = t & 63, w = t >> 6, r32 = lane & 31, hi = lane >> 5;
  const int qblk = unit & 31, h = (unit >> 5) & 7, b = unit >> 8;
  const char* ws = p.ws;
  const size_t qrow = (size_t)b * RB + CTXL + qblk * 256 + w * 32 + r32;
  bf16x8 qf[6];
  { const bf16_t* qp = (const bf16_t*)p.out + qrow * 768 + h * 96 + hi * 8;
#pragma unroll
    for (int s = 0; s < 6; ++s) qf[s] = *(const bf16x8*)(qp + 16 * s); }
  unsigned gk, gv, gh, sk, sh; int lk, lv, lh;
  { const int key = t / 12, ch = t - key * 12;
    if (ch < 8) { gk = (unsigned)OFF_KV + (unsigned)(((b * RB + key) * 1024 + h * 128 + ch * 8) * 2); sk = 64u * 1024u * 2u; }
    else { gk = (unsigned)OFF_KROPE + (unsigned)(((b * RB + key) * 32 + (ch - 8) * 8) * 2); sk = 64u * 32u * 2u; }
    lk = key * KROW + ch * 16; }
  { const int c = 512 + (t >> 1), key = c / 12, ch = c - key * 12, hf = t & 1;
    if (ch < 8) { gh = (unsigned)OFF_KV + (unsigned)(((b * RB + key) * 1024 + h * 128 + ch * 8 + hf * 4) * 2); sh = 64u * 1024u * 2u; }
    else { gh = (unsigned)OFF_KROPE + (unsigned)(((b * RB + key) * 32 + (ch - 8) * 8 + hf * 4) * 2); sh = 64u * 32u * 2u; }
    lh = key * KROW + ch * 16 + hf * 8; }
  { const int key = t >> 3, ch = t & 7; gv = (unsigned)OFF_KV + (unsigned)(((b * RB + key) * 1024 + h * 128 + 64 + ch * 8) * 2); lv = VOFF + (ch >> 2) * 4096 + key * 64 + (ch & 3) * 16; }
  const int vb = (((lane & 15) >> 2) + 4 * hi) * 64 + (16 * ((lane >> 4) & 1) + 4 * (lane & 3)) * 2;
  f32x16 o0, o1;
#pragma unroll
  for (int r = 0; r < 16; ++r) { o0[r] = 0.f; o1[r] = 0.f; }
  float q2 = 0.f;
#pragma unroll
  for (int s = 0; s < 6; ++s)
#pragma unroll
    for (int e = 0; e < 8; ++e) { const float x = bf2f((bf16_t)qf[s][e]); q2 = fmaf(x, x, q2); }
  q2 = xhalf_sum(q2);
  const float* kmw = (const float*)(ws + OFF_KMAX);
  const float Mq = 1.01f * sqrtf(q2 * (kmw[KM_KN + b * 16 + h * 2] + kmw[KM_KN + b * 16 + h * 2 + 1] + kmw[KM_KR + b]));
  bool shift_ok;
  { volatile __attribute__((address_space(3))) unsigned* vw = (volatile __attribute__((address_space(3))) unsigned*)(smem + SM_BARW) + 6;
    const bool bad_w = __any(!(Mq < 64.f));
    __syncthreads(); if (t == 0) *vw = 0u; __syncthreads(); if (bad_w && lane == 0) *vw = 1u; __syncthreads();
    shift_ok = __builtin_amdgcn_readfirstlane((int)*vw) == 0; }
  constexpr int NT = RB / 64;
  float l;
  { const u32x4 rk = *(const u32x4*)(ws + gk); const u32x4 rv = *(const u32x4*)(ws + gv); const uint2 rh = *(const uint2*)(ws + gh);
    gk += sk; gv += 64u * 1024u * 2u; gh += sh;
    __syncthreads();
    *(u32x4*)(smem + lk) = rk; *(u32x4*)(smem + lv) = rv; *(uint2*)(smem + lh) = rh; }
  if (shift_ok) {
    { const u32x4 rk = *(const u32x4*)(ws + gk); const uint2 rh = *(const uint2*)(ws + gh); gk += sk; gh += sh;
      *(u32x4*)(smem + KBYTES + lk) = rk; *(uint2*)(smem + KBYTES + lh) = rh; }
    __syncthreads();
    const int koff = r32 * KROW + hi * 16;
    f32x16 negMv;
#pragma unroll
    for (int r = 0; r < 16; ++r) negMv[r] = -Mq;
    f32x16 a0, a1, b0, b1;
    { const char* Kn = smem + koff;
#pragma unroll
      for (int s = 0; s < 6; ++s) {
        a0 = __builtin_amdgcn_mfma_f32_32x32x16_bf16(*(const bf16x8*)(Kn + s * 32), qf[s], s == 0 ? negMv : a0, 0, 0, 0);
        a1 = __builtin_amdgcn_mfma_f32_32x32x16_bf16(*(const bf16x8*)(Kn + 32 * KROW + s * 32), qf[s], s == 0 ? negMv : a1, 0, 0, 0); } }
    float l4[4] = {0.f, 0.f, 0.f, 0.f};
    u32x4 rkA, rvA, rkB, rvB; uint2 rhA, rhB;
    rkB = *(const u32x4*)(ws + gk); rvB = *(const u32x4*)(ws + gv); rhB = *(const uint2*)(ws + gh); gk += sk; gv += 64u * 1024u * 2u; gh += sh;
#pragma unroll 1
    for (int jj = 0; jj < NT / 2; ++jj) {
      mla_step<1, 0>(smem, ws, gk, gv, gh, sk, sh, lk, lv, lh, qf, a0, a1, b0, b1, o0, o1, l4, negMv, koff, vb, rkA, rvA, rhA, rkB, rvB, rhB);
      mla_step<0, 1>(smem, ws, gk, gv, gh, sk, sh, lk, lv, lh, qf, b0, b1, a0, a1, o0, o1, l4, negMv, koff, vb, rkB, rvB, rhB, rkA, rvA, rhA);
    }
    l = xhalf_sum((l4[0] + l4[1]) + (l4[2] + l4[3]));
  } else {
    __syncthreads();
    float m = -1e30f; l = 0.f;
#pragma unroll 1
    for (int j = 0; j < NT; ++j) {
      const u32x4 rk = *(const u32x4*)(ws + gk); const u32x4 rv = *(const u32x4*)(ws + gv); const uint2 rh = *(const uint2*)(ws + gh);
      gk += sk; gv += 64u * 1024u * 2u; gh += sh;
      flash_tile<96, false>(smem + (j & 1) * KBYTES, smem + VOFF + (j & 1) * 8192, qf, o0, o1, m, l, nullptr, r32, hi, vb);
      char* sw = smem + ((j + 1) & 1) * KBYTES; *(u32x4*)(sw + lk) = rk; *(uint2*)(sw + lh) = rh; *(u32x4*)(smem + ((j + 1) & 1) * 8192 + lv) = rv;
      __syncthreads();
    }
  }
  flash_store((bf16_t*)(ws + OFF_ATTN) + ((size_t)b * SEQ + qblk * 256 + w * 32 + r32) * 1024 + h * 64, o0, o1, l, hi);
}

template <bool BIAS>
DEVI void na_tile_max(const char* Ks, const char* Vs, const bf16x8 (&qf)[4], f32x16& o0, f32x16& o1, float& m, float& l, const f32x16& bi0, const f32x16& bi1, int r32, int hi, int vb) {
  constexpr int KROW = 144;
  f32x16 s0, s1;
#pragma unroll
  for (int r = 0; r < 16; ++r) { s0[r] = BIAS ? bi0[r] : 0.f; s1[r] = BIAS ? bi1[r] : 0.f; }
#pragma unroll
  for (int s = 0; s < 4; ++s) {
    const bf16x8 k0 = *(const bf16x8*)(Ks + r32 * KROW + (16 * s + 8 * hi) * 2), k1 = *(const bf16x8*)(Ks + (32 + r32) * KROW + (16 * s + 8 * hi) * 2);
    s0 = __builtin_amdgcn_mfma_f32_32x32x16_bf16(k0, qf[s], s0, 0, 0, 0); s1 = __builtin_amdgcn_mfma_f32_32x32x16_bf16(k1, qf[s], s1, 0, 0, 0);
  }
  float mx = fmaxf(s0[0], s1[0]);
#pragma unroll
  for (int r = 1; r < 16; ++r) mx = fmaxf(mx, fmaxf(s0[r], s1[r]));
  mx = xhalf_max(mx);
  const float mn = fmaxf(m, mx), alpha = __builtin_amdgcn_exp2f(m - mn); m = mn;
  float ps = 0.f;
#pragma unroll
  for (int r = 0; r < 16; ++r) { s0[r] = __builtin_amdgcn_exp2f(s0[r] - mn); s1[r] = __builtin_amdgcn_exp2f(s1[r] - mn); ps += s0[r] + s1[r]; }
  ps = xhalf_sum(ps); l = l * alpha + ps;
#pragma unroll
  for (int r = 0; r < 16; ++r) { o0[r] *= alpha; o1[r] *= alpha; }
  pv_block(Vs, vb, s0, s1, o0, o1);
}

DEVI void na_unit(const Params& p, int unit, char* smem) {
  constexpr int KROW = 144, KBYTES = 64 * KROW  , STAGE = KBYTES + 8192  ;
  const int t = threadIdx.x, lane = t & 63, w = t >> 6, r32 = lane & 31, hi = lane >> 5;
  const int head = unit & 7, rq = (unit >> 3) & 31, b = unit >> 8;
  const int rr = w >> 1, qb = w & 1, grow = rq * 4 + rr, c = qb * 32 + r32;
  int wstart = grow - 4; wstart = wstart < 0 ? 0 : (wstart > 120 ? 120 : wstart);
  int klo = rq * 4 - 4; klo = klo < 0 ? 0 : (klo > 120 ? 120 : klo);
  int khi = rq * 4 - 1; khi = (khi < 0 ? 0 : (khi > 120 ? 120 : khi)) + 8;
  const int ntw = khi - klo, ntt = ntw + 4;
  const char* ws = p.ws;
  const bf16_t* nak = (const bf16_t*)(ws + OFF_NAK) + (size_t)b * RB * 512 + head * 64;
  const bf16_t* nav = (const bf16_t*)(ws + OFF_NAV) + (size_t)b * RB * 512 + head * 64;
  bf16x8 qf[4];
  { const bf16_t* qp = (const bf16_t*)(ws + OFF_NAQ) + ((size_t)b * RB + CTXL + grow * 64 + c) * 512 + head * 64 + hi * 8;
#pragma unroll
    for (int s = 0; s < 4; ++s) qf[s] = *(const bf16x8*)(qp + 16 * s); }
  const int skey = t >> 3, sch = t & 7;
  const int goff0 = skey * 512 + sch * 8, kdst0 = skey * KROW + sch * 16, vdst0 = KBYTES + (sch >> 2) * 4096 + skey * 64 + (sch & 3) * 16;
  const int vb = (((lane & 15) >> 2) + 4 * hi) * 64 + (16 * ((lane >> 4) & 1) + 4 * (lane & 3)) * 2;
  f32x16 o0, o1;
#pragma unroll
  for (int r = 0; r < 16; ++r) { o0[r] = 0.f; o1[r] = 0.f; }
  float m = -1e30f, l = 0.f;
  const unsigned* btb = (const unsigned*)(ws + OFF_BT) + (size_t)(head * 15) * 2048 + c;
  float q2 = 0.f;
#pragma unroll
  for (int s = 0; s < 4; ++s)
#pragma unroll
    for (int e = 0; e < 8; ++e) { const float x = bf2f((bf16_t)qf[s][e]); q2 = fmaf(x, x, q2); }
  q2 = xhalf_sum(q2);
  const float* kmw = (const float*)(ws + OFF_KMAX);
  const float Mq = 1.01f * sqrtf(q2 * (kmw[KM_NA + b * 16 + head * 2] + kmw[KM_NA + b * 16 + head * 2 + 1])) + kmw[KM_BM + head];
  const bool shift_ok = !__any(!(Mq < 64.f));
  u32x4 rk, rv;
  auto rowbase = [&](int j) -> size_t { return j < ntw ? (size_t)CTXL + (size_t)(klo + j) * 64 : (size_t)(j - ntw) * 64; };
#define NA_STAGE_LOAD(J) { const size_t rb1 = rowbase(J) * 512 + goff0; rk = *(const u32x4*)(nak + rb1); rv = *(const u32x4*)(nav + rb1); }
#define NA_STAGE_WRITE(J) { char* sw = smem + ((J) & 1) * STAGE; *(u32x4*)(sw + kdst0) = rk; *(u32x4*)(sw + vdst0) = rv; }
  NA_STAGE_LOAD(0)
  __syncthreads();
  NA_STAGE_WRITE(0)
  __syncthreads();
  unsigned bp[16];
#define NA_BIAS_LOAD(J) { const int kr_ = klo + (J); if ((J) < ntw && kr_ >= wstart && kr_ < wstart + 8) { const unsigned* bt = btb + (size_t)(kr_ - grow + 7) * 2048; \
      _Pragma("unroll") for (int r = 0; r < 16; ++r) bp[r] = bt[crow(r, hi) * 64]; } }
#define NA_TILE_LOOP(WIN_CALL, CTX_CALL)                                                                                                       \
  NA_BIAS_LOAD(0)                                                                                                                                \
  _Pragma("unroll 1") for (int j = 0; j < ntt; ++j) {                                                                                            \
    const char* st = smem + (j & 1) * STAGE;                                                                                                     \
    const int kr = klo + j; const bool win = j < ntw; const bool active = !win || (kr >= wstart && kr < wstart + 8);           \
    f32x16 bc0, bc1;                                                                                                                             \
    if (win && active) { _Pragma("unroll") for (int r = 0; r < 16; ++r) { bc0[r] = __uint_as_float(bp[r] << 16); bc1[r] = __uint_as_float(bp[r] & 0xffff0000u); } } \
    __builtin_amdgcn_sched_barrier(0);                                                                                                           \
    NA_BIAS_LOAD(j + 1)                                                 \
    __builtin_amdgcn_sched_barrier(0);                                                                                                           \
    if (j + 1 < ntt) NA_STAGE_LOAD(j + 1)                                                                                                        \
    __builtin_amdgcn_sched_barrier(0);                                                                                                           \
    if (active) { if (win) { WIN_CALL; } else { CTX_CALL; } }                                                                                    \
    if (j + 1 < ntt) NA_STAGE_WRITE(j + 1)                                                                                                       \
    __syncthreads();                                                                                                                             \
  }
  if (shift_ok) { if (qb == 0) { NA_TILE_LOOP((flash_tile_shift<64, true, true, 0>(st, st + KBYTES, qf, o0, o1, l, 0.f, bc0, bc1, r32, hi, vb)), (flash_tile_shift<64, false, true>(st, st + KBYTES, qf, o0, o1, l, 0.f, bc0, bc1, r32, hi, vb))) }
    else { NA_TILE_LOOP((flash_tile_shift<64, true, true, 1>(st, st + KBYTES, qf, o0, o1, l, 0.f, bc0, bc1, r32, hi, vb)), (flash_tile_shift<64, false, true>(st, st + KBYTES, qf, o0, o1, l, 0.f, bc0, bc1, r32, hi, vb))) } }
  else { NA_TILE_LOOP((na_tile_max<true>(st, st + KBYTES, qf, o0, o1, m, l, bc0, bc1, r32, hi, vb)), (na_tile_max<false>(st, st + KBYTES, qf, o0, o1, m, l, bc0, bc1, r32, hi, vb))) }
#undef NA_TILE_LOOP
#undef NA_BIAS_LOAD
#undef NA_STAGE_LOAD
#undef NA_STAGE_WRITE
  if (shift_ok) l = xhalf_sum(l);
  flash_store((bf16_t*)(ws + OFF_ATTN) + ((size_t)b * SEQ + grow * 64 + c) * 1024 + 512 + head * 64, o0, o1, l, hi);
}

DEVI void phase_E(const Params& p, int bid, int nb, char* smem) {
  constexpr int UM = NBATCH * 8 * 32, UN = NBATCH * 32 * 8;
  { const int iters = xcd_iters(UM, nb);
    for (int it = 0; it < iters; ++it) { const int u = xcd_unit(bid + it * nb, UM); if (u >= 0) mla_unit(p, u, smem); } }
#if TIMING_PROBE
  if (blockIdx.x == 0 && threadIdx.x == 0) ((unsigned long long*)(p.ws + OFF_CNT + 64))[11] = __builtin_amdgcn_s_memrealtime();
#endif
  { const int iters = xcd_iters(UN, nb);
    for (int it = 0; it < iters; ++it) { const int u = xcd_unit(bid + it * nb, UN); if (u >= 0) na_unit(p, u, smem); } }
#if TIMING_PROBE
  if (blockIdx.x == 0 && threadIdx.x == 0) ((unsigned long long*)(p.ws + OFF_CNT + 64))[12] = __builtin_amdgcn_s_memrealtime();
#endif
}

DEVI void wave_reduce40(float (&v)[40], int lane) {
  { const bool b = lane & 32;
#pragma unroll
    for (int i = 0; i < 20; ++i) { const float keep = b ? v[i + 20] : v[i], send = b ? v[i] : v[i + 20]; v[i] = keep + __shfl_xor(send, 32); } }
  { const bool b = lane & 16;
#pragma unroll
    for (int i = 0; i < 10; ++i) { const float keep = b ? v[i + 10] : v[i], send = b ? v[i] : v[i + 10]; v[i] = keep + __shfl_xor(send, 16); } }
  { const bool b = lane & 8;
#pragma unroll
    for (int i = 0; i < 5; ++i) { const float keep = b ? v[i + 5] : v[i], send = b ? v[i] : v[i + 5]; v[i] = keep + __shfl_xor(send, 8); } }
  { const bool b = lane & 4;
#pragma unroll
    for (int i = 0; i < 3; ++i) { const float hi_ = i + 3 < 5 ? v[i + 3] : 0.f; const float keep = b ? hi_ : v[i], send = b ? v[i] : hi_; v[i] = keep + __shfl_xor(send, 4); } }
  { const bool b = lane & 2;
#pragma unroll
    for (int i = 0; i < 2; ++i) { const float hi_ = i + 2 < 3 ? v[i + 2] : 0.f; const float keep = b ? hi_ : v[i], send = b ? v[i] : hi_; v[i] = keep + __shfl_xor(send, 2); } }
  { const bool b = lane & 1;
    const float keep = b ? v[1] : v[0], send = b ? v[0] : v[1]; v[0] = keep + __shfl_xor(send, 1); }
}
template <int IDX> DEVI float reduce40_get(float v0) {
  constexpr int k = IDX % 5, low3 = k < 3 ? k : k + 1;
  constexpr int src = (IDX / 20) * 32 + ((IDX % 20) / 10) * 16 + ((IDX % 10) / 5) * 8 + low3;
  return __builtin_bit_cast(float, __builtin_amdgcn_readlane(__builtin_bit_cast(int, v0), src));
}
DEVI void route_token(const float (&lg)[20], int tl, int lane, int* te, float* tw) {
  int gs = 0; float gm = lg[0];
#pragma unroll
  for (int j = 1; j < 4; ++j) if (lg[j] > gm) { gm = lg[j]; gs = j; }
  float z = 0.f;
#pragma unroll
  for (int j = 0; j < 4; ++j) z += expf(lg[j] - gm);
  const float gw = 1.f / z;
  const float c0 = gs == 0 ? 1.f : 0.f, c1 = gs == 1 ? 1.f : 0.f, c2 = gs == 2 ? 1.f : 0.f, c3 = gs == 3 ? 1.f : 0.f;
  float e4[4];
#pragma unroll
  for (int j = 0; j < 4; ++j) e4[j] = c0 * lg[4 + j] + c1 * lg[8 + j] + c2 * lg[12 + j] + c3 * lg[16 + j];
  int i1 = 0; float m1 = e4[0];
#pragma unroll
  for (int j = 1; j < 4; ++j) if (e4[j] > m1) { m1 = e4[j]; i1 = j; }
  int i2 = -1; float m2 = -3.0e38f;
#pragma unroll
  for (int j = 0; j < 4; ++j) if (j != i1 && e4[j] > m2) { m2 = e4[j]; i2 = j; }
  const float ex = expf(m2 - m1), w1 = 1.f / (1.f + ex), w2 = ex / (1.f + ex);
  if (lane == 0) { te[tl * 2] = gs * 4 + i1; te[tl * 2 + 1] = gs * 4 + i2; tw[tl * 2] = gw * w1; tw[tl * 2 + 1] = gw * w2; }
}
DEVI void phase_G(const Params& p, int bid, int nb, char* smem) {
  int t = threadIdx.x; asm volatile("" : "+v"(t));
  const int lane = t & 63, wv = t >> 6;
  int* te = (int*)smem; float* tw = (float*)(smem + 256);
  float* lgl = (float*)(smem + 1024 + 81920);
  const float* mod = (const float*)(p.ws + OFF_MOD); act_t* hx2 = (act_t*)(p.ws + OFF_HX2);
  const float* wrt = (const float*)(smem + 1024);
  { const f32x4* src = (const f32x4*)(p.ws + OFF_WRT); f32x4* dst = (f32x4*)(smem + 1024);
    __syncthreads();
#pragma unroll
    for (int i = 0; i < 10; ++i) dst[t + 512 * i] = src[t + 512 * i];
    __syncthreads(); }
  int* cnt = (int*)(p.ws + OFF_CNT); int* elist = (int*)(p.ws + OFF_ELIST); float* ewt = (float*)(p.ws + OFF_EW);
  for (int ch = bid; ch < TT / 32; ch += nb) {
    __syncthreads();
    const int b = (ch * 32) >> 13; const float* sh = mod + b * 6144 + 3072; const float* sc = sh + 1024;
#pragma unroll 1
    for (int q = 0; q < 4; q += 2) {
      const int tl = wv * 4 + q, tok = ch * 32 + tl;
      const act_t* xa = (const act_t*)(p.ws + OFF_X1) + (size_t)tok * 1024 + lane * 4; const act_t* xb = xa + 1024;
      float sa = 0.f, sb = 0.f;
      { float va[4][4], vb[4][4];
#pragma unroll
        for (int i = 0; i < 4; ++i) { ld4(xa + 256 * i, va[i]); ld4(xb + 256 * i, vb[i]); }
#pragma unroll
        for (int i = 0; i < 4; ++i) { sa += va[i][0] * va[i][0] + va[i][1] * va[i][1] + va[i][2] * va[i][2] + va[i][3] * va[i][3]; sb += vb[i][0] * vb[i][0] + vb[i][1] * vb[i][1] + vb[i][2] * vb[i][2] + vb[i][3] * vb[i][3]; } }
      sa = wave_sum(sa); sb = wave_sum(sb);
      const float ra = rsqrtf(sa * (1.f / 1024.f) + EPS), rb = rsqrtf(sb * (1.f / 1024.f) + EPS);
      float la[20], lb[20];
#pragma unroll
      for (int j = 0; j < 20; ++j) { la[j] = 0.f; lb[j] = 0.f; }
#pragma unroll 1
      for (int i = 0; i < 4; ++i) {
        const int k = lane * 4 + 256 * i;
        float4 va, vb; { float ta[4], tb[4]; ld4(xa + 256 * i, ta); ld4(xb + 256 * i, tb); va = make_float4(ta[0], ta[1], ta[2], ta[3]); vb = make_float4(tb[0], tb[1], tb[2], tb[3]); }
        const float4 g = *(const float4*)(p.g_ffn + k), s1 = *(const float4*)(sc + k), s0 = *(const float4*)(sh + k);
        const float gx = g.x * (1.f + s1.x), gy = g.y * (1.f + s1.y), gz = g.z * (1.f + s1.z), gw = g.w * (1.f + s1.w);
        const float4 ha = make_float4(va.x * ra * gx + s0.x, va.y * ra * gy + s0.y, va.z * ra * gz + s0.z, va.w * ra * gw + s0.w);
        const float4 hb = make_float4(vb.x * rb * gx + s0.x, vb.y * rb * gy + s0.y, vb.z * rb * gz + s0.z, vb.w * rb * gw + s0.w);
        st4(hx2 + (size_t)tok * 1024 + k, ha.x, ha.y, ha.z, ha.w); st4(hx2 + (size_t)(tok + 1) * 1024 + k, hb.x, hb.y, hb.z, hb.w);
        const float* wk = wrt + k;
#pragma unroll
        for (int jg = 0; jg < 20; jg += 10) {
          float4 w[10];
#pragma unroll
          for (int u = 0; u < 10; ++u) w[u] = *(const float4*)(wk + (jg + u) * 1024);
#pragma unroll
          for (int u = 0; u < 10; ++u) {
            la[jg + u] = fmaf(ha.x, w[u].x, fmaf(ha.y, w[u].y, fmaf(ha.z, w[u].z, fmaf(ha.w, w[u].w, la[jg + u]))));
            lb[jg + u] = fmaf(hb.x, w[u].x, fmaf(hb.y, w[u].y, fmaf(hb.z, w[u].z, fmaf(hb.w, w[u].w, lb[jg + u])))); }
        }
      }
      { float v40[40];
#pragma unroll
        for (int j = 0; j < 20; ++j) { v40[j] = la[j]; v40[20 + j] = lb[j]; }
        wave_reduce40(v40, lane);
        { const int low3 = lane & 7, kk = low3 < 3 ? low3 : low3 - 1;
          if (low3 != 3 && low3 < 6) lgl[(tl + (lane >> 5)) * 20 + ((lane >> 4) & 1) * 10 + ((lane >> 3) & 1) * 5 + kk] = v40[0]; }
      }
    }
    __syncthreads();
    if (wv == 0) {
      if (lane < 32) {
        float lg[20];
#pragma unroll
        for (int j = 0; j < 20; ++j) lg[j] = lgl[lane * 20 + j] + (j < 4 ? p.b_rg[j] : p.b_re[j - 4]);
        route_token(lg, lane, 0, te, tw); }
      const int my_e = te[lane]; const float my_w = tw[lane];
      unsigned long long me_mask = 0ull; int my_n = 0;
#pragma unroll
      for (int e = 0; e < 16; ++e) { const unsigned long long mk = __ballot(my_e == e); if (my_e == e) me_mask = mk; if (lane == e) my_n = __popcll(mk); }
      int base = 0; if (lane < 16 && my_n) base = atomicAdd(&cnt[lane], my_n);
      const int my_base = __shfl(base, my_e);
      const int rank = __popcll(me_mask & ((1ull << lane) - 1ull));
      const int slot = my_base + rank;
      elist[(size_t)my_e * TT + slot] = (ch * 32 + (lane >> 1)) * 2 + (lane & 1); ewt[(size_t)my_e * TT + slot] = my_w;
    }
  }
}

DEVI void phase_J(const Params& p, int bid, int nb) {
  int tx = threadIdx.x; asm volatile("" : "+v"(tx));
  const int lane = tx & 63, wv = tx >> 6;
  const float* mod = (const float*)(p.ws + OFF_MOD); const act_t* yb = (const act_t*)(p.ws + OFF_YBUF);
  for (int tok0 = (bid * NWAVES + wv) * 4; tok0 < TT; tok0 += nb * NWAVES * 4) {
    const int b = tok0 >> 13; const float* g2 = mod + b * 6144 + 5120;
    float4 xv[4][4]; float y0[4][4][4], y1[4][4][4];
#pragma unroll
    for (int q = 0; q < 4; ++q)
#pragma unroll
      for (int i = 0; i < 4; ++i) { const int k = lane * 4 + 256 * i; { float tx4[4]; ld4((const act_t*)(p.ws + OFF_X1) + (size_t)(tok0 + q) * 1024 + k, tx4); xv[q][i] = make_float4(tx4[0], tx4[1], tx4[2], tx4[3]); }
        ld4(yb + (size_t)(tok0 + q) * 1024 + k, y0[q][i]); ld4(yb + ((size_t)TT + tok0 + q) * 1024 + k, y1[q][i]); }
#pragma unroll
    for (int q = 0; q < 4; ++q) {
      float* xo = p.out + (size_t)(tok0 + q) * 1024; float o[16]; float ss = 0.f;
#pragma unroll
      for (int i = 0; i < 4; ++i) { const int k = lane * 4 + 256 * i; const float4 g = *(const float4*)(g2 + k);
        o[4 * i] = xv[q][i].x + g.x * (y0[q][i][0] + y1[q][i][0]); o[4 * i + 1] = xv[q][i].y + g.y * (y0[q][i][1] + y1[q][i][1]);
        o[4 * i + 2] = xv[q][i].z + g.z * (y0[q][i][2] + y1[q][i][2]); o[4 * i + 3] = xv[q][i].w + g.w * (y0[q][i][3] + y1[q][i][3]);
        ss += o[4 * i] * o[4 * i] + o[4 * i + 1] * o[4 * i + 1] + o[4 * i + 2] * o[4 * i + 2] + o[4 * i + 3] * o[4 * i + 3]; }
      ss = wave_sum(ss); const float rstd = rsqrtf(ss * (1.f / 1024.f) + EPS);
#pragma unroll
      for (int i = 0; i < 4; ++i) { const int k = lane * 4 + 256 * i; const float4 g = *(const float4*)(p.g_final + k);
        *(float4*)(xo + k) = make_float4(o[4 * i] * rstd * g.x, o[4 * i + 1] * rstd * g.y, o[4 * i + 2] * rstd * g.z, o[4 * i + 3] * rstd * g.w); }
    }
  }
}

#if ONE_LAUNCH
#define XB_TMO      128
#define XB_XCNT(j)  (256  + 64 * (j))
#define XB_XSUB(j)  (1280 + 64 * (j))
#define XB_XGEN(j)  (2304 + 64 * (j))
#define XB_TOP      3328
#define XB_TOPGEN   3392
#define XCD_BAR_WORDS 3456
#define XB_SPIN_CAP (1u << 20)
#define LAS __attribute__((address_space(3)))
DEVI unsigned xb_ld(unsigned* p)              { return __hip_atomic_load(p, __ATOMIC_RELAXED, __HIP_MEMORY_SCOPE_AGENT); }
DEVI unsigned xb_add(unsigned* p, unsigned v) { return __hip_atomic_fetch_add(p, v, __ATOMIC_RELAXED, __HIP_MEMORY_SCOPE_AGENT); }
DEVI unsigned xb_xcc_id() { return (unsigned)__builtin_amdgcn_s_getreg((3 << 11) | 20) & 0xFu; }
#define XB_SPIN(cond, bar) do { unsigned _sp = 0; while (cond) { __builtin_amdgcn_s_sleep(1); \
    if ((++_sp & 255u) == 0u) { if (xb_ld(&(bar)[XB_TMO])) break; if (_sp > XB_SPIN_CAP) { atomicAdd(&(bar)[XB_TMO], 1u); break; } } } } while (0)
struct XcdBarrier { unsigned* bar; unsigned x; volatile LAS unsigned* st; };
DEVI XcdBarrier xcd_barrier_post(unsigned* bar, volatile LAS unsigned* st) {
  XcdBarrier b; b.bar = bar; b.x = xb_xcc_id(); b.st = st;
  if (threadIdx.x == 0) st[2] = xb_add(&bar[XB_XCNT(b.x)], 1u);
  return b;
}
DEVI void xcd_barrier_complete(unsigned* bar, unsigned x, unsigned& nloc, unsigned& nx) {
  const unsigned G = gridDim.x * gridDim.y * gridDim.z;
  unsigned sum, cnt, mine, sp = 0u;
  for (;;) {
    sum = 0u; cnt = 0u; mine = 0u;
#pragma unroll
    for (unsigned j = 0; j < 16; ++j) { const unsigned c = xb_ld(&bar[XB_XCNT(j)]); sum += c; cnt += (c > 0u) ? 1u : 0u; mine = (j == x) ? c : mine; }
    if (sum == G) break;
    __builtin_amdgcn_s_sleep(1);
    if ((++sp & 255u) == 0u) { if (xb_ld(&bar[XB_TMO])) break; if (sp > XB_SPIN_CAP) { atomicAdd(&bar[XB_TMO], 1u); break; } }
  }
  nloc = mine > 0u ? mine : 1u; nx = cnt > 0u ? cnt : 1u;
}
DEVI void xcd_barrier(const XcdBarrier& b) {
  asm volatile("s_waitcnt vmcnt(0)" ::: "memory");
  __syncthreads();
  if (threadIdx.x == 0) {
    unsigned* bar = b.bar;
    __builtin_amdgcn_s_waitcnt(0);
    unsigned nloc = b.st[0], nx = b.st[1];
    if (nloc == 0u) { xcd_barrier_complete(bar, b.x, nloc, nx); b.st[0] = nloc; b.st[1] = nx; }
    const unsigned old = xb_add(&bar[XB_XSUB(b.x)], 1u);
    const unsigned gen = old / nloc;
    if (old + 1u == (gen + 1u) * nloc) {
      __builtin_amdgcn_fence(__ATOMIC_RELEASE, "agent");
      asm volatile("s_waitcnt vmcnt(0)" ::: "memory");
      const unsigned og = xb_add(&bar[XB_TOP], 1u);
      const unsigned tg = og / nx;
      if (og + 1u == (tg + 1u) * nx) xb_add(&bar[XB_TOPGEN], 1u);
      else XB_SPIN(xb_ld(&bar[XB_TOPGEN]) == tg, bar);
      __builtin_amdgcn_fence(__ATOMIC_ACQUIRE, "agent");
      xb_add(&bar[XB_XGEN(b.x)], 1u);
      asm volatile("s_waitcnt vmcnt(0)" ::: "memory");
    } else {
      XB_SPIN(xb_ld(&bar[XB_XGEN(b.x)]) == gen, bar);
      __builtin_amdgcn_fence(__ATOMIC_ACQUIRE, "agent");
      asm volatile("s_waitcnt vmcnt(0)" ::: "memory");
    }
  }
  __syncthreads();
}

DEVI const float* lds_ptr(const char* smem, int i) { const unsigned* t = (const unsigned*)(smem + SM_PTR) + 2 * i;
  const unsigned lo = __builtin_amdgcn_readfirstlane(t[0]), hi = __builtin_amdgcn_readfirstlane(t[1]);
  typedef const float __attribute__((address_space(1))) gfloat; return (const float*)(gfloat*)(((unsigned long long)hi << 32) | lo); }
DEVI Params load_params(const char* smem) {
  Params q;
  q.x = lds_ptr(smem, 0); q.c = lds_ptr(smem, 1); q.ctx = lds_ptr(smem, 2); q.c_ctx = lds_ptr(smem, 3); q.w_mod = lds_ptr(smem, 4); q.b_mod = lds_ptr(smem, 5);
  q.g_attn = lds_ptr(smem, 6); q.g_ffn = lds_ptr(smem, 7); q.w_in = lds_ptr(smem, 8); q.g_q = lds_ptr(smem, 9); q.g_kv = lds_ptr(smem, 10); q.w_uq = lds_ptr(smem, 11);
  q.w_ukv = lds_ptr(smem, 12); q.rel_bias = lds_ptr(smem, 13); q.w_out = lds_ptr(smem, 14); q.w_rg = lds_ptr(smem, 15); q.b_rg = lds_ptr(smem, 16); q.w_re = lds_ptr(smem, 17);
  q.b_re = lds_ptr(smem, 18); q.w_gate = lds_ptr(smem, 19); q.w_up = lds_ptr(smem, 20); q.w_down = lds_ptr(smem, 21); q.g_final = lds_ptr(smem, 22);
  q.out = (float*)lds_ptr(smem, 23); q.ws = (char*)lds_ptr(smem, 24);
  return q;
}
DEVI XcdBarrier xb_reload(char* smem) { XcdBarrier b; b.bar = (unsigned*)((char*)lds_ptr(smem, 24) + OFF_BAR); b.st = (volatile LAS unsigned*)(smem + SM_BARW);
  b.x = (unsigned)__builtin_amdgcn_readfirstlane((int)b.st[4]); return b; }
#define GRID_BARRIER() do { const XcdBarrier _xb = xb_reload(smem); xcd_barrier(_xb); } while (0)
#define VBID() __builtin_amdgcn_readfirstlane((int)((volatile LAS unsigned*)(smem + SM_BARW))[3])
#define TS(i) do { if (TIMING_PROBE && blockIdx.x == 0 && threadIdx.x == 0) ((unsigned long long*)(pk.ws + OFF_CNT + 64))[i] = __builtin_amdgcn_s_memrealtime(); } while (0)
#ifndef REPEAT_MASK
#define REPEAT_MASK 0
#endif
#define REP(i) _Pragma("nounroll") for (int _r = 0; _r < ((PHASE_ONLY >= 0 && PHASE_ONLY != (i)) ? 0 : (((REPEAT_MASK >> (i)) & 1) ? 2 : 1)); ++_r)

__global__ void __launch_bounds__(NTHREADS, 2) mega_kernel(Params pk) {
  __shared__ __attribute__((aligned(16))) char smem[LDS_TOTAL];
  const int nb = gridDim.x;
  if (threadIdx.x == 0) { *(uint4*)(smem + SM_BARW) = make_uint4(0u, 0u, 0u, (unsigned)blockIdx.x); *(uint4*)(smem + SM_BARW + 16) = make_uint4(0u, 0u, 0u, 0u); }
  if (threadIdx.x < 25) ((unsigned long long*)(smem + SM_PTR))[threadIdx.x] = ((const unsigned long long*)&pk)[threadIdx.x];
  __syncthreads();
  { const XcdBarrier xb0 = xcd_barrier_post((unsigned*)(pk.ws + OFF_BAR), (volatile LAS unsigned*)(smem + SM_BARW));
    if (threadIdx.x == 0) ((volatile LAS unsigned*)(smem + SM_BARW))[4] = xb0.x; }
  __syncthreads();
  TS(0);
  REP(0) { const Params p = load_params(smem); phase_A(p, (int)blockIdx.x, nb, smem); GRID_BARRIER(); }
  TS(1);
  { volatile LAS unsigned* st = (volatile LAS unsigned*)(smem + SM_BARW);
    if (threadIdx.x == 0) { unsigned* bar = (unsigned*)(pk.ws + OFF_BAR); bool even = (nb % 8) == 0;
      for (unsigned j = 0; j < 16; ++j) { const unsigned c = xb_ld(&bar[XB_XCNT(j)]); even = even && (c == (j < 8 ? (unsigned)nb / 8u : 0u)); }
      st[3] = even ? st[2] * 8u + st[4] : (unsigned)blockIdx.x; }
    __syncthreads(); }
  REP(1) { const Params p = load_params(smem); const int bid = VBID(); phase_B(p, bid, nb); GRID_BARRIER(); }
  TS(2);
  REP(2) { { const Params p = load_params(smem); const int bid = VBID(); phase_C(p, bid, nb, smem); }
    { const Params p = load_params(smem); conv_queue(p, smem, 1, NCONV_A, NCONV_C); }
    GRID_BARRIER(); }
  TS(3);
  REP(3) { const Params p = load_params(smem); const int bid = VBID(); phase_D(p, bid, nb, smem); GRID_BARRIER(); }
  TS(4);
  REP(4) { { const Params p = load_params(smem); const int bid = VBID(); phase_E(p, bid, nb, smem); }
    { const Params p = load_params(smem); conv_queue(p, smem, 3, NCONV_C, NCONV_E); }
    GRID_BARRIER(); }
  TS(5);
  REP(5) { const Params p = load_params(smem); const int bid = VBID(); phase_F(p, bid, nb, smem); GRID_BARRIER(); }
  TS(6);
  REP(6) { const Params p = load_params(smem); const int bid = VBID(); phase_G(p, bid, nb, smem); GRID_BARRIER(); }
  TS(7);
  REP(7) { { const Params p = load_params(smem); const int bid = VBID(); phase_H(p, bid, nb, smem); }
    { const Params p = load_params(smem); conv_queue(p, smem, 2, NCONV_E, NCONV); }
    GRID_BARRIER(); }
  TS(8);
  REP(8) { const Params p = load_params(smem); const int bid = VBID(); phase_I(p, bid, nb, smem); GRID_BARRIER(); }
  TS(9);
  REP(9) { const Params p = load_params(smem); const int bid = VBID(); phase_J(p, bid, nb); }
#if TIMING_PROBE
  GRID_BARRIER(); TS(10);
  if (blockIdx.x == 0 && threadIdx.x < 64) {
    const int lane = threadIdx.x;
    const unsigned long long* ts = (const unsigned long long*)(pk.ws + OFF_CNT + 64); float ta = 0.f, tr = 0.f;
#pragma unroll
    for (int qq = 0; qq < 10; ++qq) { const float d = (float)(unsigned)(ts[qq + 1] - ts[qq]) * 0.01f; if ((PROBE_A_MASK >> qq) & 1) ta += d; if ((PROBE_R_MASK >> qq) & 1) tr += d; }
    if ((PROBE_A_MASK >> 10) & 1) ta += (float)(unsigned)(ts[11] - ts[4]) * 0.01f;
    if ((PROBE_R_MASK >> 11) & 1) tr += (float)(unsigned)(ts[12] - ts[11]) * 0.01f;
    if ((PROBE_A_MASK >> 12) & 1) ta += (float)(unsigned)(ts[5] - ts[12]) * 0.01f;
    if (lane == 0) pk.out[0] += 1.f + ta * 0.01f;
    { float4* o4 = (float4*)(pk.out + 1024 + lane * 16);
#pragma unroll
      for (int i = 0; i < 4; ++i) { float4 v = o4[i]; v.x += tr * PROBE_R_SCALE; v.y += tr * PROBE_R_SCALE; v.z += tr * PROBE_R_SCALE; v.w += tr * PROBE_R_SCALE; o4[i] = v; } }
  }
#endif
}
#endif

extern "C" void kernel_launch(void* const* d_in, const int* in_sizes, int n_in, void* d_out, int out_size, void* d_ws, size_t ws_size, hipStream_t stream) {
  if (n_in != 23 || out_size != TT * 1024 || ws_size < WS_NEED) { fprintf(stderr, "kernel_launch: unexpected shapes n_in %d out %d ws %zu (need %zu)\n", n_in, out_size, ws_size, (size_t)WS_NEED); return; }
  Params p{};
  const float** f = (const float**)&p;
  for (int i = 0; i < 23; ++i) f[i] = (const float*)d_in[i];
  p.out = (float*)d_out; p.ws = (char*)d_ws;
#if ONE_LAUNCH
  static int grid_blocks = 0;
  if (!grid_blocks) {
    int dev = 0, cus = 0, per_cu = 0;
    hipGetDevice(&dev);
    hipDeviceGetAttribute(&cus, hipDeviceAttributeMultiprocessorCount, dev);
    hipOccupancyMaxActiveBlocksPerMultiprocessor(&per_cu, mega_kernel, NTHREADS, 0);
    if (per_cu > 1) per_cu = 1;
    grid_blocks = cus * per_cu;
    if (grid_blocks <= 0) { fprintf(stderr, "kernel_launch: occupancy query failed (cus %d per_cu %d)\n", cus, per_cu); grid_blocks = 0; return; }
  }
  if (hipMemsetAsync((char*)d_ws + OFF_BAR, 0, 16384, stream) != hipSuccess) { fprintf(stderr, "kernel_launch: memset of barrier words failed\n"); return; }
  hipLaunchKernelGGL(mega_kernel, dim3(grid_blocks), dim3(NTHREADS), 0, stream, p);
  const hipError_t e = hipPeekAtLastError();
  if (e != hipSuccess) fprintf(stderr, "kernel_launch: launch failed: %s (grid %d)\n", hipGetErrorString(e), grid_blocks);
#else
  const int G = 1024;
  hipLaunchKernelGGL(phase_kernel<0>, dim3(G), dim3(NTHREADS), 0, stream, p);
  hipLaunchKernelGGL(phase_kernel<1>, dim3(G), dim3(NTHREADS), 0, stream, p);
  hipLaunchKernelGGL(phase_kernel<2>, dim3(G), dim3(NTHREADS), 0, stream, p);
  hipLaunchKernelGGL(phase_kernel<3>, dim3(G), dim3(NTHREADS), 0, stream, p);
  hipLaunchKernelGGL(phase_kernel<4>, dim3(G), dim3(NTHREADS), 0, stream, p);
  hipLaunchKernelGGL(phase_kernel<5>, dim3(G), dim3(NTHREADS), 0, stream, p);
  hipLaunchKernelGGL(phase_kernel<6>, dim3(G), dim3(NTHREADS), 0, stream, p);
  hipLaunchKernelGGL(phase_kernel<7>, dim3(G), dim3(NTHREADS), 0, stream, p);
  hipLaunchKernelGGL(phase_kernel<8>, dim3(G), dim3(NTHREADS), 0, stream, p);
  hipLaunchKernelGGL(phase_kernel<9>, dim3(G), dim3(NTHREADS), 0, stream, p);
#endif
}
```
